# Optimizing an MI355X kernel written in HIP

```python
import math
import jax, jax.numpy as jnp
from jax import lax
import numpy as np

D_MODEL = 1024
BATCH = 8
SEQ = 8192
DEPTH = 1

PLE_DIM = 256
C_RW = D_MODEL // 2
RW_HEAD = 64
RW_HEADS = C_RW // RW_HEAD
DECAY_LORA = 64
AAA_LORA = 64
GATE_LORA = 128
RW_COLS = 3 * C_RW + 2 * DECAY_LORA + 2 * AAA_LORA + GATE_LORA
RW_GN_EPS = RW_HEAD * 1e-5
C_DA = D_MODEL - C_RW
DA_HEADS = 4
DA_V_DIM = C_DA // DA_HEADS
DA_QK_DIM = DA_V_DIM // 2
DA_COLS = 3 * C_DA
IN_COLS = RW_COLS + DA_COLS
D_MIX = C_RW + C_DA
Q_BLOCK = 128
N_EXPERTS = 32
TOP_K = 4
D_FF = D_MODEL
SWIGLU_ALPHA = 1.702
SWIGLU_LIMIT = 7.0
EXPERT_BLOCK = 128
NORM_EPS = 1e-6

kernel_name = "hybrid_rwkv7_diffattn_moe_encoder"


def rmsnorm(x, g, eps=NORM_EPS):
    xf = x.astype(jnp.float32)
    y = xf * lax.rsqrt(jnp.mean(xf * xf, axis=-1, keepdims=True) + eps)
    return y * g.astype(jnp.float32)


def centred_shift(z):
    zp = jnp.pad(z, ((0, 0), (1, 1), (0, 0)))
    return 0.5 * (zp[:, :-2] + zp[:, 2:])


def rwkv7_bidirectional(z, mu, w0, w2, a0, a2, g2, k_k, k_a, r_k, ln_g, ln_b):
    B, T, _ = z.shape
    H, N = RW_HEADS, RW_HEAD
    z = z.astype(jnp.float32)
    z = z + (centred_shift(z) - z) * mu
    idx = [C_RW, 2 * C_RW, 3 * C_RW, 3 * C_RW + 2 * DECAY_LORA,
           3 * C_RW + 2 * DECAY_LORA + 2 * AAA_LORA]
    r, k, v, wd, ad, gd = jnp.split(z, idx, axis=-1)
    wd = wd.reshape(B, T, 2, DECAY_LORA)
    ad = ad.reshape(B, T, 2, AAA_LORA)
    w_log = -jax.nn.softplus(-(w0 + jnp.einsum('btdr,drc->btdc', jnp.tanh(wd), w2))) - 0.5
    decay = jnp.exp(-jnp.exp(w_log))
    a = jax.nn.sigmoid(a0 + jnp.einsum('btdr,drc->btdc', ad, a2))
    g = jax.nn.sigmoid(gd) @ g2
    kk = (k * k_k).reshape(B, T, H, N)
    kk = kk * lax.rsqrt(jnp.sum(kk * kk, axis=-1, keepdims=True) + 1e-12)
    kk = kk.reshape(B, T, C_RW)
    k_dir = k[:, :, None, :] * (1.0 + (a - 1.0) * k_a)
    b_dir = kk[:, :, None, :] * a

    def to_time_major(x_fwd, x_bwd):
        s = jnp.stack([x_fwd, jnp.flip(x_bwd, axis=1)], axis=0).astype(jnp.float32)
        return s.reshape(2, B, T, H, N).transpose(2, 0, 1, 3, 4)

    xs = (to_time_major(r, r),
          to_time_major(decay[:, :, 0], decay[:, :, 1]),
          to_time_major(k_dir[:, :, 0], k_dir[:, :, 1]),
          to_time_major(v, v),
          to_time_major(-kk, -kk),
          to_time_major(b_dir[:, :, 0], b_dir[:, :, 1]))

    def step(S, inp):
        r_t, w_t, k_t, v_t, a_t, b_t = inp
        sa = jnp.einsum('dbhvk,dbhk->dbhv', S, a_t)
        S = S * w_t[..., None, :] + sa[..., None] * b_t[..., None, :] + v_t[..., None] * k_t[..., None, :]
        y = jnp.einsum('dbhvk,dbhk->dbhv', S, r_t)
        return S, y

    S0 = jnp.zeros((2, B, H, N, N), jnp.float32)
    _, ys = lax.scan(step, S0, xs)
    y = ys[:, 0] + jnp.flip(ys[:, 1], axis=0)
    y = y.transpose(1, 0, 2, 3)
    mean = jnp.mean(y, axis=-1, keepdims=True)
    var = jnp.mean(jnp.square(y - mean), axis=-1, keepdims=True)
    y = (y - mean) * lax.rsqrt(var + RW_GN_EPS) * ln_g + ln_b
    k_bonus = jnp.mean(k_dir, axis=2).reshape(B, T, H, N)
    rh = r.reshape(B, T, H, N)
    vh = v.reshape(B, T, H, N)
    bonus = jnp.sum(rh * k_bonus * r_k, axis=-1, keepdims=True) * vh
    return (y + bonus).reshape(B, T, C_RW) * g


def diff_attention(zq, zk, zv, q_norm_g, k_norm_g, lq1, lk1, lq2, lk2, subln_g, lambda_init):
    B, T, _ = zq.shape
    H, D, E = DA_HEADS, DA_QK_DIM, DA_V_DIM
    q = rmsnorm(zq.reshape(B, T, H, 2, D), q_norm_g)
    k = rmsnorm(zk.reshape(B, T, H, 2, D), k_norm_g)
    v = zv.astype(jnp.float32).reshape(B, T, H, E)
    lq1, lk1, lq2, lk2 = (t.astype(jnp.float32) for t in (lq1, lk1, lq2, lk2))
    lam = jnp.exp(jnp.sum(lq1 * lk1)) - jnp.exp(jnp.sum(lq2 * lk2)) + lambda_init
    scale = 1.0 / math.sqrt(D)
    slopes = 2.0 ** (-8.0 * jnp.arange(1, H + 1, dtype=jnp.float32) / H)
    n_blocks = T // Q_BLOCK
    qb = q.reshape(B, n_blocks, Q_BLOCK, H, 2, D).transpose(1, 0, 2, 3, 4, 5)
    pos_k = jnp.arange(T, dtype=jnp.int32)

    def block(args):
        q_blk, bi = args
        pos_q = bi * Q_BLOCK + jnp.arange(Q_BLOCK, dtype=jnp.int32)
        dist = jnp.abs(pos_q[:, None] - pos_k[None, :]).astype(jnp.float32)
        s = jnp.einsum('bqhcd,bkhcd->bhcqk', q_blk, k) * scale
        s = s - slopes[:, None, None, None] * dist
        pm = jax.nn.softmax(s, axis=-1)
        attn = pm[:, :, 0] - lam * pm[:, :, 1]
        return jnp.einsum('bhqk,bkhe->bqhe', attn, v)

    o = lax.map(block, (qb, jnp.arange(n_blocks, dtype=jnp.int32)))
    o = o.transpose(1, 0, 2, 3, 4).reshape(B, T, H, E)
    o = rmsnorm(o, subln_g) * (1.0 - lambda_init)
    return o.reshape(B, T, H * E)


def routed_experts(xs, ids, gates, w1, b1, w2, b2):
    Tn = xs.shape[0]
    M = Tn * TOP_K
    e_flat = ids.reshape(M)
    g_flat = gates.reshape(M)
    order = jnp.argsort(e_flat)
    se = e_flat[order]
    stok = (order // TOP_K).astype(jnp.int32)
    sg = g_flat[order]
    counts = jnp.bincount(e_flat, length=N_EXPERTS)
    padded = (counts + EXPERT_BLOCK - 1) // EXPERT_BLOCK * EXPERT_BLOCK
    pend = jnp.cumsum(padded)
    pstart = pend - padded
    cstart = jnp.cumsum(counts) - counts
    dest = pstart[se] + jnp.arange(M, dtype=jnp.int32) - cstart[se]
    n_blk = (M + N_EXPERTS * (EXPERT_BLOCK - 1) + EXPERT_BLOCK - 1) // EXPERT_BLOCK
    P = n_blk * EXPERT_BLOCK
    row_tok = jnp.zeros((P,), jnp.int32).at[dest].set(stok)
    row_gate = jnp.zeros((P,), jnp.float32).at[dest].set(sg.astype(jnp.float32))
    blk_start = jnp.arange(n_blk, dtype=pend.dtype) * EXPERT_BLOCK
    blk_e = jnp.minimum(jnp.searchsorted(pend, blk_start, side='right'), N_EXPERTS - 1)
    xb = xs[row_tok].reshape(n_blk, EXPERT_BLOCK, xs.shape[-1])

    def expert_block(args):
        x_blk, e = args
        hcat = x_blk @ w1[e] + b1[e]
        glu = jnp.minimum(hcat[:, :D_FF], SWIGLU_LIMIT)
        lin = jnp.clip(hcat[:, D_FF:], -SWIGLU_LIMIT, SWIGLU_LIMIT)
        act = glu * jax.nn.sigmoid(SWIGLU_ALPHA * glu) * (lin + 1.0)
        return (act @ w2[e] + b2[e]).astype(jnp.float32)

    yb = lax.map(expert_block, (xb, blk_e)).reshape(P, -1)
    return jnp.zeros((Tn, yb.shape[-1]), jnp.float32).at[row_tok].add(yb * row_gate[:, None])


def moe(xn, w_router, b_router, w1, b1, w2, b2):
    logits = (xn @ w_router + b_router).astype(jnp.float32)
    vals, idx = lax.top_k(logits, TOP_K)
    gates = jax.nn.softmax(vals, axis=-1)

    def per_seq(args):
        xs, ids, gs = args
        return routed_experts(xs, ids, gs, w1, b1, w2, b2)

    return lax.map(per_seq, (xn, idx.astype(jnp.int32), gates))


def setup_inputs(seed: int = 0) -> dict:
    key = jax.random.key(seed)
    ks = iter(jax.random.split(key, 48))
    L = DEPTH
    f32 = jnp.float32

    def nrm(shape, scale):
        return jax.random.normal(next(ks), shape, f32) * scale

    def gain(shape):
        return 1.0 + nrm(shape, 0.02)

    return {
        "x": nrm((BATCH, SEQ, D_MODEL), 1.0),
        "p": nrm((DEPTH, BATCH, SEQ, PLE_DIM), 1.0),
        "norm_mix_g": gain((L, D_MODEL)),
        "w_in": nrm((L, D_MODEL, IN_COLS), D_MODEL ** -0.5),
        "rw_mu": jax.random.uniform(next(ks), (L, RW_COLS), f32, 0.0, 1.0),
        "rw_w0": jax.random.uniform(next(ks), (L, 2, C_RW), f32, -6.0, -1.0),
        "rw_w2": nrm((L, 2, DECAY_LORA, C_RW), 0.1 * DECAY_LORA ** -0.5),
        "rw_a0": nrm((L, 2, C_RW), 0.1),
        "rw_a2": nrm((L, 2, AAA_LORA, C_RW), 0.1 * AAA_LORA ** -0.5),
        "rw_g2": nrm((L, GATE_LORA, C_RW), GATE_LORA ** -0.5),
        "rw_k_k": 0.85 + nrm((L, C_RW), 0.02),
        "rw_k_a": gain((L, C_RW)),
        "rw_r_k": nrm((L, RW_HEADS, RW_HEAD), 0.1),
        "rw_ln_g": gain((L, RW_HEADS, RW_HEAD)),
        "rw_ln_b": nrm((L, RW_HEADS, RW_HEAD), 0.01),
        "da_q_norm_g": gain((L, DA_QK_DIM)),
        "da_k_norm_g": gain((L, DA_QK_DIM)),
        "da_lq1": nrm((L, DA_QK_DIM), 0.1),
        "da_lk1": nrm((L, DA_QK_DIM), 0.1),
        "da_lq2": nrm((L, DA_QK_DIM), 0.1),
        "da_lk2": nrm((L, DA_QK_DIM), 0.1),
        "da_subln_g": gain((L, DA_V_DIM)),
        "w_out": nrm((L, D_MIX, D_MODEL), D_MIX ** -0.5),
        "norm_ffn_g": gain((L, D_MODEL)),
        "w_router": nrm((L, D_MODEL, N_EXPERTS), D_MODEL ** -0.5),
        "b_router": nrm((L, N_EXPERTS), 0.01),
        "w1": nrm((L, N_EXPERTS, D_MODEL, 2 * D_FF), D_MODEL ** -0.5),
        "b1": nrm((L, N_EXPERTS, 2 * D_FF), 0.01),
        "w2": nrm((L, N_EXPERTS, D_FF, D_MODEL), D_FF ** -0.5),
        "b2": nrm((L, N_EXPERTS, D_MODEL), 0.01),
        "w_ple": nrm((L, PLE_DIM, D_MODEL), PLE_DIM ** -0.5),
        "ple_norm_g": gain((L, D_MODEL)),
        "w_ple_gate": nrm((L, D_MODEL, D_MODEL), D_MODEL ** -0.5),
    }


def reference(x, p, norm_mix_g, w_in, rw_mu, rw_w0, rw_w2, rw_a0, rw_a2, rw_g2,
              rw_k_k, rw_k_a, rw_r_k, rw_ln_g, rw_ln_b, da_q_norm_g, da_k_norm_g,
              da_lq1, da_lk1, da_lq2, da_lk2, da_subln_g, w_out, norm_ffn_g,
              w_router, b_router, w1, b1, w2, b2, w_ple, ple_norm_g, w_ple_gate):
    h = x.astype(jnp.float32)
    for i in range(DEPTH):
        lambda_init = 0.8 - 0.6 * math.exp(-0.3 * i)
        u = rmsnorm(h, norm_mix_g[i]).astype(x.dtype)
        z = u @ w_in[i]
        z_rw = z[..., :RW_COLS]
        z_q = z[..., RW_COLS:RW_COLS + C_DA]
        z_k = z[..., RW_COLS + C_DA:RW_COLS + 2 * C_DA]
        z_v = z[..., RW_COLS + 2 * C_DA:]
        o_rw = rwkv7_bidirectional(z_rw, rw_mu[i], rw_w0[i], rw_w2[i], rw_a0[i], rw_a2[i],
                                   rw_g2[i], rw_k_k[i], rw_k_a[i], rw_r_k[i],
                                   rw_ln_g[i], rw_ln_b[i])
        o_da = diff_attention(z_q, z_k, z_v, da_q_norm_g[i], da_k_norm_g[i],
                              da_lq1[i], da_lk1[i], da_lq2[i], da_lk2[i],
                              da_subln_g[i], lambda_init)
        o = jnp.concatenate([o_rw, o_da], axis=-1).astype(x.dtype)
        h = h + (o @ w_out[i]).astype(jnp.float32)
        m = rmsnorm(h, norm_ffn_g[i]).astype(x.dtype)
        h = h + moe(m, w_router[i], b_router[i], w1[i], b1[i], w2[i], b2[i])
        e = rmsnorm(p[i] @ w_ple[i], ple_norm_g[i])
        gate = jax.nn.sigmoid((h.astype(x.dtype) @ w_ple_gate[i]).astype(jnp.float32))
        h = h + e * gate
    return h.astype(x.dtype)
```

```cpp
#include <hip/hip_runtime.h>
#include <stdint.h>
#include <stdio.h>

#define LAS __attribute__((address_space(3)))
#define DI __device__ __forceinline__
typedef unsigned short bf16_t;
typedef short bf16x8 __attribute__((ext_vector_type(8)));
typedef short s16x4 __attribute__((ext_vector_type(4)));
typedef float f32x4 __attribute__((ext_vector_type(4)));
typedef float f32x2 __attribute__((ext_vector_type(2)));
typedef float f32x16 __attribute__((ext_vector_type(16)));
typedef unsigned u32x4 __attribute__((ext_vector_type(4)));
typedef unsigned u32x2 __attribute__((ext_vector_type(2)));
typedef __bf16 bf16x2_t __attribute__((ext_vector_type(2)));

constexpr int D_MODEL = 1024, BATCH = 8, SEQ = 8192, MTOK = BATCH * SEQ;
constexpr int PLE_DIM = 256;
constexpr int C_RW = 512, RW_HEAD = 64, RW_HEADS = 8, RW_COLS = 1920;
constexpr int C_DA = 512, DA_HEADS = 4, DA_V = 128, DA_QK = 64;
constexpr int IN_COLS = 3456, IN_PAD = 3584;
constexpr int N_EXP = 32, TOPK = 4, D_FF = 1024;
constexpr int ZR = 0, ZK = 512, ZV = 1024, ZWD = 1536, ZAD = 1664, ZGD = 1792, ZQ = 1920, ZKK = 2432, ZVV = 2944;
constexpr float NORM_EPS = 1e-6f;
constexpr float LOG2E = 1.4426950408889634f;

constexpr size_t MiB = 1024ull * 1024ull;
constexpr size_t WS_CTL = 0;
constexpr size_t CTL_BYTES = 64 * 1024;
constexpr size_t WS_WIN = WS_CTL + CTL_BYTES;
constexpr size_t WS_WOUT = WS_WIN + (size_t)IN_PAD * 1024 * 2;
constexpr size_t WS_W1 = WS_WOUT + 2 * MiB;
constexpr size_t WS_W2 = WS_W1 + 128 * MiB;
constexpr size_t WS_WPLE = WS_W2 + 64 * MiB;
constexpr size_t WS_WG = WS_WPLE + MiB / 2;
constexpr size_t WS_PB = WS_WG + 2 * MiB;
constexpr size_t WS_U = WS_PB + 32 * MiB;
constexpr size_t WS_Z = WS_U + 128 * MiB;
constexpr size_t WS_O = WS_Z + 432 * MiB;
constexpr size_t WS_LIST = WS_Z + 576 * MiB;
constexpr size_t WS_GATE = WS_LIST + 32 * MiB;
constexpr size_t WS_ESS = WS_GATE + MiB;
constexpr size_t WS_END = WS_ESS + MiB / 4;
constexpr int ACT_ROWS_MAX = 262144 + 128 * 256;

constexpr int CW_BAR = 0;
constexpr int CW_CNT = 4096;
constexpr int CW_QUEUE = 4352;
constexpr int CW_LAM = 4416;

struct Params {
    const float* x; const float* p; const float* norm_mix_g; const float* w_in; const float* rw_mu; const float* rw_w0; const float* rw_w2;
    const float* rw_a0; const float* rw_a2; const float* rw_g2; const float* rw_k_k; const float* rw_k_a; const float* rw_r_k; const float* rw_ln_g;
    const float* rw_ln_b; const float* da_q_norm_g; const float* da_k_norm_g; const float* da_lq1; const float* da_lk1; const float* da_lq2;
    const float* da_lk2; const float* da_subln_g; const float* w_out; const float* norm_ffn_g; const float* w_router; const float* b_router;
    const float* w1; const float* b1; const float* w2; const float* b2; const float* w_ple; const float* ple_norm_g; const float* w_ple_gate;
    float* out; unsigned char* ws; int ph_lo, ph_hi;
};

DI unsigned cvt_pk(float lo, float hi) { f32x2 v = {lo, hi}; bf16x2_t r = __builtin_convertvector(v, bf16x2_t); return __builtin_bit_cast(unsigned, r); }
DI float bf_lo(unsigned u) { return __uint_as_float(u << 16); }
DI float bf_hi(unsigned u) { return __uint_as_float(u & 0xffff0000u); }
DI float bf2f(bf16_t b) { return __uint_as_float(((unsigned)b) << 16); }
DI bf16_t f2bf(float f) { return (bf16_t)(cvt_pk(f, f) & 0xffffu); }
DI float wave_sum(float v) {
#pragma unroll
    for (int o = 32; o >= 1; o >>= 1) v += __shfl_xor(v, o);
    return v;
}
DI float sigmoidf_(float x) { return __builtin_amdgcn_rcpf(1.f + __builtin_amdgcn_exp2f(-x * LOG2E)); }

#define XB_TMO      128
#define XB_XCNT(j)  (256  + 64 * (j))
#define XB_XSUB(j)  (1280 + 64 * (j))
#define XB_XGEN(j)  (2304 + 64 * (j))
#define XB_TOP      3328
#define XB_TOPGEN   3392
#define XCD_BAR_WORDS 3456
#define XB_SPIN_CAP (1u << 22)
DI unsigned xb_ld(unsigned* p)              { return __hip_atomic_load(p, __ATOMIC_RELAXED, __HIP_MEMORY_SCOPE_AGENT); }
DI unsigned xb_add(unsigned* p, unsigned v) { return __hip_atomic_fetch_add(p, v, __ATOMIC_RELAXED, __HIP_MEMORY_SCOPE_AGENT); }
DI unsigned xb_xcc_id() { return (unsigned)__builtin_amdgcn_s_getreg((3 << 11) | 20) & 0xFu; }
#define XB_SPIN(cond, bar) do { unsigned _sp = 0; while (cond) { __builtin_amdgcn_s_sleep(1); \
    if ((++_sp & 255u) == 0u) { if (xb_ld(&(bar)[XB_TMO])) break; if (_sp > XB_SPIN_CAP) { atomicAdd(&(bar)[XB_TMO], 1u); break; } } } } while (0)
struct XcdBarrier { unsigned* bar; unsigned x; volatile LAS unsigned* st; };
DI XcdBarrier xcd_barrier_post(unsigned* bar, volatile LAS unsigned* st) {
    XcdBarrier b; b.bar = bar; b.x = xb_xcc_id(); b.st = st;
    if (threadIdx.x == 0) (void)xb_add(&bar[XB_XCNT(b.x)], 1u);
    return b;
}
DI void xcd_barrier_complete(unsigned* bar, unsigned x, unsigned& nloc, unsigned& nx) {
    const unsigned G = gridDim.x * gridDim.y * gridDim.z;
    unsigned sum, cnt, mine, sp = 0u;
    for (;;) {
        sum = 0u; cnt = 0u; mine = 0u;
#pragma unroll
        for (unsigned j = 0; j < 16; ++j) { const unsigned c = xb_ld(&bar[XB_XCNT(j)]); sum += c; cnt += (c > 0u) ? 1u : 0u; mine = (j == x) ? c : mine; }
        if (sum == G) break;
        __builtin_amdgcn_s_sleep(1);
        if ((++sp & 255u) == 0u) { if (xb_ld(&bar[XB_TMO])) break; if (sp > XB_SPIN_CAP) { atomicAdd(&bar[XB_TMO], 1u); break; } }
    }
    nloc = mine > 0u ? mine : 1u; nx = cnt > 0u ? cnt : 1u;
}
DI void xcd_barrier(const XcdBarrier& b) {
    asm volatile("s_waitcnt vmcnt(0)" ::: "memory");
    __syncthreads();
    if (threadIdx.x == 0) {
        unsigned* bar = b.bar;
        __builtin_amdgcn_s_waitcnt(0);
        unsigned nloc = b.st[0], nx = b.st[1];
        if (nloc == 0u) { xcd_barrier_complete(bar, b.x, nloc, nx); b.st[0] = nloc; b.st[1] = nx; }
        const unsigned old = xb_add(&bar[XB_XSUB(b.x)], 1u);
        const unsigned gen = old / nloc;
        if (old + 1u == (gen + 1u) * nloc) {
            __builtin_amdgcn_fence(__ATOMIC_RELEASE, "agent");
            asm volatile("s_waitcnt vmcnt(0)" ::: "memory");
            const unsigned og = xb_add(&bar[XB_TOP], 1u);
            const unsigned tg = og / nx;
            if (og + 1u == (tg + 1u) * nx) xb_add(&bar[XB_TOPGEN], 1u);
            else XB_SPIN(xb_ld(&bar[XB_TOPGEN]) == tg, bar);
            __builtin_amdgcn_fence(__ATOMIC_ACQUIRE, "agent");
            xb_add(&bar[XB_XGEN(b.x)], 1u);
            asm volatile("s_waitcnt vmcnt(0)" ::: "memory");
        } else {
            XB_SPIN(xb_ld(&bar[XB_XGEN(b.x)]) == gen, bar);
            __builtin_amdgcn_fence(__ATOMIC_ACQUIRE, "agent");
            asm volatile("s_waitcnt vmcnt(0)" ::: "memory");
        }
    }
    __syncthreads();
}

constexpr int BM = 256, BK = 64, HALF = 128, HTB = HALF * BK * 2, STAGE_BYTES = 8 * HTB, NXCD = 8, WGM = 8;
constexpr int LDS_TAB = STAGE_BYTES;
constexpr int LDS_GRP = STAGE_BYTES + 2048;
constexpr int LDS_BYTES = 156 * 1024;
constexpr int LDS_XB = LDS_BYTES - 16;
constexpr int LDS_QW = LDS_BYTES - 32;

DI void tconv_tile(const float* __restrict__ src, int ldn, int k0, int ncol0, bool zero, bf16_t* __restrict__ dst, int K, int nrow0, float* tile  ) {
    const int t = threadIdx.x;
    {
        const int kk = t >> 4, c4 = (t & 15) * 4;
#pragma unroll
        for (int i = 0; i < 2; ++i) {
            const int k = kk + 32 * i;
            f32x4 v = {0.f, 0.f, 0.f, 0.f};
            if (!zero) v = *(const f32x4*)(src + (size_t)(k0 + k) * ldn + ncol0 + c4);
            tile[(c4 + 0) * 65 + k] = v[0]; tile[(c4 + 1) * 65 + k] = v[1]; tile[(c4 + 2) * 65 + k] = v[2]; tile[(c4 + 3) * 65 + k] = v[3];
        }
    }
    __syncthreads();
    {
        const int n = t >> 3, kc = (t & 7) * 8;
        const float* r = tile + n * 65 + kc;
        u32x4 o = {cvt_pk(r[0], r[1]), cvt_pk(r[2], r[3]), cvt_pk(r[4], r[5]), cvt_pk(r[6], r[7])};
        *(u32x4*)(dst + (size_t)(nrow0 + n) * K + k0 + kc) = o;
    }
    __syncthreads();
}

DI void phase_prep(const Params& P, unsigned char* lds_generic) {
    float* tile = (float*)lds_generic;
    const int wg = blockIdx.x, nwg = gridDim.x;
    unsigned char* ws = P.ws;
    constexpr int J0 = 16 * 56, J1 = J0 + 256, J2 = J1 + 32 * 16 * 32, J3 = J2 + 32 * 16 * 16, J4 = J3 + 64, J5 = J4 + 256;
    for (int j = wg; j < J5; j += nwg) {
        if (j < J0) { const int kt = j / 56, nt = j % 56; tconv_tile(P.w_in, IN_COLS, kt * 64, nt * 64, nt >= 54, (bf16_t*)(ws + WS_WIN), 1024, nt * 64, tile); }
        else if (j < J1) { const int q = j - J0, kt = q >> 4, nt = q & 15; tconv_tile(P.w_out, 1024, kt * 64, nt * 64, false, (bf16_t*)(ws + WS_WOUT), 1024, nt * 64, tile); }
        else if (j < J2) { const int q = j - J1, e = q >> 9, r = q & 511, kt = r >> 5, nt = r & 31; const int n0 = nt * 64;
            const int orig = ((n0 & 128) ? 1024 : 0) + (n0 >> 8) * 128 + (n0 & 127);
            tconv_tile(P.w1 + (size_t)e * 1024 * 2048, 2048, kt * 64, orig, false, (bf16_t*)(ws + WS_W1) + (size_t)e * 2048 * 1024, 1024, n0, tile); }
        else if (j < J3) { const int q = j - J2, e = q >> 8, r = q & 255, kt = r >> 4, nt = r & 15;
            tconv_tile(P.w2 + (size_t)e * 1024 * 1024, 1024, kt * 64, nt * 64, false, (bf16_t*)(ws + WS_W2) + (size_t)e * 1024 * 1024, 1024, nt * 64, tile); }
        else if (j < J4) { const int q = j - J3, kt = q >> 4, nt = q & 15; tconv_tile(P.w_ple, 1024, kt * 64, nt * 64, false, (bf16_t*)(ws + WS_WPLE), 256, nt * 64, tile); }
        else { const int q = j - J4, kt = q >> 4, nt = q & 15; tconv_tile(P.w_ple_gate, 1024, kt * 64, nt * 64, false, (bf16_t*)(ws + WS_WG), 1024, nt * 64, tile); }
    }
    {
        const int wid = threadIdx.x >> 6, lane = threadIdx.x & 63;
        f32x4 g[4];
#pragma unroll
        for (int i = 0; i < 4; ++i) g[i] = *(const f32x4*)(P.norm_mix_g + 4 * lane + 256 * i);
        bf16_t* U = (bf16_t*)(ws + WS_U);
        for (int row = wg * 8 + wid; row < MTOK; row += nwg * 8) {
            const float* xr = P.x + (size_t)row * 1024;
            f32x4 v[4]; float ss = 0.f;
#pragma unroll
            for (int i = 0; i < 4; ++i) { v[i] = *(const f32x4*)(xr + 4 * lane + 256 * i); ss += v[i][0] * v[i][0] + v[i][1] * v[i][1] + v[i][2] * v[i][2] + v[i][3] * v[i][3]; }
            ss = wave_sum(ss);
            const float rinv = __builtin_amdgcn_rsqf(ss * (1.f / 1024.f) + NORM_EPS);
#pragma unroll
            for (int i = 0; i < 4; ++i) {
                u32x2 o = {cvt_pk(v[i][0] * rinv * g[i][0], v[i][1] * rinv * g[i][1]), cvt_pk(v[i][2] * rinv * g[i][2], v[i][3] * rinv * g[i][3])};
                *(u32x2*)(U + (size_t)row * 1024 + 4 * lane + 256 * i) = o;
            }
        }
    }
    {
        bf16_t* PB = (bf16_t*)(ws + WS_PB);
        const size_t n8 = (size_t)MTOK * PLE_DIM / 8;
        for (size_t i = (size_t)wg * 512 + threadIdx.x; i < n8; i += (size_t)nwg * 512) {
            const f32x4 a = *(const f32x4*)(P.p + i * 8), b = *(const f32x4*)(P.p + i * 8 + 4);
            u32x4 o = {cvt_pk(a[0], a[1]), cvt_pk(a[2], a[3]), cvt_pk(b[0], b[1]), cvt_pk(b[2], b[3])};
            *(u32x4*)(PB + i * 8) = o;
        }
    }
}

DI int lds_byte(int r, int c) { const int st = (r >> 4) * 2 + (c >> 5), rr = r & 15, cc = c & 31, ob = rr * 64 + cc * 2; return st * 1024 + (ob ^ (((ob >> 9) & 1) << 5)); }
DI void stage_rc(int b, int& R, int& C) { const int st = b / 1024, sb = b % 1024, swz = sb ^ (((sb >> 9) & 1) << 5); R = (st >> 1) * 16 + swz / 64; C = (st & 1) * 32 + (swz % 64) / 2; }
DI int perm32(int rho) { const int n = rho >> 4, i = rho & 15; return 8 * (i >> 2) + 4 * n + (i & 3); }

struct Unit { const char* A; const char* B; int pm, pn, g, cnt, arow; };
typedef f32x4 AccT[2][2][4][2];

struct DenseOrder {
    const char* A; const char* B; int nM, nN, nwg, G, c; size_t astep, bstep;
    DI void init(const void* A_, const void* B_, int M, int N, int lda_bytes, int ldb_bytes) { A = (const char*)A_; B = (const char*)B_; nM = M / BM; nN = N / BM; nwg = nM * nN; G = gridDim.x; c = blockIdx.x; astep = (size_t)BM * lda_bytes; bstep = (size_t)BM * ldb_bytes; }
    static constexpr bool GATHER = false;
    DI bool next(int i, Unit& u) const {
        const long L = (long)i * G + c; if (L >= nwg) return false;
        int wgid = (int)L; { const int q = nwg / NXCD, r = nwg % NXCD, xcd = wgid % NXCD, off = wgid / NXCD; wgid = (xcd < r ? xcd * (q + 1) : r * (q + 1) + (xcd - r) * q) + off; }
        const int nig = WGM * nN, gid = wgid / nig, fm = gid * WGM, gsz = (nM - fm) < WGM ? (nM - fm) : WGM;
        u.pm = fm + ((wgid % nig) % gsz); u.pn = (wgid % nig) / gsz; u.A = A + (size_t)u.pm * astep; u.B = B + (size_t)u.pn * bstep; u.g = 0; u.cnt = 256; u.arow = u.pm * 256; return true;
    }
    DI void issue_table(const Unit&, LAS unsigned char*) const {}
    DI unsigned row_off(const Unit&, LAS unsigned char*, int) const { return 0u; }
};

#define G_WAIT_V(n) asm volatile("s_waitcnt vmcnt(" #n ")" ::: "memory")
#define G_WAIT_L(n) asm volatile("s_waitcnt lgkmcnt(" #n ")" ::: "memory")
#define G_BAR __builtin_amdgcn_s_barrier()
#define G_SCHED __builtin_amdgcn_sched_barrier(0)

template <bool OPQ, class Sched, class Epi>
DI void gemm_phase(LAS unsigned char* lds, const int K_  , const int lda_  , const Sched& S, const Epi& E) {
    int K = K_, lda = lda_; if constexpr (OPQ) asm volatile("" : "+s"(K), "+s"(lda));
    const int tid = threadIdx.x, wid = __builtin_amdgcn_readfirstlane(tid >> 6), lane = tid & 63, wr = wid >> 2, wc = wid & 3, fr = lane & 15, fq = lane >> 4;
    const int nt = K / BK;
    unsigned vA[2][2], voffB[2]; int R0 = 0, C0 = 0;
#pragma unroll
    for (int i = 0; i < 2; ++i) { int R, C; stage_rc(tid * 16 + i * 8192, R, C); const int Rb = Epi::PERM ? ((R & ~31) + perm32(R & 31)) : R;
        if (i == 0) { R0 = R; C0 = C; } voffB[i] = (unsigned)(Rb * K + C) * 2u;
        vA[0][i] = (unsigned)(R * lda + C) * 2u; vA[1][i] = (unsigned)((R + HALF) * lda + C) * 2u; }
    const size_t kstep = (size_t)(BK * 2);
    const size_t hstepB = (size_t)HALF * K * 2;
    const unsigned ldsw = (unsigned)wid * 1024u;
    const int aoff = lds_byte(wr * 64 + fr, fq * 8), boff = lds_byte(wc * 32 + fr, fq * 8);
#define G_SA(b, h) (((b) * 2 + (h)) * HTB)
#define G_SB(b, h) ((4 + (b) * 2 + (h)) * HTB)
#define G_STAGE(bufoff, gbase, v0, v1) do { \
        __builtin_amdgcn_global_load_lds((const unsigned*)((const char*)(gbase) + (v0)), (LAS unsigned*)(lds + (bufoff) + ldsw), 16, 0, 0); \
        __builtin_amdgcn_global_load_lds((const unsigned*)((const char*)(gbase) + (v1)), (LAS unsigned*)(lds + (bufoff) + ldsw + 8192), 16, 0, 0); } while (0)
#define G_LDA(dst, b, h) do { _Pragma("unroll") for (int m = 0; m < 4; ++m) _Pragma("unroll") for (int k = 0; k < 2; ++k) dst[m][k] = *(const LAS bf16x8*)(lds + G_SA(b, h) + aoff + m * 2048 + k * 1024); } while (0)
#define G_LDB(dst, b, h) do { _Pragma("unroll") for (int n = 0; n < 2; ++n) _Pragma("unroll") for (int k = 0; k < 2; ++k) dst[n][k] = *(const LAS bf16x8*)(lds + G_SB(b, h) + boff + n * 2048 + k * 1024); } while (0)
#define G_MMA(ai, bj, At, Bt) do { __builtin_amdgcn_s_setprio(1); _Pragma("unroll") for (int m = 0; m < 4; ++m) _Pragma("unroll") for (int n = 0; n < 2; ++n) _Pragma("unroll") for (int k = 0; k < 2; ++k) \
        acc[ai][bj][m][n] = __builtin_amdgcn_mfma_f32_16x16x32_bf16(Bt[n][k], At[m][k], acc[ai][bj][m][n], 0, 0, 0); __builtin_amdgcn_s_setprio(0); } while (0)
    Unit cur, nxt; int ui = 0;
    if (!S.next(0, cur)) return;
    AccT acc;
#pragma unroll
    for (int a = 0; a < 2; ++a)
#pragma unroll
        for (int b = 0; b < 2; ++b)
#pragma unroll
            for (int m = 0; m < 4; ++m)
#pragma unroll
                for (int n = 0; n < 2; ++n) acc[a][b][m][n] = (f32x4){0.f, 0.f, 0.f, 0.f};
    bf16x8 At[4][2], B0[2][2], B1[2][2];
    const char* cA = cur.A; const char* cB = cur.B;
    if constexpr (Sched::GATHER) {
        S.issue_table(cur, lds + LDS_TAB);
        G_WAIT_V(0); __syncthreads();
#pragma unroll
        for (int h = 0; h < 2; ++h)
#pragma unroll
            for (int i = 0; i < 2; ++i) { vA[h][i] = S.row_off(cur, lds + LDS_TAB, R0 + 64 * i + HALF * h) + (unsigned)C0 * 2u; }
    }
    G_STAGE(G_SB(0, 0), cB, voffB[0], voffB[1]); G_STAGE(G_SA(0, 0), cA, vA[0][0], vA[0][1]); G_STAGE(G_SB(0, 1), cB + hstepB, voffB[0], voffB[1]); G_STAGE(G_SA(0, 1), cA, vA[1][0], vA[1][1]);
    if (wr == 1) G_BAR;
    G_WAIT_V(4); G_BAR;
    G_STAGE(G_SB(1, 0), cB + kstep, voffB[0], voffB[1]); G_STAGE(G_SA(1, 0), cA + kstep, vA[0][0], vA[0][1]); G_STAGE(G_SB(1, 1), cB + hstepB + kstep, voffB[0], voffB[1]);
    G_WAIT_V(6); G_BAR;
    for (;;) {
        const bool has_next = S.next(ui + 1, nxt);
        const char* nA = has_next ? nxt.A : cA; const char* nB = has_next ? nxt.B : cB;
        for (int t = 0; t < nt; t += 2) {
            const bool last = (t == nt - 2);
            const char* a1 = cA + (size_t)(t + 1) * kstep;
            const char* a2 = last ? nA : cA + (size_t)(t + 2) * kstep; const char* b2 = last ? nB : cB + (size_t)(t + 2) * kstep;
            const char* a3 = a2 + kstep; const char* b3 = b2 + kstep;
            if constexpr (Sched::GATHER) {
                if (t == 0 && has_next) S.issue_table(nxt, lds + LDS_TAB + ((ui + 1) & 1) * 1024);
            }
            G_LDB(B0, 0, 0); G_SCHED; G_LDA(At, 0, 0); G_STAGE(G_SA(1, 1), a1, vA[1][0], vA[1][1]);
            if constexpr (Sched::GATHER) {
                if (last && has_next) {
                    int tz = threadIdx.x; asm volatile("" : "+v"(tz)); int Rz, Cz; stage_rc(tz * 16, Rz, Cz);
#pragma unroll
                    for (int h = 0; h < 2; ++h)
#pragma unroll
                        for (int i = 0; i < 2; ++i) vA[h][i] = S.row_off(nxt, lds + LDS_TAB + ((ui + 1) & 1) * 1024, Rz + 64 * i + HALF * h) + (unsigned)Cz * 2u;
                }
            }
            G_WAIT_L(8); G_BAR; G_WAIT_L(0); G_MMA(0, 0, At, B0); G_BAR; G_SCHED;
            G_LDB(B1, 0, 1); G_STAGE(G_SB(0, 0), b2, voffB[0], voffB[1]);
            G_BAR; G_WAIT_L(0); G_MMA(0, 1, At, B1); G_BAR;
            G_LDA(At, 0, 1); G_STAGE(G_SA(0, 0), a2, vA[0][0], vA[0][1]);
            G_BAR; G_WAIT_L(0); G_MMA(1, 0, At, B0); G_BAR; G_SCHED;
            G_STAGE(G_SB(0, 1), b2 + hstepB, voffB[0], voffB[1]);
            G_WAIT_V(6); G_BAR; G_MMA(1, 1, At, B1); G_BAR;
            G_LDB(B0, 1, 0); G_SCHED; G_LDA(At, 1, 0); G_STAGE(G_SA(0, 1), a2, vA[1][0], vA[1][1]);
            G_WAIT_L(8); G_BAR; G_WAIT_L(0); G_MMA(0, 0, At, B0); G_BAR; G_SCHED;
            G_LDB(B1, 1, 1); G_STAGE(G_SB(1, 0), b3, voffB[0], voffB[1]);
            G_BAR; G_WAIT_L(0); G_MMA(0, 1, At, B1); G_BAR;
            G_LDA(At, 1, 1); G_STAGE(G_SA(1, 0), a3, vA[0][0], vA[0][1]);
            G_BAR; G_WAIT_L(0); G_MMA(1, 0, At, B0); G_BAR; G_SCHED;
            G_STAGE(G_SB(1, 1), b3 + hstepB, voffB[0], voffB[1]);
            G_WAIT_V(6); G_BAR; G_MMA(1, 1, At, B1); G_BAR;
        }
        { int tz = threadIdx.x; asm volatile("" : "+v"(tz)); const int wz = tz >> 6, lz = tz & 63; E(acc, cur, wz >> 2, wz & 3, lz & 15, lz >> 4); }
        if (!has_next) break;
#pragma unroll
        for (int a = 0; a < 2; ++a)
#pragma unroll
            for (int b = 0; b < 2; ++b)
#pragma unroll
                for (int m = 0; m < 4; ++m)
#pragma unroll
                    for (int n = 0; n < 2; ++n) acc[a][b][m][n] = (f32x4){0.f, 0.f, 0.f, 0.f};
        cur = nxt; cA = nA; cB = nB; ++ui;
    }
    G_WAIT_V(0);
    if (wr == 0) G_BAR;
    G_BAR;
}

struct EpiZ {
    static constexpr bool PERM = true;
    bf16_t* Z;
    DI void operator()(const AccT& acc, const Unit& u, int wr, int wc, int fr, int fq) const {
        const int row0 = u.pm * BM + wr * 64 + fr, col0 = u.pn * BM + wc * 32 + 8 * fq;
#pragma unroll
        for (int ai = 0; ai < 2; ++ai)
#pragma unroll
            for (int m = 0; m < 4; ++m) { bf16_t* rowp = Z + (size_t)(row0 + ai * HALF + m * 16) * IN_COLS + col0;
#pragma unroll
                for (int bj = 0; bj < 2; ++bj) { if (col0 + bj * HALF < IN_COLS) { const f32x4 v0 = acc[ai][bj][m][0], v1 = acc[ai][bj][m][1];
                    u32x4 o = {cvt_pk(v0[0], v0[1]), cvt_pk(v0[2], v0[3]), cvt_pk(v1[0], v1[1]), cvt_pk(v1[2], v1[3])}; *(u32x4*)(rowp + bj * HALF) = o; } } }
    }
};
struct EpiH1 {
    static constexpr bool PERM = false;
    const float* X; float* H;
    DI void operator()(const AccT& acc, const Unit& u, int wr, int wc, int fr, int fq) const {
        const int row0 = u.pm * BM + wr * 64 + fr, col0 = u.pn * BM + wc * 32 + 4 * fq;
#pragma unroll
        for (int ai = 0; ai < 2; ++ai)
#pragma unroll
            for (int m = 0; m < 4; ++m) { const size_t ro = (size_t)(row0 + ai * HALF + m * 16) * 1024 + col0;
#pragma unroll
                for (int bj = 0; bj < 2; ++bj)
#pragma unroll
                    for (int n = 0; n < 2; ++n) { const f32x4 xv = *(const f32x4*)(X + ro + bj * HALF + n * 16); *(f32x4*)(H + ro + bj * HALF + n * 16) = xv + acc[ai][bj][m][n]; } }
    }
};
struct EpiMoe1 {
    static constexpr bool PERM = true;
    bf16_t* ACT; const float* b1;
    DI void operator()(const AccT& acc, const Unit& u, int wr, int wc, int fr, int fq) const {
        const int e = u.g & 31, cb = u.pn * 128 + wc * 32 + 8 * fq;
        const float* bg = b1 + (size_t)e * 2048 + cb; const float* bl = bg + 1024;
        const f32x4 bg0 = *(const f32x4*)bg, bg1 = *(const f32x4*)(bg + 4), bl0 = *(const f32x4*)bl, bl1 = *(const f32x4*)(bl + 4);
#pragma unroll
        for (int ai = 0; ai < 2; ++ai)
#pragma unroll
            for (int m = 0; m < 4; ++m) {
                const int rl = ai * HALF + wr * 64 + m * 16 + fr;
                float o[8];
#pragma unroll
                for (int n = 0; n < 2; ++n)
#pragma unroll
                    for (int j = 0; j < 4; ++j) {
                        float glu = acc[ai][0][m][n][j] + (n ? bg1[j] : bg0[j]); float lin = acc[ai][1][m][n][j] + (n ? bl1[j] : bl0[j]);
                        glu = fminf(glu, 7.0f); lin = fminf(fmaxf(lin, -7.0f), 7.0f);
                        o[n * 4 + j] = glu * sigmoidf_(1.702f * glu) * (lin + 1.0f);
                    }
                u32x4 ov = {cvt_pk(o[0], o[1]), cvt_pk(o[2], o[3]), cvt_pk(o[4], o[5]), cvt_pk(o[6], o[7])};
                *(u32x4*)(ACT + (size_t)(u.arow + rl) * 1024 + cb) = ov;
            }
    }
};
struct EpiMoe2 {
    static constexpr bool PERM = false;
    float* H; bf16_t* HB; const float* b2; const int* list; const float* gate; int slot;
    DI void operator()(const AccT& acc, const Unit& u, int wr, int wc, int fr, int fq) const {
        const int e = u.g & 31, col0 = u.pn * BM + wc * 32 + 4 * fq;
        f32x4 bv[2][2];
#pragma unroll
        for (int bj = 0; bj < 2; ++bj)
#pragma unroll
            for (int n = 0; n < 2; ++n) bv[bj][n] = *(const f32x4*)(b2 + (size_t)e * 1024 + col0 + bj * HALF + n * 16);
        const int* lp = list + (size_t)u.g * 65536 + (size_t)u.pm * 256;
#pragma unroll
        for (int ai = 0; ai < 2; ++ai)
#pragma unroll
            for (int m = 0; m < 4; ++m) {
                const int rl = ai * HALF + wr * 64 + m * 16 + fr;
                if (rl < u.cnt) {
                    const int tok = lp[rl]; const float gt = gate[(size_t)tok * 4 + slot];
                    float* hp = H + (size_t)tok * 1024 + col0;
#pragma unroll
                    for (int bj = 0; bj < 2; ++bj)
#pragma unroll
                        for (int n = 0; n < 2; ++n) {
                            f32x4 hv = *(const f32x4*)(hp + bj * HALF + n * 16);
                            hv = hv + gt * (acc[ai][bj][m][n] + bv[bj][n]);
                            *(f32x4*)(hp + bj * HALF + n * 16) = hv;
                            if (slot == 3) { u32x2 o = {cvt_pk(hv[0], hv[1]), cvt_pk(hv[2], hv[3])}; *(u32x2*)(HB + (size_t)tok * 1024 + col0 + bj * HALF + n * 16) = o; }
                        }
                }
            }
    }
};
struct EpiPle {
    static constexpr bool PERM = true;
    bf16_t* EB; float* ESS;
    DI void operator()(const AccT& acc, const Unit& u, int wr, int wc, int fr, int fq) const {
        const int row0 = u.pm * BM + wr * 64 + fr, col0 = u.pn * BM + wc * 32 + 8 * fq;
#pragma unroll
        for (int ai = 0; ai < 2; ++ai)
#pragma unroll
            for (int m = 0; m < 4; ++m) { const int row = row0 + ai * HALF + m * 16; bf16_t* rowp = EB + (size_t)row * 1024 + col0; float ss = 0.f;
#pragma unroll
                for (int bj = 0; bj < 2; ++bj) { const f32x4 v0 = acc[ai][bj][m][0], v1 = acc[ai][bj][m][1];
                    ss += v0[0] * v0[0] + v0[1] * v0[1] + v0[2] * v0[2] + v0[3] * v0[3] + v1[0] * v1[0] + v1[1] * v1[1] + v1[2] * v1[2] + v1[3] * v1[3];
                    u32x4 o = {cvt_pk(v0[0], v0[1]), cvt_pk(v0[2], v0[3]), cvt_pk(v1[0], v1[1]), cvt_pk(v1[2], v1[3])}; *(u32x4*)(rowp + bj * HALF) = o; }
                ss += __shfl_xor(ss, 16); ss += __shfl_xor(ss, 32);
                if (fq == 0) atomicAdd(ESS + row, ss);
            }
    }
};
struct EpiFinal {
    static constexpr bool PERM = false;
    float* H; const bf16_t* EB; const float* ESS; const float* g;
    DI void operator()(const AccT& acc, const Unit& u, int wr, int wc, int fr, int fq) const {
        const int row0 = u.pm * BM + wr * 64 + fr, col0 = u.pn * BM + wc * 32 + 4 * fq;
        f32x4 gv[2][2];
#pragma unroll
        for (int bj = 0; bj < 2; ++bj)
#pragma unroll
            for (int n = 0; n < 2; ++n) gv[bj][n] = *(const f32x4*)(g + col0 + bj * HALF + n * 16);
#pragma unroll
        for (int ai = 0; ai < 2; ++ai)
#pragma unroll
            for (int m = 0; m < 4; ++m) { const int row = row0 + ai * HALF + m * 16; const size_t ro = (size_t)row * 1024 + col0;
                const float rinv = __builtin_amdgcn_rsqf(ESS[row] * (1.f / 1024.f) + NORM_EPS);
#pragma unroll
                for (int bj = 0; bj < 2; ++bj)
#pragma unroll
                    for (int n = 0; n < 2; ++n) {
                        const size_t o = ro + bj * HALF + n * 16;
                        const u32x2 eb = *(const u32x2*)(EB + o); const f32x4 hv = *(const f32x4*)(H + o); const f32x4 a = acc[ai][bj][m][n];
                        f32x4 r;
                        r[0] = hv[0] + bf_lo(eb[0]) * rinv * gv[bj][n][0] * sigmoidf_(a[0]);
                        r[1] = hv[1] + bf_hi(eb[0]) * rinv * gv[bj][n][1] * sigmoidf_(a[1]);
                        r[2] = hv[2] + bf_lo(eb[1]) * rinv * gv[bj][n][2] * sigmoidf_(a[2]);
                        r[3] = hv[3] + bf_hi(eb[1]) * rinv * gv[bj][n][3] * sigmoidf_(a[3]);
                        *(f32x4*)(H + o) = r;
                    }
            }
    }
};

DI void moe_tables(LAS unsigned char* lds, const unsigned* cnt_g) {
    LAS int* cntL = (LAS int*)(lds + LDS_GRP); LAS int* pre = cntL + 128;
    __syncthreads();
    if (threadIdx.x < 128) cntL[threadIdx.x] = (int)cnt_g[threadIdx.x];
    __syncthreads();
    if (threadIdx.x == 0) { int s = 0; for (int g = 0; g < 128; ++g) { pre[g] = s; s += (cntL[g] + 255) >> 8; } pre[128] = s; }
    __syncthreads();
}
template <int NT, bool GATHER_>
struct MoeOrder {
    static constexpr bool GATHER = GATHER_;
    const char* A; const char* B; size_t bexp; int g0, ng, G, c; LAS unsigned char* lds; const int* list;
    DI bool next(int i, Unit& u) const {
        LAS int* cntL = (LAS int*)(lds + LDS_GRP); LAS int* pre = cntL + 128;
        const int L = i * G + c; const int base = __builtin_amdgcn_readfirstlane(pre[g0]), tot = __builtin_amdgcn_readfirstlane(pre[g0 + ng]) - base;
        const int rbg = L / NT; if (rbg >= tot) return false;
        const int ra = rbg + base; int lo = g0, hi = g0 + ng;
        while (hi - lo > 1) { const int mid = (lo + hi) >> 1; const int pm_ = __builtin_amdgcn_readfirstlane(pre[mid]); if (pm_ <= ra) lo = mid; else hi = mid; }
        const int g = lo, pg = __builtin_amdgcn_readfirstlane(pre[g]), rb = ra - pg, cg = __builtin_amdgcn_readfirstlane(cntL[g]);
        u.g = g; u.pm = rb; u.pn = L % NT; u.cnt = (cg - rb * 256) < 256 ? (cg - rb * 256) : 256; u.arow = ra * 256;
        u.A = GATHER ? A : A + (size_t)u.arow * 2048; u.B = B + (size_t)(g & 31) * bexp + (size_t)u.pn * (256 * 2048);
        return true;
    }
    DI void issue_table(const Unit& u, LAS unsigned char* tab) const {
        if (threadIdx.x < 256) { const int wid = __builtin_amdgcn_readfirstlane(threadIdx.x >> 6);
            __builtin_amdgcn_global_load_lds((const unsigned*)(list + (size_t)u.g * 65536 + (size_t)u.pm * 256 + threadIdx.x), (LAS unsigned*)(tab + wid * 256), 4, 0, 0); }
    }
    DI unsigned row_off(const Unit& u, LAS unsigned char* tab, int r) const { const unsigned t = *(const LAS unsigned*)(tab + r * 4); return (r < u.cnt) ? t * 2048u : 0u; }
};

DI void phase_qknorm(const Params& P) {
    bf16_t* Z = (bf16_t*)(P.ws + WS_Z);
    const int t = threadIdx.x & 127, grp = t >> 3, sub = t & 7;
    const bool isq = grp < 8;
    const int col = (isq ? ZQ : ZKK) + (grp & 7) * 64 + sub * 8;
    const float* gp = (isq ? P.da_q_norm_g : P.da_k_norm_g) + sub * 8;
    float g[8];
#pragma unroll
    for (int j = 0; j < 8; ++j) g[j] = gp[j] * (isq ? (0.125f * LOG2E) : 1.0f);
    for (int tok = blockIdx.x * 4 + (threadIdx.x >> 7); tok < MTOK; tok += gridDim.x * 4) {
        bf16_t* zp = Z + (size_t)tok * IN_COLS + col;
        const u32x4 v = *(const u32x4*)zp;
        float f[8] = {bf_lo(v[0]), bf_hi(v[0]), bf_lo(v[1]), bf_hi(v[1]), bf_lo(v[2]), bf_hi(v[2]), bf_lo(v[3]), bf_hi(v[3])};
        float ss = 0.f;
#pragma unroll
        for (int j = 0; j < 8; ++j) ss += f[j] * f[j];
        ss += __shfl_xor(ss, 1); ss += __shfl_xor(ss, 2); ss += __shfl_xor(ss, 4);
        const float rinv = __builtin_amdgcn_rsqf(ss * (1.f / 64.f) + NORM_EPS);
        u32x4 o = {cvt_pk(f[0] * rinv * g[0], f[1] * rinv * g[1]), cvt_pk(f[2] * rinv * g[2], f[3] * rinv * g[3]),
                   cvt_pk(f[4] * rinv * g[4], f[5] * rinv * g[5]), cvt_pk(f[6] * rinv * g[6], f[7] * rinv * g[7])};
        *(u32x4*)zp = o;
    }
}

constexpr int LDS_RT_SEL = STAGE_BYTES;
DI void phase_route(const Params& P, LAS unsigned char* lds) {
    LAS float* wT = (LAS float*)lds;
    LAS int* sel_e = (LAS int*)(lds + LDS_RT_SEL); LAS float* sel_g = (LAS float*)(sel_e + 1024); LAS int* lpos = (LAS int*)(sel_g + 1024);
    LAS int* lcnt = lpos + 1024; LAS int* lbase = lcnt + 128;
    const int tid = threadIdx.x, wid = tid >> 6, lane = tid & 63;
    const float* H = P.out; bf16_t* Mb = (bf16_t*)(P.ws + WS_U);
    unsigned* cnt_g = (unsigned*)(P.ws + WS_CTL) + CW_CNT; int* list = (int*)(P.ws + WS_LIST); float* gate = (float*)(P.ws + WS_GATE);
    __syncthreads();
    for (int i = tid; i < 1024 * 32; i += 512) { const int k = i >> 5, e = i & 31; wT[e * 1024 + k] = P.w_router[i]; }
    __syncthreads();
    f32x4 g[4];
#pragma unroll
    for (int i = 0; i < 4; ++i) g[i] = *(const f32x4*)(P.norm_ffn_g + 4 * lane + 256 * i);
    int erev = 0;
#pragma unroll
    for (int b = 0; b < 5; ++b) erev |= ((lane >> b) & 1) << (4 - b);
    const float brt = P.b_router[erev];
    for (int blk = blockIdx.x; blk < MTOK / 256; blk += gridDim.x) {
        if (tid < 128) lcnt[tid] = 0;
        for (int rp = 0; rp < 32; ++rp) {
            const int r0 = wid * 32 + rp;
            f32x4 mv[4];
            {
                const int row = blk * 256 + r0; const float* hr = H + (size_t)row * 1024; float ss = 0.f; f32x4 v[4];
#pragma unroll
                for (int i = 0; i < 4; ++i) { v[i] = *(const f32x4*)(hr + 4 * lane + 256 * i); ss += v[i][0] * v[i][0] + v[i][1] * v[i][1] + v[i][2] * v[i][2] + v[i][3] * v[i][3]; }
                ss = wave_sum(ss);
                const float rinv = __builtin_amdgcn_rsqf(ss * (1.f / 1024.f) + NORM_EPS);
#pragma unroll
                for (int i = 0; i < 4; ++i) { mv[i] = v[i] * rinv * g[i];
                    u32x2 o = {cvt_pk(mv[i][0], mv[i][1]), cvt_pk(mv[i][2], mv[i][3])}; *(u32x2*)(Mb + (size_t)row * 1024 + 4 * lane + 256 * i) = o; }
            }
            float acc[32];
#pragma unroll
            for (int e = 0; e < 32; ++e) {
                float a0 = 0.f;
#pragma unroll
                for (int i = 0; i < 4; ++i) { const f32x4 w = *(const LAS f32x4*)(wT + e * 1024 + 256 * i + 4 * lane);
                    a0 += mv[i][0] * w[0] + mv[i][1] * w[1] + mv[i][2] * w[2] + mv[i][3] * w[3]; }
                acc[e] = a0;
            }
            {
#define TR_STAGE(HN, DD) do { const bool up = (lane & (DD)) != 0; _Pragma("unroll") for (int i = 0; i < (HN); ++i) { \
                    const float keep = up ? acc[i + (HN)] : acc[i], send = up ? acc[i] : acc[i + (HN)]; acc[i] = keep + __shfl_xor(send, (DD)); } } while (0)
                TR_STAGE(16, 1); TR_STAGE(8, 2); TR_STAGE(4, 4); TR_STAGE(2, 8); TR_STAGE(1, 16);
#undef TR_STAGE
                float v = acc[0] + __shfl_xor(acc[0], 32) + brt;
                float tv[4]; int te[4];
#pragma unroll
                for (int k = 0; k < 4; ++k) {
                    float mx = v;
#pragma unroll
                    for (int o = 32; o >= 1; o >>= 1) mx = fmaxf(mx, __shfl_xor(mx, o));
                    int ce = (v == mx) ? erev : 99;
#pragma unroll
                    for (int o = 32; o >= 1; o >>= 1) ce = min(ce, __shfl_xor(ce, o));
                    tv[k] = mx; te[k] = ce; if (erev == ce) v = -3.0e38f;
                }
                const float e1 = __expf(tv[1] - tv[0]), e2 = __expf(tv[2] - tv[0]), e3 = __expf(tv[3] - tv[0]); const float inv = 1.f / (1.f + e1 + e2 + e3);
                if (lane == 0) { const int r = r0; sel_e[r * 4 + 0] = te[0]; sel_e[r * 4 + 1] = te[1]; sel_e[r * 4 + 2] = te[2]; sel_e[r * 4 + 3] = te[3];
                    sel_g[r * 4 + 0] = inv; sel_g[r * 4 + 1] = e1 * inv; sel_g[r * 4 + 2] = e2 * inv; sel_g[r * 4 + 3] = e3 * inv; }
            }
        }
        __syncthreads();
        if (tid < 256) {
#pragma unroll
            for (int s = 0; s < 4; ++s) lpos[tid * 4 + s] = atomicAdd((int*)&lcnt[s * 32 + sel_e[tid * 4 + s]], 1);
        }
        __syncthreads();
        if (tid < 128) lbase[tid] = (int)atomicAdd(cnt_g + tid, (unsigned)lcnt[tid]);
        __syncthreads();
        if (tid < 256) { const int tok = blk * 256 + tid;
#pragma unroll
            for (int s = 0; s < 4; ++s) { const int gi = s * 32 + sel_e[tid * 4 + s]; list[(size_t)gi * 65536 + lbase[gi] + lpos[tid * 4 + s]] = tok; gate[(size_t)tok * 4 + s] = sel_g[tid * 4 + s]; }
        }
        __syncthreads();
    }
}

constexpr int AT_V = 0, AT_K = 32768, AT_WS = 65536;
#define KSWZ(row, colB) ((row) * 256 + ((colB) ^ (((row) & 7) << 4)))
DI int crow(int r, int hi) { return (r & 3) + 8 * (r >> 2) + 4 * hi; }
DI int v_st(int k, int c) { const int kk = (k & ~0xC) | ((k & 4) << 1) | ((k & 8) >> 1); return ((kk >> 3) * 4 + (c >> 5)) * 512 + ((kk & 7) * 32 + (c & 31)) * 2; }
DI int v_rd_base(int lane) { return ((lane & 3) << 3) | (((lane >> 2) & 3) << 6) | (((lane >> 4) & 1) << 5) | (((lane >> 5) & 1) << 8); }
constexpr int v_rd_off(int d0, int ks, int half) { return d0 * 512 + ks * 4096 + half * 2048; }
template <int OFF> DI s16x4 tr_read(int vb) { s16x4 r; asm volatile("ds_read_b64_tr_b16 %0, %1 offset:%2" : "=&v"(r) : "v"(vb), "i"(OFF) : "memory"); return r; }
#define AT_PK(L, H) (bf16x8){L[0], L[1], L[2], L[3], H[0], H[1], H[2], H[3]}
template <int D0> DI void pv_one(f32x16& od, int vb, bf16x8 pa0, bf16x8 pa1, bf16x8 pa2, bf16x8 pa3) {
    const s16x4 l0 = tr_read<v_rd_off(D0, 0, 0)>(vb), h0 = tr_read<v_rd_off(D0, 0, 1)>(vb), l1 = tr_read<v_rd_off(D0, 1, 0)>(vb), h1 = tr_read<v_rd_off(D0, 1, 1)>(vb);
    const s16x4 l2 = tr_read<v_rd_off(D0, 2, 0)>(vb), h2 = tr_read<v_rd_off(D0, 2, 1)>(vb), l3 = tr_read<v_rd_off(D0, 3, 0)>(vb), h3 = tr_read<v_rd_off(D0, 3, 1)>(vb);
    asm volatile("s_waitcnt lgkmcnt(0)" ::: "memory"); __builtin_amdgcn_sched_barrier(0);
    od = __builtin_amdgcn_mfma_f32_32x32x16_bf16(pa0, AT_PK(l0, h0), od, 0, 0, 0);
    od = __builtin_amdgcn_mfma_f32_32x32x16_bf16(pa1, AT_PK(l1, h1), od, 0, 0, 0);
    od = __builtin_amdgcn_mfma_f32_32x32x16_bf16(pa2, AT_PK(l2, h2), od, 0, 0, 0);
    od = __builtin_amdgcn_mfma_f32_32x32x16_bf16(pa3, AT_PK(l3, h3), od, 0, 0, 0);
}
DI void at_softmax(f32x16& p0, f32x16& p1, float& l_reg, bf16x8& pa0, bf16x8& pa1, bf16x8& pa2, bf16x8& pa3) {
#pragma unroll
    for (int r = 0; r < 16; ++r) { p0[r] = __builtin_amdgcn_exp2f(p0[r]); p1[r] = __builtin_amdgcn_exp2f(p1[r]); }
    float ps = 0.f;
#pragma unroll
    for (int r = 0; r < 16; ++r) ps += p0[r] + p1[r];
    l_reg += ps;
#define AT_PK4(Pv, BASE, OUT) do { unsigned a0 = cvt_pk(Pv[BASE + 0], Pv[BASE + 1]), a1 = cvt_pk(Pv[BASE + 2], Pv[BASE + 3]); \
    unsigned b0 = cvt_pk(Pv[BASE + 4], Pv[BASE + 5]), b1 = cvt_pk(Pv[BASE + 6], Pv[BASE + 7]); \
    auto r0 = __builtin_amdgcn_permlane32_swap(a0, b0, false, false); auto r1 = __builtin_amdgcn_permlane32_swap(a1, b1, false, false); \
    u32x4 w = {r0[0], r1[0], r0[1], r1[1]}; OUT = __builtin_bit_cast(bf16x8, w); } while (0)
    AT_PK4(p0, 0, pa0); AT_PK4(p0, 8, pa1); AT_PK4(p1, 0, pa2); AT_PK4(p1, 8, pa3);
#undef AT_PK4
}

DI void attn_unit(const Params& P, unsigned char* lds, int b, int h, int qb, float lam, float smax2, int W) {
    int tid_ = threadIdx.x; asm volatile("" : "+v"(tid_));
    const int tid = tid_, wid = tid >> 6, lane = tid & 63, r32 = lane & 31, hi = lane >> 5, grp = wid >> 1, c = wid & 1;
    const bf16_t* Zb = (const bf16_t*)(P.ws + WS_Z) + (size_t)b * SEQ * IN_COLS;
    const int i0 = qb * 128, qi = i0 + grp * 32 + r32;
    const float slope2 = exp2f(-2.0f * (float)(h + 1)) * LOG2E;
    bf16x8 qr[4];
    { const bf16_t* qp = Zb + (size_t)qi * IN_COLS + ZQ + h * 128 + c * 64 + hi * 8;
#pragma unroll
      for (int d0 = 0; d0 < 4; ++d0) qr[d0] = *(const bf16x8*)(qp + d0 * 16); }
    const bf16_t* Kh = Zb + ZKK + h * 128; const bf16_t* Vh = Zb + ZVV + h * 128;
    const int sr = tid >> 4, sc = (tid & 15) * 8, vst0 = v_st(sr, sc), vst1 = v_st(32 + sr, sc);
    const int vb0 = (int)(uintptr_t)(lds + AT_V) + v_rd_base(lane);
    int jlo = i0 - W; if (jlo < 0) jlo = 0; jlo >>= 6;
    int jhi = i0 + 127 + W; if (jhi > SEQ - 1) jhi = SEQ - 1; jhi >>= 6;
    const int NT = jhi - jlo + 1;
    f32x16 o[4];
#pragma unroll
    for (int d = 0; d < 4; ++d)
#pragma unroll
        for (int r = 0; r < 16; ++r) o[d][r] = 0.f;
    float l = 0.f;
    bf16x8 vs0, vs1, ks0, ks1;
#define AT_LOAD(k0) do { vs0 = *(const bf16x8*)(Vh + (size_t)((k0) + sr) * IN_COLS + sc); vs1 = *(const bf16x8*)(Vh + (size_t)((k0) + 32 + sr) * IN_COLS + sc); \
    ks0 = *(const bf16x8*)(Kh + (size_t)((k0) + sr) * IN_COLS + sc); ks1 = *(const bf16x8*)(Kh + (size_t)((k0) + 32 + sr) * IN_COLS + sc); } while (0)
#define AT_WRITE(bf) do { *(bf16x8*)(lds + AT_V + (bf) * 16384 + vst0) = vs0; *(bf16x8*)(lds + AT_V + (bf) * 16384 + vst1) = vs1; \
    *(bf16x8*)(lds + AT_K + (bf) * 16384 + KSWZ(sr, sc * 2)) = ks0; *(bf16x8*)(lds + AT_K + (bf) * 16384 + KSWZ(32 + sr, sc * 2)) = ks1; } while (0)
    __syncthreads();
    AT_LOAD(jlo * 64); AT_WRITE(0); __syncthreads();
    for (int j = 0; j < NT; ++j) {
        const int buf = j & 1, j0 = (jlo + j) * 64;
        if (j + 1 < NT) AT_LOAD(j0 + 64);
        const unsigned char* Ks = lds + AT_K + buf * 16384;
        const float x = (float)(qi - j0 - 4 * hi);
        f32x16 p0, p1;
#pragma unroll
        for (int r = 0; r < 16; ++r) { const float c0 = (float)((r & 3) + 8 * (r >> 2));
            p0[r] = fmaf(fabsf(x - c0), -slope2, -smax2); p1[r] = fmaf(fabsf(x - (c0 + 32.f)), -slope2, -smax2); }
#pragma unroll
        for (int d0 = 0; d0 < 4; ++d0) { const int cb = (c * 64 + d0 * 16 + hi * 8) * 2;
            const bf16x8 k0 = *(const bf16x8*)(Ks + KSWZ(r32, cb)), k1 = *(const bf16x8*)(Ks + KSWZ(32 + r32, cb));
            p0 = __builtin_amdgcn_mfma_f32_32x32x16_bf16(k0, qr[d0], p0, 0, 0, 0);
            p1 = __builtin_amdgcn_mfma_f32_32x32x16_bf16(k1, qr[d0], p1, 0, 0, 0); }
        bf16x8 pa0, pa1, pa2, pa3;
        at_softmax(p0, p1, l, pa0, pa1, pa2, pa3);
        const int vb = vb0 + buf * 16384;
        pv_one<0>(o[0], vb, pa0, pa1, pa2, pa3); pv_one<1>(o[1], vb, pa0, pa1, pa2, pa3); pv_one<2>(o[2], vb, pa0, pa1, pa2, pa3); pv_one<3>(o[3], vb, pa0, pa1, pa2, pa3);
        if (j + 1 < NT) AT_WRITE(buf ^ 1);
        __syncthreads();
    }
#undef AT_LOAD
#undef AT_WRITE
    l += __shfl_xor(l, 32);
    float* wsf = (float*)(lds + AT_WS) + wid * 32;
    float* exch = (float*)lds + grp * 4096;
    if (hi == 0) wsf[r32] = l;
    asm volatile("s_waitcnt lgkmcnt(0)" ::: "memory");
    float rl[16];
#pragma unroll
    for (int r = 0; r < 16; ++r) rl[r] = __builtin_amdgcn_rcpf(wsf[crow(r, hi)]) * (c ? lam : 1.0f);
    if (c == 1) {
#pragma unroll
        for (int d = 0; d < 4; ++d)
#pragma unroll
            for (int r = 0; r < 16; ++r) exch[(d * 16 + r) * 64 + lane] = o[d][r] * rl[r];
    }
    __syncthreads();
    if (c == 0) {
        float ss[16];
#pragma unroll
        for (int r = 0; r < 16; ++r) { float sacc = 0.f;
#pragma unroll
            for (int d = 0; d < 4; ++d) { const float v = o[d][r] * rl[r] - exch[(d * 16 + r) * 64 + lane]; o[d][r] = v; sacc += v * v; }
            ss[r] = sacc; }
#pragma unroll
        for (int r = 0; r < 16; ++r) {
#pragma unroll
            for (int m = 16; m >= 1; m >>= 1) ss[r] += __shfl_xor(ss[r], m);
        }
        bf16_t* Ob = (bf16_t*)(P.ws + WS_O) + (size_t)(b * SEQ + i0 + grp * 32) * 1024 + C_RW + h * 128;
        float sg[4];
#pragma unroll
        for (int d = 0; d < 4; ++d) sg[d] = P.da_subln_g[d * 32 + r32] * 0.8f;
#pragma unroll
        for (int r = 0; r < 16; ++r) { const float rn = __builtin_amdgcn_rsqf(ss[r] * (1.f / 128.f) + NORM_EPS); bf16_t* op = Ob + (size_t)crow(r, hi) * 1024 + r32;
#pragma unroll
            for (int d = 0; d < 4; ++d) op[d * 32] = f2bf(o[d][r] * rn * sg[d]); }
    }
}

constexpr int RW_W2T = 0, RW_A2T = 2 * 64 * 72 * 2, RW_G2T = 4 * 64 * 72 * 2;
constexpr int RW_XA = RW_G2T + 64 * 136 * 2;
constexpr int RW_LORA = RW_XA + 11264;
constexpr int RW_YP = RW_LORA + 16384;
constexpr int RW_ZS = RW_YP + 32768;
constexpr int RW_STEP = RW_ZS + 12288;
constexpr int RW_SAX = RW_STEP + 16384;
constexpr int RW_END = RW_SAX + 4096;

DI void rwkv_task(const Params& P, unsigned char* lds, int b, int h) {
    int tid_ = threadIdx.x; asm volatile("" : "+v"(tid_));
    const int tid = tid_, wid = tid >> 6, lane = tid & 63;
    const bf16_t* Zb = (const bf16_t*)(P.ws + WS_Z) + (size_t)b * SEQ * IN_COLS;
    float* Ysc = (float*)(P.ws + WS_U) + (size_t)b * SEQ * 512 + h * 64;
    bf16_t* Ob = (bf16_t*)(P.ws + WS_O) + (size_t)b * SEQ * 1024 + h * 64;
    const int hc = h * 64;
    __syncthreads();
    for (int i = tid; i < 2 * 64 * 64; i += 512) { const int d = i >> 12, r = (i >> 6) & 63, c = i & 63;
        ((bf16_t*)(lds + RW_W2T))[(d * 64 + c) * 72 + r] = f2bf(P.rw_w2[(size_t)(d * 64 + r) * 512 + hc + c]);
        ((bf16_t*)(lds + RW_A2T))[(d * 64 + c) * 72 + r] = f2bf(P.rw_a2[(size_t)(d * 64 + r) * 512 + hc + c]); }
    for (int i = tid; i < 128 * 64; i += 512) { const int r = i >> 6, c = i & 63; ((bf16_t*)(lds + RW_G2T))[c * 136 + r] = f2bf(P.rw_g2[(size_t)r * 512 + hc + c]); }
    float S[2][8];
#pragma unroll
    for (int d = 0; d < 2; ++d)
#pragma unroll
        for (int i = 0; i < 8; ++i) S[d][i] = 0.f;
    float* zs = (float*)(lds + RW_ZS); float* st = (float*)(lds + RW_STEP); float* lora = (float*)(lds + RW_LORA); float* sax = (float*)(lds + RW_SAX); float* yp_l = (float*)(lds + RW_YP);
    bf16_t* xa = (bf16_t*)(lds + RW_XA);
    const float kk_c = P.rw_k_k[hc + lane], ka_c = P.rw_k_a[hc + lane], rk_c = P.rw_r_k[hc + lane], lng_c = P.rw_ln_g[hc + lane], lnb_c = P.rw_ln_b[hc + lane];
    for (int s = 0; s < SEQ / 16; ++s) {
        const bool fin = s >= SEQ / 32;
#pragma unroll
        for (int d = 0; d < 2; ++d) {
            const int c16 = d ? (SEQ / 16 - 1 - s) : s;
            const float w0_c = P.rw_w0[d * 512 + hc + lane], a0_c = P.rw_a0[d * 512 + hc + lane], a0o_c = P.rw_a0[(1 - d) * 512 + hc + lane];
            __syncthreads();
            for (int it = tid; it < 16 * 64; it += 512) {
                const int i = it >> 6, cg = it & 63;
                if (!fin && cg >= 40) continue;
                const int t = d ? (c16 * 16 + 15 - i) : (c16 * 16 + i);
                int col; if (cg < 8) col = ZR + hc + cg * 8; else if (cg < 16) col = ZK + hc + (cg - 8) * 8; else if (cg < 24) col = ZV + hc + (cg - 16) * 8;
                else if (cg < 32) col = ZWD + d * 64 + (cg - 24) * 8; else if (cg < 40) col = ZAD + d * 64 + (cg - 32) * 8; else if (cg < 48) col = ZAD + (1 - d) * 64 + (cg - 40) * 8; else col = ZGD + (cg - 48) * 8;
                const bf16_t* zp = Zb + (size_t)t * IN_COLS + col;
                const u32x4 vc = *(const u32x4*)zp; u32x4 vp = {0u, 0u, 0u, 0u}, vn = {0u, 0u, 0u, 0u};
                if (t > 0) vp = *(const u32x4*)(zp - IN_COLS);
                if (t < SEQ - 1) vn = *(const u32x4*)(zp + IN_COLS);
                const f32x4 mu0 = *(const f32x4*)(P.rw_mu + col), mu1 = *(const f32x4*)(P.rw_mu + col + 4);
                float f[8];
#pragma unroll
                for (int q = 0; q < 4; ++q) {
                    const float c0 = bf_lo(vc[q]), c1 = bf_hi(vc[q]);
                    const float m0 = q < 2 ? mu0[2 * q] : mu1[2 * q - 4], m1 = q < 2 ? mu0[2 * q + 1] : mu1[2 * q - 3];
                    f[2 * q] = c0 + (0.5f * (bf_lo(vp[q]) + bf_lo(vn[q])) - c0) * m0; f[2 * q + 1] = c1 + (0.5f * (bf_hi(vp[q]) + bf_hi(vn[q])) - c1) * m1;
                }
                if (cg < 24) { float* dst = zs + ((cg >> 3) * 16 + i) * 64 + (cg & 7) * 8;
#pragma unroll
                    for (int q = 0; q < 8; ++q) dst[q] = f[q]; }
                else {
                    bf16_t* dst;
                    if (cg < 32) { dst = xa + i * 72 + (cg - 24) * 8;
#pragma unroll
                        for (int q = 0; q < 8; ++q) f[q] = tanhf(f[q]); }
                    else if (cg < 40) dst = xa + 1152 + i * 72 + (cg - 32) * 8;
                    else if (cg < 48) dst = xa + 2304 + i * 72 + (cg - 40) * 8;
                    else { dst = xa + 3456 + i * 136 + (cg - 48) * 8;
#pragma unroll
                        for (int q = 0; q < 8; ++q) f[q] = sigmoidf_(f[q]); }
                    u32x4 ov = {cvt_pk(f[0], f[1]), cvt_pk(f[2], f[3]), cvt_pk(f[4], f[5]), cvt_pk(f[6], f[7])}; *(u32x4*)dst = ov;
                }
            }
            __syncthreads();
            for (int job = wid; job < (fin ? 16 : 8); job += 8) {
                const int mat = job >> 2, nt = job & 3, fr = lane & 15, fq = lane >> 4;
                const bf16_t* X = xa + (mat == 0 ? 0 : mat == 1 ? 1152 : mat == 2 ? 2304 : 3456); const int xs = mat == 3 ? 136 : 72;
                const bf16_t* Wt = (const bf16_t*)(lds + (mat == 0 ? RW_W2T + d * 64 * 72 * 2 : mat == 1 ? RW_A2T + d * 64 * 72 * 2 : mat == 2 ? RW_A2T + (1 - d) * 64 * 72 * 2 : RW_G2T));
                f32x4 acc = {0.f, 0.f, 0.f, 0.f};
                const int nks = mat == 3 ? 4 : 2;
                for (int ks = 0; ks < nks; ++ks) {
                    const bf16x8 af = *(const bf16x8*)(X + fr * xs + ks * 32 + fq * 8), bfm = *(const bf16x8*)(Wt + (nt * 16 + fr) * xs + ks * 32 + fq * 8);
                    acc = __builtin_amdgcn_mfma_f32_16x16x32_bf16(af, bfm, acc, 0, 0, 0);
                }
#pragma unroll
                for (int j = 0; j < 4; ++j) lora[(mat * 16 + fq * 4 + j) * 64 + nt * 16 + fr] = acc[j];
            }
            __syncthreads();
#pragma unroll
            for (int q = 0; q < 2; ++q) { const int i = wid * 2 + q, c = lane;
                const float wl = w0_c + lora[(0 * 16 + i) * 64 + c];
                const float sp = fmaxf(-wl, 0.f) + log1pf(__expf(-fabsf(wl)));
                const float decay = __expf(-__expf(-sp - 0.5f));
                const float a = sigmoidf_(a0_c + lora[(1 * 16 + i) * 64 + c]);
                const float k = zs[(1 * 16 + i) * 64 + c]; float kk = k * kk_c;
                const float n2 = wave_sum(kk * kk); kk *= __builtin_amdgcn_rsqf(n2 + 1e-12f);
                st[(0 * 16 + i) * 64 + c] = decay; st[(1 * 16 + i) * 64 + c] = k * (1.f + (a - 1.f) * ka_c); st[(2 * 16 + i) * 64 + c] = -kk; st[(3 * 16 + i) * 64 + c] = kk * a;
            }
            __syncthreads();
            for (int i = 0; i < 16; ++i) {
                const float* wv = st + (0 * 16 + i) * 64 + wid * 8; const float* kdv = st + (1 * 16 + i) * 64 + wid * 8; const float* nav = st + (2 * 16 + i) * 64 + wid * 8; const float* bv = st + (3 * 16 + i) * 64 + wid * 8;
                const float* rv = zs + (0 * 16 + i) * 64 + wid * 8; const float vv = zs[(2 * 16 + i) * 64 + lane];
                float sp = 0.f;
#pragma unroll
                for (int q = 0; q < 8; ++q) sp += S[d][q] * nav[q];
                float* sx = sax + (i & 1) * 512;
                sx[wid * 64 + lane] = sp;
                __syncthreads();
                float sa = 0.f;
#pragma unroll
                for (int w = 0; w < 8; ++w) sa += sx[w * 64 + lane];
                float yp = 0.f;
#pragma unroll
                for (int q = 0; q < 8; ++q) { S[d][q] = S[d][q] * wv[q] + sa * bv[q] + vv * kdv[q]; yp += S[d][q] * rv[q]; }
                yp_l[(wid * 16 + i) * 64 + lane] = yp;
            }
            __syncthreads();
#pragma unroll
            for (int q = 0; q < 2; ++q) { const int i = wid * 2 + q, c = lane; const int t = d ? (c16 * 16 + 15 - i) : (c16 * 16 + i);
                float y = 0.f;
#pragma unroll
                for (int w = 0; w < 8; ++w) y += yp_l[(w * 16 + i) * 64 + c];
                if (!fin) Ysc[(size_t)t * 512 + c] = y;
                else {
                    y += Ysc[(size_t)t * 512 + c];
                    const float mean = wave_sum(y) * (1.f / 64.f); const float dv = y - mean; const float var = wave_sum(dv * dv) * (1.f / 64.f);
                    const float gn = dv * __builtin_amdgcn_rsqf(var + 64e-5f) * lng_c + lnb_c;
                    const float a = sigmoidf_(a0_c + lora[(1 * 16 + i) * 64 + c]), ao = sigmoidf_(a0o_c + lora[(2 * 16 + i) * 64 + c]);
                    const float r = zs[(0 * 16 + i) * 64 + c], k = zs[(1 * 16 + i) * 64 + c], v = zs[(2 * 16 + i) * 64 + c];
                    const float kb = k * (1.f + (0.5f * (a + ao) - 1.f) * ka_c);
                    const float bon = wave_sum(r * kb * rk_c);
                    const float g = lora[(3 * 16 + i) * 64 + c];
                    Ob[(size_t)t * 1024 + c] = f2bf((gn + bon * v) * g);
                }
            }
        }
    }
}

DI void phase_mixer(const Params& P, unsigned char* lds) {
    const int lane = threadIdx.x & 63;
    const float lam = __expf(wave_sum(P.da_lq1[lane] * P.da_lk1[lane])) - __expf(wave_sum(P.da_lq2[lane] * P.da_lk2[lane])) + 0.2f;
    float mq = fabsf(P.da_q_norm_g[lane]), mk = fabsf(P.da_k_norm_g[lane]);
#pragma unroll
    for (int o = 32; o >= 1; o >>= 1) { mq = fmaxf(mq, __shfl_xor(mq, o)); mk = fmaxf(mk, __shfl_xor(mk, o)); }
    const float smax = 8.0f * mq * mk * 1.01f, smax2 = smax * LOG2E;
    unsigned* qhead = (unsigned*)(P.ws + WS_CTL) + CW_QUEUE;
    volatile unsigned* qw = (volatile unsigned*)(lds + LDS_QW);
    for (;;) {
        __syncthreads();
        if (threadIdx.x == 0) *qw = atomicAdd(qhead, 1u);
        __syncthreads();
        const unsigned idx = *qw;
        if (idx >= 64u + 2048u) break;
#if !defined(MIX_ONLY) || MIX_ONLY == 1
        if (idx < 64u) rwkv_task(P, lds, (int)(idx >> 3), (int)(idx & 7));
#endif
#if !defined(MIX_ONLY) || MIX_ONLY == 2
        if (idx >= 64u) { const unsigned u = idx - 64u; const int h = 3 - (int)(u >> 9), b = (int)((u >> 6) & 7), qb = (int)(u & 63);
            const float slope = exp2f(-2.0f * (float)(h + 1)); int W = (int)ceilf((25.65f + 2.0f * smax) / slope); if (W > SEQ) W = SEQ;
            attn_unit(P, lds, b, h, qb, lam, smax2, W); }
#endif
    }
}

constexpr int N_PHASES = 13;
__global__ void __launch_bounds__(512, 2) mega(Params P) {
    extern __shared__ __attribute__((aligned(16))) unsigned char shm[];
    LAS unsigned char* lds = (LAS unsigned char*)shm;
    unsigned char* ws = P.ws;
    if (threadIdx.x == 0) *(LAS u32x4*)(lds + LDS_XB) = (u32x4){0u, 0u, 0u, 0u};
    __syncthreads();
    XcdBarrier bar = xcd_barrier_post((unsigned*)(ws + WS_CTL) + CW_BAR + (size_t)P.ph_lo * 0, (volatile LAS unsigned*)(lds + LDS_XB));
#ifndef ONLY_PHASE
#define RUN(k) (P.ph_lo <= (k) && (k) < P.ph_hi)
#else
#define RUN(k) ((k) == ONLY_PHASE && P.ph_lo <= (k) && (k) < P.ph_hi)
#endif
#define SYNC(k) do { if (P.ph_lo <= (k) && (k) + 1 < P.ph_hi) xcd_barrier(bar); } while (0)
    if (RUN(0)) phase_prep(P, shm);
    SYNC(0);
    if (RUN(1)) { DenseOrder S; S.init(ws + WS_U, ws + WS_WIN, MTOK, IN_PAD, 2048, 2048); EpiZ E{(bf16_t*)(ws + WS_Z)}; gemm_phase<false>(lds, 1024, 1024, S, E); }
    SYNC(1);
    if (RUN(2)) phase_qknorm(P);
    SYNC(2);
    if (RUN(3)) phase_mixer(P, shm);
    SYNC(3);
    if (RUN(4)) { DenseOrder S; S.init(ws + WS_O, ws + WS_WOUT, MTOK, 1024, 2048, 2048); EpiH1 E{P.x, P.out}; gemm_phase<false>(lds, 1024, 1024, S, E); }
    SYNC(4);
    if (RUN(5)) phase_route(P, lds);
    SYNC(5);
    if (RUN(6)) { moe_tables(lds, (const unsigned*)(ws + WS_CTL) + CW_CNT);
        MoeOrder<8, true> S{(const char*)(ws + WS_U), (const char*)(ws + WS_W1), (size_t)2048 * 1024 * 2, 0, 128, (int)gridDim.x, (int)blockIdx.x, lds, (const int*)(ws + WS_LIST)};
        EpiMoe1 E{(bf16_t*)(ws + WS_Z), P.b1}; gemm_phase<false>(lds, 1024, 1024, S, E); }
    SYNC(6);
#define MOE2(k, s) if (RUN(k)) { moe_tables(lds, (const unsigned*)(ws + WS_CTL) + CW_CNT); \
        MoeOrder<4, false> S{(const char*)(ws + WS_Z), (const char*)(ws + WS_W2), (size_t)1024 * 1024 * 2, 32 * (s), 32, (int)gridDim.x, (int)blockIdx.x, lds, (const int*)(ws + WS_LIST)}; \
        EpiMoe2 E{P.out, (bf16_t*)(ws + WS_U), P.b2, (const int*)(ws + WS_LIST), (const float*)(ws + WS_GATE), (s)}; gemm_phase<false>(lds, 1024, 1024, S, E); } SYNC(k);
    MOE2(7, 0) MOE2(8, 1) MOE2(9, 2) MOE2(10, 3)
    if (RUN(11)) { DenseOrder S; S.init(ws + WS_PB, ws + WS_WPLE, MTOK, 1024, 512, 512); EpiPle E{(bf16_t*)(ws + WS_Z), (float*)(ws + WS_ESS)}; gemm_phase<true>(lds, 256, 256, S, E); }
    SYNC(11);
    if (RUN(12)) { DenseOrder S; S.init(ws + WS_U, ws + WS_WG, MTOK, 1024, 2048, 2048); EpiFinal E{P.out, (const bf16_t*)(ws + WS_Z), (const float*)(ws + WS_ESS), P.ple_norm_g}; gemm_phase<false>(lds, 1024, 1024, S, E); }
}

#ifndef MK_N_LAUNCHES
#define MK_N_LAUNCHES 13
#endif
extern "C" void kernel_launch(void* const* d_in, const int* in_sizes, int n_in, void* d_out, int out_size, void* d_ws, size_t ws_size, hipStream_t stream) {
    static int grid = 0;
    if (grid == 0) {
        if (n_in != 33 || in_sizes[0] != MTOK * D_MODEL || out_size != MTOK * D_MODEL || ws_size < WS_END) {
            fprintf(stderr, "kernel_launch: shape mismatch: n_in %d in0 %d out %d ws %zu (need %zu)\n", n_in, n_in > 0 ? in_sizes[0] : -1, out_size, ws_size, (size_t)WS_END); grid = -1; return; }
        int dev = 0, cus = 0, per_cu = 0;
        if (hipGetDevice(&dev) != hipSuccess || hipDeviceGetAttribute(&cus, hipDeviceAttributeMultiprocessorCount, dev) != hipSuccess) { grid = -1; return; }
        if (hipFuncSetAttribute((const void*)mega, hipFuncAttributeMaxDynamicSharedMemorySize, LDS_BYTES) != hipSuccess) { fprintf(stderr, "kernel_launch: hipFuncSetAttribute failed\n"); grid = -1; return; }
        if (hipOccupancyMaxActiveBlocksPerMultiprocessor(&per_cu, (const void*)mega, 512, LDS_BYTES) != hipSuccess || per_cu < 1) fprintf(stderr, "kernel_launch: occupancy query says %d\n", per_cu);
        (void)hipGetLastError();
        grid = cus;
    }
    if (grid < 0) return;
    (void)hipMemsetAsync((char*)d_ws + WS_CTL, 0, CTL_BYTES, stream);
    (void)hipMemsetAsync((char*)d_ws + WS_ESS, 0, (size_t)MTOK * 4, stream);
    Params p{};
    const float** f = (const float**)&p;
    for (int i = 0; i < 33; ++i) f[i] = (const float*)d_in[i];
    p.out = (float*)d_out; p.ws = (unsigned char*)d_ws;
    if (MK_N_LAUNCHES == 1) { p.ph_lo = 0; p.ph_hi = N_PHASES; hipLaunchKernelGGL(mega, dim3(grid), dim3(512), LDS_BYTES, stream, p); }
    else for (int k = 0; k < N_PHASES; ++k) { p.ph_lo = k; p.ph_hi = k + 1; hipLaunchKernelGGL(mega, dim3(grid), dim3(512), LDS_BYTES, stream, p); }
    const hipError_t le = hipPeekAtLastError();
    if (le != hipSuccess) fprintf(stderr, "kernel_launch: launch failed: %s\n", hipGetErrorName(le));
}
```

```cpp
#include <hip/hip_runtime.h>
#include <stdint.h>
#include <stdio.h>

#define LAS __attribute__((address_space(3)))
#define DI __device__ __forceinline__
typedef unsigned short bf16_t;
typedef short bf16x8 __attribute__((ext_vector_type(8)));
typedef short s16x4 __attribute__((ext_vector_type(4)));
typedef float f32x4 __attribute__((ext_vector_type(4)));
typedef float f32x2 __attribute__((ext_vector_type(2)));
typedef float f32x16 __attribute__((ext_vector_type(16)));
typedef unsigned u32x4 __attribute__((ext_vector_type(4)));
typedef unsigned u32x2 __attribute__((ext_vector_type(2)));
typedef __bf16 bf16x2_t __attribute__((ext_vector_type(2)));

constexpr int D_MODEL = 1024, BATCH = 8, SEQ = 8192, MTOK = BATCH * SEQ;
constexpr int PLE_DIM = 256;
constexpr int C_RW = 512, RW_HEAD = 64, RW_HEADS = 8, RW_COLS = 1920;
constexpr int C_DA = 512, DA_HEADS = 4, DA_V = 128, DA_QK = 64;
constexpr int IN_COLS = 3456, IN_PAD = 3584;
constexpr int N_EXP = 32, TOPK = 4, D_FF = 1024;
constexpr int ZR = 0, ZK = 512, ZV = 1024, ZWD = 1536, ZAD = 1664, ZGD = 1792, ZQ = 1920, ZKK = 2432, ZVV = 2944;
constexpr float NORM_EPS = 1e-6f;
constexpr float LOG2E = 1.4426950408889634f;

constexpr size_t MiB = 1024ull * 1024ull;
constexpr size_t WS_CTL = 0;
constexpr size_t CTL_BYTES = 64 * 1024;
constexpr size_t WS_WIN = WS_CTL + CTL_BYTES;
constexpr size_t WS_WOUT = WS_WIN + (size_t)IN_PAD * 1024 * 2;
constexpr size_t WS_W1 = WS_WOUT + 2 * MiB;
constexpr size_t WS_W2 = WS_W1 + 128 * MiB;
constexpr size_t WS_WPLE = WS_W2 + 64 * MiB;
constexpr size_t WS_WG = WS_WPLE + MiB / 2;
constexpr size_t WS_PB = WS_WG + 2 * MiB;
constexpr size_t WS_U = WS_PB + 32 * MiB;
constexpr size_t WS_Z = WS_U + 128 * MiB;
constexpr size_t WS_O = WS_Z + 432 * MiB;
constexpr size_t WS_LIST = WS_Z + 576 * MiB;
constexpr size_t WS_GATE = WS_LIST + 32 * MiB;
constexpr size_t WS_ESS = WS_GATE + MiB;
constexpr size_t WS_END = WS_ESS + MiB / 4;
constexpr int ACT_ROWS_MAX = 262144 + 128 * 256;

constexpr int CW_BAR = 0;
constexpr int CW_CNT = 4096;
constexpr int CW_QUEUE = 4352;
constexpr int CW_LAM = 4416;

struct Params {
    const float* x; const float* p; const float* norm_mix_g; const float* w_in; const float* rw_mu; const float* rw_w0; const float* rw_w2;
    const float* rw_a0; const float* rw_a2; const float* rw_g2; const float* rw_k_k; const float* rw_k_a; const float* rw_r_k; const float* rw_ln_g;
    const float* rw_ln_b; const float* da_q_norm_g; const float* da_k_norm_g; const float* da_lq1; const float* da_lk1; const float* da_lq2;
    const float* da_lk2; const float* da_subln_g; const float* w_out; const float* norm_ffn_g; const float* w_router; const float* b_router;
    const float* w1; const float* b1; const float* w2; const float* b2; const float* w_ple; const float* ple_norm_g; const float* w_ple_gate;
    float* out; unsigned char* ws; int ph_lo, ph_hi;
};

DI unsigned cvt_pk(float lo, float hi) { f32x2 v = {lo, hi}; bf16x2_t r = __builtin_convertvector(v, bf16x2_t); return __builtin_bit_cast(unsigned, r); }
DI float bf_lo(unsigned u) { return __uint_as_float(u << 16); }
DI float bf_hi(unsigned u) { return __uint_as_float(u & 0xffff0000u); }
DI float bf2f(bf16_t b) { return __uint_as_float(((unsigned)b) << 16); }
DI bf16_t f2bf(float f) { return (bf16_t)(cvt_pk(f, f) & 0xffffu); }
DI float wave_sum(float v) {
#pragma unroll
    for (int o = 32; o >= 1; o >>= 1) v += __shfl_xor(v, o);
    return v;
}
DI float sigmoidf_(float x) { return __builtin_amdgcn_rcpf(1.f + __builtin_amdgcn_exp2f(-x * LOG2E)); }

#define XB_TMO      128
#define XB_XCNT(j)  (256  + 64 * (j))
#define XB_XSUB(j)  (1280 + 64 * (j))
#define XB_XGEN(j)  (2304 + 64 * (j))
#define XB_TOP      3328
#define XB_TOPGEN   3392
#define XCD_BAR_WORDS 3456
#define XB_SPIN_CAP (1u << 22)
DI unsigned xb_ld(unsigned* p)              { return __hip_atomic_load(p, __ATOMIC_RELAXED, __HIP_MEMORY_SCOPE_AGENT); }
DI unsigned xb_add(unsigned* p, unsigned v) { return __hip_atomic_fetch_add(p, v, __ATOMIC_RELAXED, __HIP_MEMORY_SCOPE_AGENT); }
DI unsigned xb_xcc_id() { return (unsigned)__builtin_amdgcn_s_getreg((3 << 11) | 20) & 0xFu; }
#define XB_SPIN(cond, bar) do { unsigned _sp = 0; while (cond) { __builtin_amdgcn_s_sleep(1); \
    if ((++_sp & 255u) == 0u) { if (xb_ld(&(bar)[XB_TMO])) break; if (_sp > XB_SPIN_CAP) { atomicAdd(&(bar)[XB_TMO], 1u); break; } } } } while (0)
struct XcdBarrier { unsigned* bar; unsigned x; volatile LAS unsigned* st; };
DI XcdBarrier xcd_barrier_post(unsigned* bar, volatile LAS unsigned* st) {
    XcdBarrier b; b.bar = bar; b.x = xb_xcc_id(); b.st = st;
    if (threadIdx.x == 0) (void)xb_add(&bar[XB_XCNT(b.x)], 1u);
    return b;
}
DI void xcd_barrier_complete(unsigned* bar, unsigned x, unsigned& nloc, unsigned& nx) {
    const unsigned G = gridDim.x * gridDim.y * gridDim.z;
    unsigned sum, cnt, mine, sp = 0u;
    for (;;) {
        sum = 0u; cnt = 0u; mine = 0u;
#pragma unroll
        for (unsigned j = 0; j < 16; ++j) { const unsigned c = xb_ld(&bar[XB_XCNT(j)]); sum += c; cnt += (c > 0u) ? 1u : 0u; mine = (j == x) ? c : mine; }
        if (sum == G) break;
        __builtin_amdgcn_s_sleep(1);
        if ((++sp & 255u) == 0u) { if (xb_ld(&bar[XB_TMO])) break; if (sp > XB_SPIN_CAP) { atomicAdd(&bar[XB_TMO], 1u); break; } }
    }
    nloc = mine > 0u ? mine : 1u; nx = cnt > 0u ? cnt : 1u;
}
DI void xcd_barrier(const XcdBarrier& b) {
    asm volatile("s_waitcnt vmcnt(0)" ::: "memory");
    __syncthreads();
    if (threadIdx.x == 0) {
        unsigned* bar = b.bar;
        __builtin_amdgcn_s_waitcnt(0);
        unsigned nloc = b.st[0], nx = b.st[1];
        if (nloc == 0u) { xcd_barrier_complete(bar, b.x, nloc, nx); b.st[0] = nloc; b.st[1] = nx; }
        const unsigned old = xb_add(&bar[XB_XSUB(b.x)], 1u);
        const unsigned gen = old / nloc;
        if (old + 1u == (gen + 1u) * nloc) {
            __builtin_amdgcn_fence(__ATOMIC_RELEASE, "agent");
            asm volatile("s_waitcnt vmcnt(0)" ::: "memory");
            const unsigned og = xb_add(&bar[XB_TOP], 1u);
            const unsigned tg = og / nx;
            if (og + 1u == (tg + 1u) * nx) xb_add(&bar[XB_TOPGEN], 1u);
            else XB_SPIN(xb_ld(&bar[XB_TOPGEN]) == tg, bar);
            __builtin_amdgcn_fence(__ATOMIC_ACQUIRE, "agent");
            xb_add(&bar[XB_XGEN(b.x)], 1u);
            asm volatile("s_waitcnt vmcnt(0)" ::: "memory");
        } else {
            XB_SPIN(xb_ld(&bar[XB_XGEN(b.x)]) == gen, bar);
            __builtin_amdgcn_fence(__ATOMIC_ACQUIRE, "agent");
            asm volatile("s_waitcnt vmcnt(0)" ::: "memory");
        }
    }
    __syncthreads();
}

constexpr int BM = 256, BK = 64, HALF = 128, HTB = HALF * BK * 2, STAGE_BYTES = 8 * HTB, NXCD = 8, WGM = 8;
constexpr int LDS_TAB = STAGE_BYTES;
constexpr int LDS_GRP = STAGE_BYTES + 2048;
constexpr int LDS_BYTES = 156 * 1024;
constexpr int LDS_XB = LDS_BYTES - 16;
constexpr int LDS_QW = LDS_BYTES - 32;

DI void tconv_tile(const float* __restrict__ src, int ldn, int k0, int ncol0, bool zero, bf16_t* __restrict__ dst, int K, int nrow0, float* tile  ) {
    const int t = threadIdx.x;
    {
        const int kk = t >> 4, c4 = (t & 15) * 4;
#pragma unroll
        for (int i = 0; i < 2; ++i) {
            const int k = kk + 32 * i;
            f32x4 v = {0.f, 0.f, 0.f, 0.f};
            if (!zero) v = *(const f32x4*)(src + (size_t)(k0 + k) * ldn + ncol0 + c4);
            tile[(c4 + 0) * 65 + k] = v[0]; tile[(c4 + 1) * 65 + k] = v[1]; tile[(c4 + 2) * 65 + k] = v[2]; tile[(c4 + 3) * 65 + k] = v[3];
        }
    }
    __syncthreads();
    {
        const int n = t >> 3, kc = (t & 7) * 8;
        const float* r = tile + n * 65 + kc;
        u32x4 o = {cvt_pk(r[0], r[1]), cvt_pk(r[2], r[3]), cvt_pk(r[4], r[5]), cvt_pk(r[6], r[7])};
        *(u32x4*)(dst + (size_t)(nrow0 + n) * K + k0 + kc) = o;
    }
    __syncthreads();
}

DI void phase_prep(const Params& P, unsigned char* lds_generic) {
    float* tile = (float*)lds_generic;
    const int wg = blockIdx.x, nwg = gridDim.x;
    unsigned char* ws = P.ws;
    constexpr int J0 = 16 * 56, J1 = J0 + 256, J2 = J1 + 32 * 16 * 32, J3 = J2 + 32 * 16 * 16, J4 = J3 + 64, J5 = J4 + 256;
    for (int j = wg; j < J5; j += nwg) {
        if (j < J0) { const int kt = j / 56, nt = j % 56; tconv_tile(P.w_in, IN_COLS, kt * 64, nt * 64, nt >= 54, (bf16_t*)(ws + WS_WIN), 1024, nt * 64, tile); }
        else if (j < J1) { const int q = j - J0, kt = q >> 4, nt = q & 15; tconv_tile(P.w_out, 1024, kt * 64, nt * 64, false, (bf16_t*)(ws + WS_WOUT), 1024, nt * 64, tile); }
        else if (j < J2) { const int q = j - J1, e = q >> 9, r = q & 511, kt = r >> 5, nt = r & 31; const int n0 = nt * 64;
            const int orig = ((n0 & 128) ? 1024 : 0) + (n0 >> 8) * 128 + (n0 & 127);
            tconv_tile(P.w1 + (size_t)e * 1024 * 2048, 2048, kt * 64, orig, false, (bf16_t*)(ws + WS_W1) + (size_t)e * 2048 * 1024, 1024, n0, tile); }
        else if (j < J3) { const int q = j - J2, e = q >> 8, r = q & 255, kt = r >> 4, nt = r & 15;
            tconv_tile(P.w2 + (size_t)e * 1024 * 1024, 1024, kt * 64, nt * 64, false, (bf16_t*)(ws + WS_W2) + (size_t)e * 1024 * 1024, 1024, nt * 64, tile); }
        else if (j < J4) { const int q = j - J3, kt = q >> 4, nt = q & 15; tconv_tile(P.w_ple, 1024, kt * 64, nt * 64, false, (bf16_t*)(ws + WS_WPLE), 256, nt * 64, tile); }
        else { const int q = j - J4, kt = q >> 4, nt = q & 15; tconv_tile(P.w_ple_gate, 1024, kt * 64, nt * 64, false, (bf16_t*)(ws + WS_WG), 1024, nt * 64, tile); }
    }
    {
        const int wid = threadIdx.x >> 6, lane = threadIdx.x & 63;
        f32x4 g[4];
#pragma unroll
        for (int i = 0; i < 4; ++i) g[i] = *(const f32x4*)(P.norm_mix_g + 4 * lane + 256 * i);
        bf16_t* U = (bf16_t*)(ws + WS_U);
        for (int row = wg * 8 + wid; row < MTOK; row += nwg * 8) {
            const float* xr = P.x + (size_t)row * 1024;
            f32x4 v[4]; float ss = 0.f;
#pragma unroll
            for (int i = 0; i < 4; ++i) { v[i] = *(const f32x4*)(xr + 4 * lane + 256 * i); ss += v[i][0] * v[i][0] + v[i][1] * v[i][1] + v[i][2] * v[i][2] + v[i][3] * v[i][3]; }
            ss = wave_sum(ss);
            const float rinv = __builtin_amdgcn_rsqf(ss * (1.f / 1024.f) + NORM_EPS);
#pragma unroll
            for (int i = 0; i < 4; ++i) {
                u32x2 o = {cvt_pk(v[i][0] * rinv * g[i][0], v[i][1] * rinv * g[i][1]), cvt_pk(v[i][2] * rinv * g[i][2], v[i][3] * rinv * g[i][3])};
                *(u32x2*)(U + (size_t)row * 1024 + 4 * lane + 256 * i) = o;
            }
        }
    }
    {
        bf16_t* PB = (bf16_t*)(ws + WS_PB);
        const size_t n8 = (size_t)MTOK * PLE_DIM / 8;
        for (size_t i = (size_t)wg * 512 + threadIdx.x; i < n8; i += (size_t)nwg * 512) {
            const f32x4 a = *(const f32x4*)(P.p + i * 8), b = *(const f32x4*)(P.p + i * 8 + 4);
            u32x4 o = {cvt_pk(a[0], a[1]), cvt_pk(a[2], a[3]), cvt_pk(b[0], b[1]), cvt_pk(b[2], b[3])};
            *(u32x4*)(PB + i * 8) = o;
        }
    }
}

DI int lds_byte(int r, int c) { const int st = (r >> 4) * 2 + (c >> 5), rr = r & 15, cc = c & 31, ob = rr * 64 + cc * 2; return st * 1024 + (ob ^ (((ob >> 9) & 1) << 5)); }
DI void stage_rc(int b, int& R, int& C) { const int st = b / 1024, sb = b % 1024, swz = sb ^ (((sb >> 9) & 1) << 5); R = (st >> 1) * 16 + swz / 64; C = (st & 1) * 32 + (swz % 64) / 2; }
DI int perm32(int rho) { const int n = rho >> 4, i = rho & 15; return 8 * (i >> 2) + 4 * n + (i & 3); }

struct Unit { const char* A; const char* B; int pm, pn, g, cnt, arow; };
typedef f32x4 AccT[2][2][4][2];

struct DenseOrder {
    const char* A; const char* B; int nM, nN, nwg, G, c; size_t astep, bstep;
    DI void init(const void* A_, const void* B_, int M, int N, int lda_bytes, int ldb_bytes) { A = (const char*)A_; B = (const char*)B_; nM = M / BM; nN = N / BM; nwg = nM * nN; G = gridDim.x; c = blockIdx.x; astep = (size_t)BM * lda_bytes; bstep = (size_t)BM * ldb_bytes; }
    static constexpr bool GATHER = false;
    DI bool next(int i, Unit& u) const {
        const long L = (long)i * G + c; if (L >= nwg) return false;
        int wgid = (int)L; { const int q = nwg / NXCD, r = nwg % NXCD, xcd = wgid % NXCD, off = wgid / NXCD; wgid = (xcd < r ? xcd * (q + 1) : r * (q + 1) + (xcd - r) * q) + off; }
        const int nig = WGM * nN, gid = wgid / nig, fm = gid * WGM, gsz = (nM - fm) < WGM ? (nM - fm) : WGM;
        u.pm = fm + ((wgid % nig) % gsz); u.pn = (wgid % nig) / gsz; u.A = A + (size_t)u.pm * astep; u.B = B + (size_t)u.pn * bstep; u.g = 0; u.cnt = 256; u.arow = u.pm * 256; return true;
    }
    DI void issue_table(const Unit&, LAS unsigned char*) const {}
    DI unsigned row_off(const Unit&, LAS unsigned char*, int) const { return 0u; }
};

#define G_WAIT_V(n) asm volatile("s_waitcnt vmcnt(" #n ")" ::: "memory")
#define G_WAIT_L(n) asm volatile("s_waitcnt lgkmcnt(" #n ")" ::: "memory")
#define G_BAR __builtin_amdgcn_s_barrier()
#define G_SCHED __builtin_amdgcn_sched_barrier(0)

template <bool OPQ, class Sched, class Epi>
DI void gemm_phase(LAS unsigned char* lds, const int K_  , const int lda_  , const Sched& S, const Epi& E) {
    int K = K_, lda = lda_; if constexpr (OPQ) asm volatile("" : "+s"(K), "+s"(lda));
    const int tid = threadIdx.x, wid = __builtin_amdgcn_readfirstlane(tid >> 6), lane = tid & 63, wr = wid >> 2, wc = wid & 3, fr = lane & 15, fq = lane >> 4;
    const int nt = K / BK;
    unsigned vA[2][2], voffB[2]; int R0 = 0, C0 = 0;
#pragma unroll
    for (int i = 0; i < 2; ++i) { int R, C; stage_rc(tid * 16 + i * 8192, R, C); const int Rb = Epi::PERM ? ((R & ~31) + perm32(R & 31)) : R;
        if (i == 0) { R0 = R; C0 = C; } voffB[i] = (unsigned)(Rb * K + C) * 2u;
        vA[0][i] = (unsigned)(R * lda + C) * 2u; vA[1][i] = (unsigned)((R + HALF) * lda + C) * 2u; }
    const size_t kstep = (size_t)(BK * 2);
    const size_t hstepB = (size_t)HALF * K * 2;
    const unsigned ldsw = (unsigned)wid * 1024u;
    const int aoff = lds_byte(wr * 64 + fr, fq * 8), boff = lds_byte(wc * 32 + fr, fq * 8);
#define G_SA(b, h) (((b) * 2 + (h)) * HTB)
#define G_SB(b, h) ((4 + (b) * 2 + (h)) * HTB)
#define G_STAGE(bufoff, gbase, v0, v1) do { \
        __builtin_amdgcn_global_load_lds((const unsigned*)((const char*)(gbase) + (v0)), (LAS unsigned*)(lds + (bufoff) + ldsw), 16, 0, 0); \
        __builtin_amdgcn_global_load_lds((const unsigned*)((const char*)(gbase) + (v1)), (LAS unsigned*)(lds + (bufoff) + ldsw + 8192), 16, 0, 0); } while (0)
#define G_LDA(dst, b, h) do { _Pragma("unroll") for (int m = 0; m < 4; ++m) _Pragma("unroll") for (int k = 0; k < 2; ++k) dst[m][k] = *(const LAS bf16x8*)(lds + G_SA(b, h) + aoff + m * 2048 + k * 1024); } while (0)
#define G_LDB(dst, b, h) do { _Pragma("unroll") for (int n = 0; n < 2; ++n) _Pragma("unroll") for (int k = 0; k < 2; ++k) dst[n][k] = *(const LAS bf16x8*)(lds + G_SB(b, h) + boff + n * 2048 + k * 1024); } while (0)
#define G_MMA(ai, bj, At, Bt) do { __builtin_amdgcn_s_setprio(1); _Pragma("unroll") for (int m = 0; m < 4; ++m) _Pragma("unroll") for (int n = 0; n < 2; ++n) _Pragma("unroll") for (int k = 0; k < 2; ++k) \
        acc[ai][bj][m][n] = __builtin_amdgcn_mfma_f32_16x16x32_bf16(Bt[n][k], At[m][k], acc[ai][bj][m][n], 0, 0, 0); __builtin_amdgcn_s_setprio(0); } while (0)
    Unit cur, nxt; int ui = 0;
    if (!S.next(0, cur)) return;
    AccT acc;
#pragma unroll
    for (int a = 0; a < 2; ++a)
#pragma unroll
        for (int b = 0; b < 2; ++b)
#pragma unroll
            for (int m = 0; m < 4; ++m)
#pragma unroll
                for (int n = 0; n < 2; ++n) acc[a][b][m][n] = (f32x4){0.f, 0.f, 0.f, 0.f};
    bf16x8 At[4][2], B0[2][2], B1[2][2];
    const char* cA = cur.A; const char* cB = cur.B;
    if constexpr (Sched::GATHER) {
        S.issue_table(cur, lds + LDS_TAB);
        G_WAIT_V(0); __syncthreads();
#pragma unroll
        for (int h = 0; h < 2; ++h)
#pragma unroll
            for (int i = 0; i < 2; ++i) { vA[h][i] = S.row_off(cur, lds + LDS_TAB, R0 + 64 * i + HALF * h) + (unsigned)C0 * 2u; }
    }
    G_STAGE(G_SB(0, 0), cB, voffB[0], voffB[1]); G_STAGE(G_SA(0, 0), cA, vA[0][0], vA[0][1]); G_STAGE(G_SB(0, 1), cB + hstepB, voffB[0], voffB[1]); G_STAGE(G_SA(0, 1), cA, vA[1][0], vA[1][1]);
    if (wr == 1) G_BAR;
    G_WAIT_V(4); G_BAR;
    G_STAGE(G_SB(1, 0), cB + kstep, voffB[0], voffB[1]); G_STAGE(G_SA(1, 0), cA + kstep, vA[0][0], vA[0][1]); G_STAGE(G_SB(1, 1), cB + hstepB + kstep, voffB[0], voffB[1]);
    G_WAIT_V(6); G_BAR;
    for (;;) {
        const bool has_next = S.next(ui + 1, nxt);
        const char* nA = has_next ? nxt.A : cA; const char* nB = has_next ? nxt.B : cB;
        for (int t = 0; t < nt; t += 2) {
            const bool last = (t == nt - 2);
            const char* a1 = cA + (size_t)(t + 1) * kstep;
            const char* a2 = last ? nA : cA + (size_t)(t + 2) * kstep; const char* b2 = last ? nB : cB + (size_t)(t + 2) * kstep;
            const char* a3 = a2 + kstep; const char* b3 = b2 + kstep;
            if constexpr (Sched::GATHER) {
                if (t == 0 && has_next) S.issue_table(nxt, lds + LDS_TAB + ((ui + 1) & 1) * 1024);
            }
            G_LDB(B0, 0, 0); G_SCHED; G_LDA(At, 0, 0); G_STAGE(G_SA(1, 1), a1, vA[1][0], vA[1][1]);
            if constexpr (Sched::GATHER) {
                if (last && has_next) {
                    int tz = threadIdx.x; asm volatile("" : "+v"(tz)); int Rz, Cz; stage_rc(tz * 16, Rz, Cz);
#pragma unroll
                    for (int h = 0; h < 2; ++h)
#pragma unroll
                        for (int i = 0; i < 2; ++i) vA[h][i] = S.row_off(nxt, lds + LDS_TAB + ((ui + 1) & 1) * 1024, Rz + 64 * i + HALF * h) + (unsigned)Cz * 2u;
                }
            }
            G_WAIT_L(8); G_BAR; G_WAIT_L(0); G_MMA(0, 0, At, B0); G_BAR; G_SCHED;
            G_LDB(B1, 0, 1); G_STAGE(G_SB(0, 0), b2, voffB[0], voffB[1]);
            G_BAR; G_WAIT_L(0); G_MMA(0, 1, At, B1); G_BAR;
            G_LDA(At, 0, 1); G_STAGE(G_SA(0, 0), a2, vA[0][0], vA[0][1]);
            G_BAR; G_WAIT_L(0); G_MMA(1, 0, At, B0); G_BAR; G_SCHED;
            G_STAGE(G_SB(0, 1), b2 + hstepB, voffB[0], voffB[1]);
            G_WAIT_V(6); G_BAR; G_MMA(1, 1, At, B1); G_BAR;
            G_LDB(B0, 1, 0); G_SCHED; G_LDA(At, 1, 0); G_STAGE(G_SA(0, 1), a2, vA[1][0], vA[1][1]);
            G_WAIT_L(8); G_BAR; G_WAIT_L(0); G_MMA(0, 0, At, B0); G_BAR; G_SCHED;
            G_LDB(B1, 1, 1); G_STAGE(G_SB(1, 0), b3, voffB[0], voffB[1]);
            G_BAR; G_WAIT_L(0); G_MMA(0, 1, At, B1); G_BAR;
            G_LDA(At, 1, 1); G_STAGE(G_SA(1, 0), a3, vA[0][0], vA[0][1]);
            G_BAR; G_WAIT_L(0); G_MMA(1, 0, At, B0); G_BAR; G_SCHED;
            G_STAGE(G_SB(1, 1), b3 + hstepB, voffB[0], voffB[1]);
            G_WAIT_V(6); G_BAR; G_MMA(1, 1, At, B1); G_BAR;
        }
        { int tz = threadIdx.x; asm volatile("" : "+v"(tz)); const int wz = tz >> 6, lz = tz & 63; E(acc, cur, wz >> 2, wz & 3, lz & 15, lz >> 4); }
        if (!has_next) break;
#pragma unroll
        for (int a = 0; a < 2; ++a)
#pragma unroll
            for (int b = 0; b < 2; ++b)
#pragma unroll
                for (int m = 0; m < 4; ++m)
#pragma unroll
                    for (int n = 0; n < 2; ++n) acc[a][b][m][n] = (f32x4){0.f, 0.f, 0.f, 0.f};
        cur = nxt; cA = nA; cB = nB; ++ui;
    }
    G_WAIT_V(0);
    if (wr == 0) G_BAR;
    G_BAR;
}

struct EpiZ {
    static constexpr bool PERM = true;
    bf16_t* Z;
    DI void operator()(const AccT& acc, const Unit& u, int wr, int wc, int fr, int fq) const {
        const int row0 = u.pm * BM + wr * 64 + fr, col0 = u.pn * BM + wc * 32 + 8 * fq;
#pragma unroll
        for (int ai = 0; ai < 2; ++ai)
#pragma unroll
            for (int m = 0; m < 4; ++m) { bf16_t* rowp = Z + (size_t)(row0 + ai * HALF + m * 16) * IN_COLS + col0;
#pragma unroll
                for (int bj = 0; bj < 2; ++bj) { if (col0 + bj * HALF < IN_COLS) { const f32x4 v0 = acc[ai][bj][m][0], v1 = acc[ai][bj][m][1];
                    u32x4 o = {cvt_pk(v0[0], v0[1]), cvt_pk(v0[2], v0[3]), cvt_pk(v1[0], v1[1]), cvt_pk(v1[2], v1[3])}; *(u32x4*)(rowp + bj * HALF) = o; } } }
    }
};
struct EpiH1 {
    static constexpr bool PERM = false;
    const float* X; float* H;
    DI void operator()(const AccT& acc, const Unit& u, int wr, int wc, int fr, int fq) const {
        const int row0 = u.pm * BM + wr * 64 + fr, col0 = u.pn * BM + wc * 32 + 4 * fq;
#pragma unroll
        for (int ai = 0; ai < 2; ++ai)
#pragma unroll
            for (int m = 0; m < 4; ++m) { const size_t ro = (size_t)(row0 + ai * HALF + m * 16) * 1024 + col0;
#pragma unroll
                for (int bj = 0; bj < 2; ++bj)
#pragma unroll
                    for (int n = 0; n < 2; ++n) { const f32x4 xv = *(const f32x4*)(X + ro + bj * HALF + n * 16); *(f32x4*)(H + ro + bj * HALF + n * 16) = xv + acc[ai][bj][m][n]; } }
    }
};
struct EpiMoe1 {
    static constexpr bool PERM = true;
    bf16_t* ACT; const float* b1;
    DI void operator()(const AccT& acc, const Unit& u, int wr, int wc, int fr, int fq) const {
        const int e = u.g & 31, cb = u.pn * 128 + wc * 32 + 8 * fq;
        const float* bg = b1 + (size_t)e * 2048 + cb; const float* bl = bg + 1024;
        const f32x4 bg0 = *(const f32x4*)bg, bg1 = *(const f32x4*)(bg + 4), bl0 = *(const f32x4*)bl, bl1 = *(const f32x4*)(bl + 4);
#pragma unroll
        for (int ai = 0; ai < 2; ++ai)
#pragma unroll
            for (int m = 0; m < 4; ++m) {
                const int rl = ai * HALF + wr * 64 + m * 16 + fr;
                float o[8];
#pragma unroll
                for (int n = 0; n < 2; ++n)
#pragma unroll
                    for (int j = 0; j < 4; ++j) {
                        float glu = acc[ai][0][m][n][j] + (n ? bg1[j] : bg0[j]); float lin = acc[ai][1][m][n][j] + (n ? bl1[j] : bl0[j]);
                        glu = fminf(glu, 7.0f); lin = fminf(fmaxf(lin, -7.0f), 7.0f);
                        o[n * 4 + j] = glu * sigmoidf_(1.702f * glu) * (lin + 1.0f);
                    }
                u32x4 ov = {cvt_pk(o[0], o[1]), cvt_pk(o[2], o[3]), cvt_pk(o[4], o[5]), cvt_pk(o[6], o[7])};
                *(u32x4*)(ACT + (size_t)(u.arow + rl) * 1024 + cb) = ov;
            }
    }
};
struct EpiMoe2 {
    static constexpr bool PERM = false;
    float* H; bf16_t* HB; const float* b2; const int* list; const float* gate; int slot;
    DI void operator()(const AccT& acc, const Unit& u, int wr, int wc, int fr, int fq) const {
        const int e = u.g & 31, col0 = u.pn * BM + wc * 32 + 4 * fq;
        f32x4 bv[2][2];
#pragma unroll
        for (int bj = 0; bj < 2; ++bj)
#pragma unroll
            for (int n = 0; n < 2; ++n) bv[bj][n] = *(const f32x4*)(b2 + (size_t)e * 1024 + col0 + bj * HALF + n * 16);
        const int* lp = list + (size_t)u.g * 65536 + (size_t)u.pm * 256;
#pragma unroll
        for (int ai = 0; ai < 2; ++ai)
#pragma unroll
            for (int m = 0; m < 4; ++m) {
                const int rl = ai * HALF + wr * 64 + m * 16 + fr;
                if (rl < u.cnt) {
                    const int tok = lp[rl]; const float gt = gate[(size_t)tok * 4 + slot];
                    float* hp = H + (size_t)tok * 1024 + col0;
#pragma unroll
                    for (int bj = 0; bj < 2; ++bj)
#pragma unroll
                        for (int n = 0; n < 2; ++n) {
                            f32x4 hv = *(const f32x4*)(hp + bj * HALF + n * 16);
                            hv = hv + gt * (acc[ai][bj][m][n] + bv[bj][n]);
                            *(f32x4*)(hp + bj * HALF + n * 16) = hv;
                            if (slot == 3) { u32x2 o = {cvt_pk(hv[0], hv[1]), cvt_pk(hv[2], hv[3])}; *(u32x2*)(HB + (size_t)tok * 1024 + col0 + bj * HALF + n * 16) = o; }
                        }
                }
            }
    }
};
struct EpiPle {
    static constexpr bool PERM = true;
    bf16_t* EB; float* ESS;
    DI void operator()(const AccT& acc, const Unit& u, int wr, int wc, int fr, int fq) const {
        const int row0 = u.pm * BM + wr * 64 + fr, col0 = u.pn * BM + wc * 32 + 8 * fq;
#pragma unroll
        for (int ai = 0; ai < 2; ++ai)
#pragma unroll
            for (int m = 0; m < 4; ++m) { const int row = row0 + ai * HALF + m * 16; bf16_t* rowp = EB + (size_t)row * 1024 + col0; float ss = 0.f;
#pragma unroll
                for (int bj = 0; bj < 2; ++bj) { const f32x4 v0 = acc[ai][bj][m][0], v1 = acc[ai][bj][m][1];
                    ss += v0[0] * v0[0] + v0[1] * v0[1] + v0[2] * v0[2] + v0[3] * v0[3] + v1[0] * v1[0] + v1[1] * v1[1] + v1[2] * v1[2] + v1[3] * v1[3];
                    u32x4 o = {cvt_pk(v0[0], v0[1]), cvt_pk(v0[2], v0[3]), cvt_pk(v1[0], v1[1]), cvt_pk(v1[2], v1[3])}; *(u32x4*)(rowp + bj * HALF) = o; }
                ss += __shfl_xor(ss, 16); ss += __shfl_xor(ss, 32);
                if (fq == 0) atomicAdd(ESS + row, ss);
            }
    }
};
struct EpiFinal {
    static constexpr bool PERM = false;
    float* H; const bf16_t* EB; const float* ESS; const float* g;
    DI void operator()(const AccT& acc, const Unit& u, int wr, int wc, int fr, int fq) const {
        const int row0 = u.pm * BM + wr * 64 + fr, col0 = u.pn * BM + wc * 32 + 4 * fq;
        f32x4 gv[2][2];
#pragma unroll
        for (int bj = 0; bj < 2; ++bj)
#pragma unroll
            for (int n = 0; n < 2; ++n) gv[bj][n] = *(const f32x4*)(g + col0 + bj * HALF + n * 16);
#pragma unroll
        for (int ai = 0; ai < 2; ++ai)
#pragma unroll
            for (int m = 0; m < 4; ++m) { const int row = row0 + ai * HALF + m * 16; const size_t ro = (size_t)row * 1024 + col0;
                const float rinv = __builtin_amdgcn_rsqf(ESS[row] * (1.f / 1024.f) + NORM_EPS);
#pragma unroll
                for (int bj = 0; bj < 2; ++bj)
#pragma unroll
                    for (int n = 0; n < 2; ++n) {
                        const size_t o = ro + bj * HALF + n * 16;
                        const u32x2 eb = *(const u32x2*)(EB + o); const f32x4 hv = *(const f32x4*)(H + o); const f32x4 a = acc[ai][bj][m][n];
                        f32x4 r;
                        r[0] = hv[0] + bf_lo(eb[0]) * rinv * gv[bj][n][0] * sigmoidf_(a[0]);
                        r[1] = hv[1] + bf_hi(eb[0]) * rinv * gv[bj][n][1] * sigmoidf_(a[1]);
                        r[2] = hv[2] + bf_lo(eb[1]) * rinv * gv[bj][n][2] * sigmoidf_(a[2]);
                        r[3] = hv[3] + bf_hi(eb[1]) * rinv * gv[bj][n][3] * sigmoidf_(a[3]);
                        *(f32x4*)(H + o) = r;
                    }
            }
    }
};

DI void moe_tables(LAS unsigned char* lds, const unsigned* cnt_g) {
    LAS int* cntL = (LAS int*)(lds + LDS_GRP); LAS int* pre = cntL + 128;
    __syncthreads();
    if (threadIdx.x < 128) cntL[threadIdx.x] = (int)cnt_g[threadIdx.x];
    __syncthreads();
    if (threadIdx.x == 0) { int s = 0; for (int g = 0; g < 128; ++g) { pre[g] = s; s += (cntL[g] + 255) >> 8; } pre[128] = s; }
    __syncthreads();
}
template <int NT, bool GATHER_>
struct MoeOrder {
    static constexpr bool GATHER = GATHER_;
    const char* A; const char* B; size_t bexp; int g0, ng, G, c; LAS unsigned char* lds; const int* list;
    DI bool next(int i, Unit& u) const {
        LAS int* cntL = (LAS int*)(lds + LDS_GRP); LAS int* pre = cntL + 128;
        const int L = i * G + c; const int base = __builtin_amdgcn_readfirstlane(pre[g0]), tot = __builtin_amdgcn_readfirstlane(pre[g0 + ng]) - base;
        const int rbg = L / NT; if (rbg >= tot) return false;
        const int ra = rbg + base; int lo = g0, hi = g0 + ng;
        while (hi - lo > 1) { const int mid = (lo + hi) >> 1; const int pm_ = __builtin_amdgcn_readfirstlane(pre[mid]); if (pm_ <= ra) lo = mid; else hi = mid; }
        const int g = lo, pg = __builtin_amdgcn_readfirstlane(pre[g]), rb = ra - pg, cg = __builtin_amdgcn_readfirstlane(cntL[g]);
        u.g = g; u.pm = rb; u.pn = L % NT; u.cnt = (cg - rb * 256) < 256 ? (cg - rb * 256) : 256; u.arow = ra * 256;
        u.A = GATHER ? A : A + (size_t)u.arow * 2048; u.B = B + (size_t)(g & 31) * bexp + (size_t)u.pn * (256 * 2048);
        return true;
    }
    DI void issue_table(const Unit& u, LAS unsigned char* tab) const {
        if (threadIdx.x < 256) { const int wid = __builtin_amdgcn_readfirstlane(threadIdx.x >> 6);
            __builtin_amdgcn_global_load_lds((const unsigned*)(list + (size_t)u.g * 65536 + (size_t)u.pm * 256 + threadIdx.x), (LAS unsigned*)(tab + wid * 256), 4, 0, 0); }
    }
    DI unsigned row_off(const Unit& u, LAS unsigned char* tab, int r) const { const unsigned t = *(const LAS unsigned*)(tab + r * 4); return (r < u.cnt) ? t * 2048u : 0u; }
};

DI void phase_qknorm(const Params& P) {
    bf16_t* Z = (bf16_t*)(P.ws + WS_Z);
    const int t = threadIdx.x & 127, grp = t >> 3, sub = t & 7;
    const bool isq = grp < 8;
    const int col = (isq ? ZQ : ZKK) + (grp & 7) * 64 + sub * 8;
    const float* gp = (isq ? P.da_q_norm_g : P.da_k_norm_g) + sub * 8;
    float g[8];
#pragma unroll
    for (int j = 0; j < 8; ++j) g[j] = gp[j] * (isq ? (0.125f * LOG2E) : 1.0f);
    for (int tok = blockIdx.x * 4 + (threadIdx.x >> 7); tok < MTOK; tok += gridDim.x * 4) {
        bf16_t* zp = Z + (size_t)tok * IN_COLS + col;
        const u32x4 v = *(const u32x4*)zp;
        float f[8] = {bf_lo(v[0]), bf_hi(v[0]), bf_lo(v[1]), bf_hi(v[1]), bf_lo(v[2]), bf_hi(v[2]), bf_lo(v[3]), bf_hi(v[3])};
        float ss = 0.f;
#pragma unroll
        for (int j = 0; j < 8; ++j) ss += f[j] * f[j];
        ss += __shfl_xor(ss, 1); ss += __shfl_xor(ss, 2); ss += __shfl_xor(ss, 4);
        const float rinv = __builtin_amdgcn_rsqf(ss * (1.f / 64.f) + NORM_EPS);
        u32x4 o = {cvt_pk(f[0] * rinv * g[0], f[1] * rinv * g[1]), cvt_pk(f[2] * rinv * g[2], f[3] * rinv * g[3]),
                   cvt_pk(f[4] * rinv * g[4], f[5] * rinv * g[5]), cvt_pk(f[6] * rinv * g[6], f[7] * rinv * g[7])};
        *(u32x4*)zp = o;
    }
}

constexpr int LDS_RT_SEL = STAGE_BYTES;
DI void phase_route(const Params& P, LAS unsigned char* lds) {
    LAS float* wT = (LAS float*)lds;
    LAS int* sel_e = (LAS int*)(lds + LDS_RT_SEL); LAS float* sel_g = (LAS float*)(sel_e + 1024); LAS int* lpos = (LAS int*)(sel_g + 1024);
    LAS int* lcnt = lpos + 1024; LAS int* lbase = lcnt + 128;
    const int tid = threadIdx.x, wid = tid >> 6, lane = tid & 63;
    const float* H = P.out; bf16_t* Mb = (bf16_t*)(P.ws + WS_U);
    unsigned* cnt_g = (unsigned*)(P.ws + WS_CTL) + CW_CNT; int* list = (int*)(P.ws + WS_LIST); float* gate = (float*)(P.ws + WS_GATE);
    __syncthreads();
    for (int i = tid; i < 1024 * 32; i += 512) { const int k = i >> 5, e = i & 31; wT[e * 1024 + k] = P.w_router[i]; }
    __syncthreads();
    f32x4 g[4];
#pragma unroll
    for (int i = 0; i < 4; ++i) g[i] = *(const f32x4*)(P.norm_ffn_g + 4 * lane + 256 * i);
    int erev = 0;
#pragma unroll
    for (int b = 0; b < 5; ++b) erev |= ((lane >> b) & 1) << (4 - b);
    const float brt = P.b_router[erev];
    for (int blk = blockIdx.x; blk < MTOK / 256; blk += gridDim.x) {
        if (tid < 128) lcnt[tid] = 0;
        for (int rp = 0; rp < 32; ++rp) {
            const int r0 = wid * 32 + rp;
            f32x4 mv[4];
            {
                const int row = blk * 256 + r0; const float* hr = H + (size_t)row * 1024; float ss = 0.f; f32x4 v[4];
#pragma unroll
                for (int i = 0; i < 4; ++i) { v[i] = *(const f32x4*)(hr + 4 * lane + 256 * i); ss += v[i][0] * v[i][0] + v[i][1] * v[i][1] + v[i][2] * v[i][2] + v[i][3] * v[i][3]; }
                ss = wave_sum(ss);
                const float rinv = __builtin_amdgcn_rsqf(ss * (1.f / 1024.f) + NORM_EPS);
#pragma unroll
                for (int i = 0; i < 4; ++i) { mv[i] = v[i] * rinv * g[i];
                    u32x2 o = {cvt_pk(mv[i][0], mv[i][1]), cvt_pk(mv[i][2], mv[i][3])}; *(u32x2*)(Mb + (size_t)row * 1024 + 4 * lane + 256 * i) = o; }
            }
            float acc[32];
#pragma unroll
            for (int e = 0; e < 32; ++e) {
                float a0 = 0.f;
#pragma unroll
                for (int i = 0; i < 4; ++i) { const f32x4 w = *(const LAS f32x4*)(wT + e * 1024 + 256 * i + 4 * lane);
                    a0 += mv[i][0] * w[0] + mv[i][1] * w[1] + mv[i][2] * w[2] + mv[i][3] * w[3]; }
                acc[e] = a0;
            }
            {
#define TR_STAGE(HN, DD) do { const bool up = (lane & (DD)) != 0; _Pragma("unroll") for (int i = 0; i < (HN); ++i) { \
                    const float keep = up ? acc[i + (HN)] : acc[i], send = up ? acc[i] : acc[i + (HN)]; acc[i] = keep + __shfl_xor(send, (DD)); } } while (0)
                TR_STAGE(16, 1); TR_STAGE(8, 2); TR_STAGE(4, 4); TR_STAGE(2, 8); TR_STAGE(1, 16);
#undef TR_STAGE
                float v = acc[0] + __shfl_xor(acc[0], 32) + brt;
                float tv[4]; int te[4];
#pragma unroll
                for (int k = 0; k < 4; ++k) {
                    float mx = v;
#pragma unroll
                    for (int o = 32; o >= 1; o >>= 1) mx = fmaxf(mx, __shfl_xor(mx, o));
                    int ce = (v == mx) ? erev : 99;
#pragma unroll
                    for (int o = 32; o >= 1; o >>= 1) ce = min(ce, __shfl_xor(ce, o));
                    tv[k] = mx; te[k] = ce; if (erev == ce) v = -3.0e38f;
                }
                const float e1 = __expf(tv[1] - tv[0]), e2 = __expf(tv[2] - tv[0]), e3 = __expf(tv[3] - tv[0]); const float inv = 1.f / (1.f + e1 + e2 + e3);
                if (lane == 0) { const int r = r0; sel_e[r * 4 + 0] = te[0]; sel_e[r * 4 + 1] = te[1]; sel_e[r * 4 + 2] = te[2]; sel_e[r * 4 + 3] = te[3];
                    sel_g[r * 4 + 0] = inv; sel_g[r * 4 + 1] = e1 * inv; sel_g[r * 4 + 2] = e2 * inv; sel_g[r * 4 + 3] = e3 * inv; }
            }
        }
        __syncthreads();
        if (tid < 256) {
#pragma unroll
            for (int s = 0; s < 4; ++s) lpos[tid * 4 + s] = atomicAdd((int*)&lcnt[s * 32 + sel_e[tid * 4 + s]], 1);
        }
        __syncthreads();
        if (tid < 128) lbase[tid] = (int)atomicAdd(cnt_g + tid, (unsigned)lcnt[tid]);
        __syncthreads();
        if (tid < 256) { const int tok = blk * 256 + tid;
#pragma unroll
            for (int s = 0; s < 4; ++s) { const int gi = s * 32 + sel_e[tid * 4 + s]; list[(size_t)gi * 65536 + lbase[gi] + lpos[tid * 4 + s]] = tok; gate[(size_t)tok * 4 + s] = sel_g[tid * 4 + s]; }
        }
        __syncthreads();
    }
}

constexpr int AT_V = 0, AT_K = 32768, AT_WS = 65536;
#define KSWZ(row, colB) ((row) * 256 + ((colB) ^ (((row) & 7) << 4)))
DI int crow(int r, int hi) { return (r & 3) + 8 * (r >> 2) + 4 * hi; }
DI int v_st(int k, int c) { const int kk = (k & ~0xC) | ((k & 4) << 1) | ((k & 8) >> 1); return ((kk >> 3) * 4 + (c >> 5)) * 512 + ((kk & 7) * 32 + (c & 31)) * 2; }
DI int v_rd_base(int lane) { return ((lane & 3) << 3) | (((lane >> 2) & 3) << 6) | (((lane >> 4) & 1) << 5) | (((lane >> 5) & 1) << 8); }
constexpr int v_rd_off(int d0, int ks, int half) { return d0 * 512 + ks * 4096 + half * 2048; }
template <int OFF> DI s16x4 tr_read(int vb) { s16x4 r; asm volatile("ds_read_b64_tr_b16 %0, %1 offset:%2" : "=&v"(r) : "v"(vb), "i"(OFF) : "memory"); return r; }
#define AT_PK(L, H) (bf16x8){L[0], L[1], L[2], L[3], H[0], H[1], H[2], H[3]}
template <int D0> DI void pv_one(f32x16& od, int vb, bf16x8 pa0, bf16x8 pa1, bf16x8 pa2, bf16x8 pa3) {
    const s16x4 l0 = tr_read<v_rd_off(D0, 0, 0)>(vb), h0 = tr_read<v_rd_off(D0, 0, 1)>(vb), l1 = tr_read<v_rd_off(D0, 1, 0)>(vb), h1 = tr_read<v_rd_off(D0, 1, 1)>(vb);
    const s16x4 l2 = tr_read<v_rd_off(D0, 2, 0)>(vb), h2 = tr_read<v_rd_off(D0, 2, 1)>(vb), l3 = tr_read<v_rd_off(D0, 3, 0)>(vb), h3 = tr_read<v_rd_off(D0, 3, 1)>(vb);
    asm volatile("s_waitcnt lgkmcnt(0)" ::: "memory"); __builtin_amdgcn_sched_barrier(0);
    od = __builtin_amdgcn_mfma_f32_32x32x16_bf16(pa0, AT_PK(l0, h0), od, 0, 0, 0);
    od = __builtin_amdgcn_mfma_f32_32x32x16_bf16(pa1, AT_PK(l1, h1), od, 0, 0, 0);
    od = __builtin_amdgcn_mfma_f32_32x32x16_bf16(pa2, AT_PK(l2, h2), od, 0, 0, 0);
    od = __builtin_amdgcn_mfma_f32_32x32x16_bf16(pa3, AT_PK(l3, h3), od, 0, 0, 0);
}
DI void at_softmax(f32x16& p0, f32x16& p1, float& l_reg, bf16x8& pa0, bf16x8& pa1, bf16x8& pa2, bf16x8& pa3) {
#pragma unroll
    for (int r = 0; r < 16; ++r) { p0[r] = __builtin_amdgcn_exp2f(p0[r]); p1[r] = __builtin_amdgcn_exp2f(p1[r]); }
    float ps = 0.f;
#pragma unroll
    for (int r = 0; r < 16; ++r) ps += p0[r] + p1[r];
    l_reg += ps;
#define AT_PK4(Pv, BASE, OUT) do { unsigned a0 = cvt_pk(Pv[BASE + 0], Pv[BASE + 1]), a1 = cvt_pk(Pv[BASE + 2], Pv[BASE + 3]); \
    unsigned b0 = cvt_pk(Pv[BASE + 4], Pv[BASE + 5]), b1 = cvt_pk(Pv[BASE + 6], Pv[BASE + 7]); \
    auto r0 = __builtin_amdgcn_permlane32_swap(a0, b0, false, false); auto r1 = __builtin_amdgcn_permlane32_swap(a1, b1, false, false); \
    u32x4 w = {r0[0], r1[0], r0[1], r1[1]}; OUT = __builtin_bit_cast(bf16x8, w); } while (0)
    AT_PK4(p0, 0, pa0); AT_PK4(p0, 8, pa1); AT_PK4(p1, 0, pa2); AT_PK4(p1, 8, pa3);
#undef AT_PK4
}

DI void attn_unit(const Params& P, unsigned char* lds, int b, int h, int qb, float lam, float smax2, int W) {
    int tid_ = threadIdx.x; asm volatile("" : "+v"(tid_));
    const int tid = tid_, wid = tid >> 6, lane = tid & 63, r32 = lane & 31, hi = lane >> 5, grp = wid >> 1, c = wid & 1;
    const bf16_t* Zb = (const bf16_t*)(P.ws + WS_Z) + (size_t)b * SEQ * IN_COLS;
    const int i0 = qb * 128, qi = i0 + grp * 32 + r32;
    const float slope2 = exp2f(-2.0f * (float)(h + 1)) * LOG2E;
    bf16x8 qr[4];
    { const bf16_t* qp = Zb + (size_t)qi * IN_COLS + ZQ + h * 128 + c * 64 + hi * 8;
#pragma unroll
      for (int d0 = 0; d0 < 4; ++d0) qr[d0] = *(const bf16x8*)(qp + d0 * 16); }
    const bf16_t* Kh = Zb + ZKK + h * 128; const bf16_t* Vh = Zb + ZVV + h * 128;
    const int sr = tid >> 4, sc = (tid & 15) * 8, vst0 = v_st(sr, sc), vst1 = v_st(32 + sr, sc);
    const int vb0 = (int)(uintptr_t)(lds + AT_V) + v_rd_base(lane);
    int jlo = i0 - W; if (jlo < 0) jlo = 0; jlo >>= 6;
    int jhi = i0 + 127 + W; if (jhi > SEQ - 1) jhi = SEQ - 1; jhi >>= 6;
    const int NT = jhi - jlo + 1;
    f32x16 o[4];
#pragma unroll
    for (int d = 0; d < 4; ++d)
#pragma unroll
        for (int r = 0; r < 16; ++r) o[d][r] = 0.f;
    float l = 0.f;
    bf16x8 vs0, vs1, ks0, ks1;
#define AT_LOAD(k0) do { vs0 = *(const bf16x8*)(Vh + (size_t)((k0) + sr) * IN_COLS + sc); vs1 = *(const bf16x8*)(Vh + (size_t)((k0) + 32 + sr) * IN_COLS + sc); \
    ks0 = *(const bf16x8*)(Kh + (size_t)((k0) + sr) * IN_COLS + sc); ks1 = *(const bf16x8*)(Kh + (size_t)((k0) + 32 + sr) * IN_COLS + sc); } while (0)
#define AT_WRITE(bf) do { *(bf16x8*)(lds + AT_V + (bf) * 16384 + vst0) = vs0; *(bf16x8*)(lds + AT_V + (bf) * 16384 + vst1) = vs1; \
    *(bf16x8*)(lds + AT_K + (bf) * 16384 + KSWZ(sr, sc * 2)) = ks0; *(bf16x8*)(lds + AT_K + (bf) * 16384 + KSWZ(32 + sr, sc * 2)) = ks1; } while (0)
    __syncthreads();
    AT_LOAD(jlo * 64); AT_WRITE(0); __syncthreads();
    for (int j = 0; j < NT; ++j) {
        const int buf = j & 1, j0 = (jlo + j) * 64;
        if (j + 1 < NT) AT_LOAD(j0 + 64);
        const unsigned char* Ks = lds + AT_K + buf * 16384;
        const float x = (float)(qi - j0 - 4 * hi);
        f32x16 p0, p1;
#pragma unroll
        for (int r = 0; r < 16; ++r) { const float c0 = (float)((r & 3) + 8 * (r >> 2));
            p0[r] = fmaf(fabsf(x - c0), -slope2, -smax2); p1[r] = fmaf(fabsf(x - (c0 + 32.f)), -slope2, -smax2); }
#pragma unroll
        for (int d0 = 0; d0 < 4; ++d0) { const int cb = (c * 64 + d0 * 16 + hi * 8) * 2;
            const bf16x8 k0 = *(const bf16x8*)(Ks + KSWZ(r32, cb)), k1 = *(const bf16x8*)(Ks + KSWZ(32 + r32, cb));
            p0 = __builtin_amdgcn_mfma_f32_32x32x16_bf16(k0, qr[d0], p0, 0, 0, 0);
            p1 = __builtin_amdgcn_mfma_f32_32x32x16_bf16(k1, qr[d0], p1, 0, 0, 0); }
        bf16x8 pa0, pa1, pa2, pa3;
        at_softmax(p0, p1, l, pa0, pa1, pa2, pa3);
        const int vb = vb0 + buf * 16384;
        pv_one<0>(o[0], vb, pa0, pa1, pa2, pa3); pv_one<1>(o[1], vb, pa0, pa1, pa2, pa3); pv_one<2>(o[2], vb, pa0, pa1, pa2, pa3); pv_one<3>(o[3], vb, pa0, pa1, pa2, pa3);
        if (j + 1 < NT) AT_WRITE(buf ^ 1);
        __syncthreads();
    }
#undef AT_LOAD
#undef AT_WRITE
    l += __shfl_xor(l, 32);
    float* wsf = (float*)(lds + AT_WS) + wid * 32;
    float* exch = (float*)lds + grp * 4096;
    if (hi == 0) wsf[r32] = l;
    asm volatile("s_waitcnt lgkmcnt(0)" ::: "memory");
    float rl[16];
#pragma unroll
    for (int r = 0; r < 16; ++r) rl[r] = __builtin_amdgcn_rcpf(wsf[crow(r, hi)]) * (c ? lam : 1.0f);
    if (c == 1) {
#pragma unroll
        for (int d = 0; d < 4; ++d)
#pragma unroll
            for (int r = 0; r < 16; ++r) exch[(d * 16 + r) * 64 + lane] = o[d][r] * rl[r];
    }
    __syncthreads();
    if (c == 0) {
        float ss[16];
#pragma unroll
        for (int r = 0; r < 16; ++r) { float sacc = 0.f;
#pragma unroll
            for (int d = 0; d < 4; ++d) { const float v = o[d][r] * rl[r] - exch[(d * 16 + r) * 64 + lane]; o[d][r] = v; sacc += v * v; }
            ss[r] = sacc; }
#pragma unroll
        for (int r = 0; r < 16; ++r) {
#pragma unroll
            for (int m = 16; m >= 1; m >>= 1) ss[r] += __shfl_xor(ss[r], m);
        }
        bf16_t* Ob = (bf16_t*)(P.ws + WS_O) + (size_t)(b * SEQ + i0 + grp * 32) * 1024 + C_RW + h * 128;
        float sg[4];
#pragma unroll
        for (int d = 0; d < 4; ++d) sg[d] = P.da_subln_g[d * 32 + r32] * 0.8f;
#pragma unroll
        for (int r = 0; r < 16; ++r) { const float rn = __builtin_amdgcn_rsqf(ss[r] * (1.f / 128.f) + NORM_EPS); bf16_t* op = Ob + (size_t)crow(r, hi) * 1024 + r32;
#pragma unroll
            for (int d = 0; d < 4; ++d) op[d * 32] = f2bf(o[d][r] * rn * sg[d]); }
    }
}

constexpr int RW_W2T = 0, RW_A2T = 2 * 64 * 72 * 2, RW_G2T = 4 * 64 * 72 * 2;
constexpr int RW_XA = RW_G2T + 64 * 136 * 2;
constexpr int RW_LORA = RW_XA + 11264;
constexpr int RW_YP = RW_LORA + 16384;
constexpr int RW_ZS = RW_YP + 32768;
constexpr int RW_STEP = RW_ZS + 12288;
constexpr int RW_SAX = RW_STEP + 16384;
constexpr int RW_END = RW_SAX + 4096;

DI void rwkv_task(const Params& P, unsigned char* lds, int b, int h) {
    int tid_ = threadIdx.x; asm volatile("" : "+v"(tid_));
    const int tid = tid_, wid = tid >> 6, lane = tid & 63;
    const bf16_t* Zb = (const bf16_t*)(P.ws + WS_Z) + (size_t)b * SEQ * IN_COLS;
    float* Ysc = (float*)(P.ws + WS_U) + (size_t)b * SEQ * 512 + h * 64;
    bf16_t* Ob = (bf16_t*)(P.ws + WS_O) + (size_t)b * SEQ * 1024 + h * 64;
    const int hc = h * 64;
    __syncthreads();
    for (int i = tid; i < 2 * 64 * 64; i += 512) { const int d = i >> 12, r = (i >> 6) & 63, c = i & 63;
        ((bf16_t*)(lds + RW_W2T))[(d * 64 + c) * 72 + r] = f2bf(P.rw_w2[(size_t)(d * 64 + r) * 512 + hc + c]);
        ((bf16_t*)(lds + RW_A2T))[(d * 64 + c) * 72 + r] = f2bf(P.rw_a2[(size_t)(d * 64 + r) * 512 + hc + c]); }
    for (int i = tid; i < 128 * 64; i += 512) { const int r = i >> 6, c = i & 63; ((bf16_t*)(lds + RW_G2T))[c * 136 + r] = f2bf(P.rw_g2[(size_t)r * 512 + hc + c]); }
    float S[2][8];
#pragma unroll
    for (int d = 0; d < 2; ++d)
#pragma unroll
        for (int i = 0; i < 8; ++i) S[d][i] = 0.f;
    float* zs = (float*)(lds + RW_ZS); float* st = (float*)(lds + RW_STEP); float* lora = (float*)(lds + RW_LORA); float* sax = (float*)(lds + RW_SAX); float* yp_l = (float*)(lds + RW_YP);
    bf16_t* xa = (bf16_t*)(lds + RW_XA);
    const float kk_c = P.rw_k_k[hc + lane], ka_c = P.rw_k_a[hc + lane], rk_c = P.rw_r_k[hc + lane], lng_c = P.rw_ln_g[hc + lane], lnb_c = P.rw_ln_b[hc + lane];
    for (int s = 0; s < SEQ / 16; ++s) {
        const bool fin = s >= SEQ / 32;
#pragma unroll
        for (int d = 0; d < 2; ++d) {
            const int c16 = d ? (SEQ / 16 - 1 - s) : s;
            const float w0_c = P.rw_w0[d * 512 + hc + lane], a0_c = P.rw_a0[d * 512 + hc + lane], a0o_c = P.rw_a0[(1 - d) * 512 + hc + lane];
            __syncthreads();
            for (int it = tid; it < 16 * 64; it += 512) {
                const int i = it >> 6, cg = it & 63;
                if (!fin && cg >= 40) continue;
                const int t = d ? (c16 * 16 + 15 - i) : (c16 * 16 + i);
                int col; if (cg < 8) col = ZR + hc + cg * 8; else if (cg < 16) col = ZK + hc + (cg - 8) * 8; else if (cg < 24) col = ZV + hc + (cg - 16) * 8;
                else if (cg < 32) col = ZWD + d * 64 + (cg - 24) * 8; else if (cg < 40) col = ZAD + d * 64 + (cg - 32) * 8; else if (cg < 48) col = ZAD + (1 - d) * 64 + (cg - 40) * 8; else col = ZGD + (cg - 48) * 8;
                const bf16_t* zp = Zb + (size_t)t * IN_COLS + col;
                const u32x4 vc = *(const u32x4*)zp; u32x4 vp = {0u, 0u, 0u, 0u}, vn = {0u, 0u, 0u, 0u};
                if (t > 0) vp = *(const u32x4*)(zp - IN_COLS);
                if (t < SEQ - 1) vn = *(const u32x4*)(zp + IN_COLS);
                const f32x4 mu0 = *(const f32x4*)(P.rw_mu + col), mu1 = *(const f32x4*)(P.rw_mu + col + 4);
                float f[8];
#pragma unroll
                for (int q = 0; q < 4; ++q) {
                    const float c0 = bf_lo(vc[q]), c1 = bf_hi(vc[q]);
                    const float m0 = q < 2 ? mu0[2 * q] : mu1[2 * q - 4], m1 = q < 2 ? mu0[2 * q + 1] : mu1[2 * q - 3];
                    f[2 * q] = c0 + (0.5f * (bf_lo(vp[q]) + bf_lo(vn[q])) - c0) * m0; f[2 * q + 1] = c1 + (0.5f * (bf_hi(vp[q]) + bf_hi(vn[q])) - c1) * m1;
                }
                if (cg < 24) { float* dst = zs + ((cg >> 3) * 16 + i) * 64 + (cg & 7) * 8;
#pragma unroll
                    for (int q = 0; q < 8; ++q) dst[q] = f[q]; }
                else {
                    bf16_t* dst;
                    if (cg < 32) { dst = xa + i * 72 + (cg - 24) * 8;
#pragma unroll
                        for (int q = 0; q < 8; ++q) f[q] = tanhf(f[q]); }
                    else if (cg < 40) dst = xa + 1152 + i * 72 + (cg - 32) * 8;
                    else if (cg < 48) dst = xa + 2304 + i * 72 + (cg - 40) * 8;
                    else { dst = xa + 3456 + i * 136 + (cg - 48) * 8;
#pragma unroll
                        for (int q = 0; q < 8; ++q) f[q] = sigmoidf_(f[q]); }
                    u32x4 ov = {cvt_pk(f[0], f[1]), cvt_pk(f[2], f[3]), cvt_pk(f[4], f[5]), cvt_pk(f[6], f[7])}; *(u32x4*)dst = ov;
                }
            }
            __syncthreads();
            for (int job = wid; job < (fin ? 16 : 8); job += 8) {
                const int mat = job >> 2, nt = job & 3, fr = lane & 15, fq = lane >> 4;
                const bf16_t* X = xa + (mat == 0 ? 0 : mat == 1 ? 1152 : mat == 2 ? 2304 : 3456); const int xs = mat == 3 ? 136 : 72;
                const bf16_t* Wt = (const bf16_t*)(lds + (mat == 0 ? RW_W2T + d * 64 * 72 * 2 : mat == 1 ? RW_A2T + d * 64 * 72 * 2 : mat == 2 ? RW_A2T + (1 - d) * 64 * 72 * 2 : RW_G2T));
                f32x4 acc = {0.f, 0.f, 0.f, 0.f};
                const int nks = mat == 3 ? 4 : 2;
                for (int ks = 0; ks < nks; ++ks) {
                    const bf16x8 af = *(const bf16x8*)(X + fr * xs + ks * 32 + fq * 8), bfm = *(const bf16x8*)(Wt + (nt * 16 + fr) * xs + ks * 32 + fq * 8);
                    acc = __builtin_amdgcn_mfma_f32_16x16x32_bf16(af, bfm, acc, 0, 0, 0);
                }
#pragma unroll
                for (int j = 0; j < 4; ++j) lora[(mat * 16 + fq * 4 + j) * 64 + nt * 16 + fr] = acc[j];
            }
            __syncthreads();
#pragma unroll
            for (int q = 0; q < 2; ++q) { const int i = wid * 2 + q, c = lane;
                const float wl = w0_c + lora[(0 * 16 + i) * 64 + c];
                const float sp = fmaxf(-wl, 0.f) + log1pf(__expf(-fabsf(wl)));
                const float decay = __expf(-__expf(-sp - 0.5f));
                const float a = sigmoidf_(a0_c + lora[(1 * 16 + i) * 64 + c]);
                const float k = zs[(1 * 16 + i) * 64 + c]; float kk = k * kk_c;
                const float n2 = wave_sum(kk * kk); kk *= __builtin_amdgcn_rsqf(n2 + 1e-12f);
                st[(0 * 16 + i) * 64 + c] = decay; st[(1 * 16 + i) * 64 + c] = k * (1.f + (a - 1.f) * ka_c); st[(2 * 16 + i) * 64 + c] = -kk; st[(3 * 16 + i) * 64 + c] = kk * a;
            }
            __syncthreads();
            for (int i = 0; i < 16; ++i) {
                const float* wv = st + (0 * 16 + i) * 64 + wid * 8; const float* kdv = st + (1 * 16 + i) * 64 + wid * 8; const float* nav = st + (2 * 16 + i) * 64 + wid * 8; const float* bv = st + (3 * 16 + i) * 64 + wid * 8;
                const float* rv = zs + (0 * 16 + i) * 64 + wid * 8; const float vv = zs[(2 * 16 + i) * 64 + lane];
                float sp = 0.f;
#pragma unroll
                for (int q = 0; q < 8; ++q) sp += S[d][q] * nav[q];
                float* sx = sax + (i & 1) * 512;
                sx[wid * 64 + lane] = sp;
                __syncthreads();
                float sa = 0.f;
#pragma unroll
                for (int w = 0; w < 8; ++w) sa += sx[w * 64 + lane];
                float yp = 0.f;
#pragma unroll
                for (int q = 0; q < 8; ++q) { S[d][q] = S[d][q] * wv[q] + sa * bv[q] + vv * kdv[q]; yp += S[d][q] * rv[q]; }
                yp_l[(wid * 16 + i) * 64 + lane] = yp;
            }
            __syncthreads();
#pragma unroll
            for (int q = 0; q < 2; ++q) { const int i = wid * 2 + q, c = lane; const int t = d ? (c16 * 16 + 15 - i) : (c16 * 16 + i);
                float y = 0.f;
#pragma unroll
                for (int w = 0; w < 8; ++w) y += yp_l[(w * 16 + i) * 64 + c];
                if (!fin) Ysc[(size_t)t * 512 + c] = y;
                else {
                    y += Ysc[(size_t)t * 512 + c];
                    const float mean = wave_sum(y) * (1.f / 64.f); const float dv = y - mean; const float var = wave_sum(dv * dv) * (1.f / 64.f);
                    const float gn = dv * __builtin_amdgcn_rsqf(var + 64e-5f) * lng_c + lnb_c;
                    const float a = sigmoidf_(a0_c + lora[(1 * 16 + i) * 64 + c]), ao = sigmoidf_(a0o_c + lora[(2 * 16 + i) * 64 + c]);
                    const float r = zs[(0 * 16 + i) * 64 + c], k = zs[(1 * 16 + i) * 64 + c], v = zs[(2 * 16 + i) * 64 + c];
                    const float kb = k * (1.f + (0.5f * (a + ao) - 1.f) * ka_c);
                    const float bon = wave_sum(r * kb * rk_c);
                    const float g = lora[(3 * 16 + i) * 64 + c];
                    Ob[(size_t)t * 1024 + c] = f2bf((gn + bon * v) * g);
                }
            }
        }
    }
}

DI void phase_mixer(const Params& P, unsigned char* lds) {
    const int lane = threadIdx.x & 63;
    const float lam = __expf(wave_sum(P.da_lq1[lane] * P.da_lk1[lane])) - __expf(wave_sum(P.da_lq2[lane] * P.da_lk2[lane])) + 0.2f;
    float mq = fabsf(P.da_q_norm_g[lane]), mk = fabsf(P.da_k_norm_g[lane]);
#pragma unroll
    for (int o = 32; o >= 1; o >>= 1) { mq = fmaxf(mq, __shfl_xor(mq, o)); mk = fmaxf(mk, __shfl_xor(mk, o)); }
    const float smax = 8.0f * mq * mk * 1.01f, smax2 = smax * LOG2E;
    unsigned* qhead = (unsigned*)(P.ws + WS_CTL) + CW_QUEUE;
    volatile unsigned* qw = (volatile unsigned*)(lds + LDS_QW);
    for (;;) {
        __syncthreads();
        if (threadIdx.x == 0) *qw = atomicAdd(qhead, 1u);
        __syncthreads();
        const unsigned idx = *qw;
        if (idx >= 64u + 2048u) break;
#if !defined(MIX_ONLY) || MIX_ONLY == 1
        if (idx < 64u) rwkv_task(P, lds, (int)(idx >> 3), (int)(idx & 7));
#endif
#if !defined(MIX_ONLY) || MIX_ONLY == 2
        if (idx >= 64u) { const unsigned u = idx - 64u; const int h = 3 - (int)(u >> 9), b = (int)((u >> 6) & 7), qb = (int)(u & 63);
            const float slope = exp2f(-2.0f * (float)(h + 1)); int W = (int)ceilf((25.65f + 2.0f * smax) / slope); if (W > SEQ) W = SEQ;
            attn_unit(P, lds, b, h, qb, lam, smax2, W); }
#endif
    }
}

constexpr int N_PHASES = 13;
__global__ void __launch_bounds__(512, 2) mega(Params P) {
    extern __shared__ __attribute__((aligned(16))) unsigned char shm[];
    LAS unsigned char* lds = (LAS unsigned char*)shm;
    unsigned char* ws = P.ws;
    if (threadIdx.x == 0) *(LAS u32x4*)(lds + LDS_XB) = (u32x4){0u, 0u, 0u, 0u};
    __syncthreads();
    XcdBarrier bar = xcd_barrier_post((unsigned*)(ws + WS_CTL) + CW_BAR + (size_t)P.ph_lo * 0, (volatile LAS unsigned*)(lds + LDS_XB));
#ifndef ONLY_PHASE
#define RUN(k) (P.ph_lo <= (k) && (k) < P.ph_hi)
#else
#define RUN(k) ((k) == ONLY_PHASE && P.ph_lo <= (k) && (k) < P.ph_hi)
#endif
#define SYNC(k) do { if (P.ph_lo <= (k) && (k) + 1 < P.ph_hi) xcd_barrier(bar); } while (0)
    if (RUN(0)) phase_prep(P, shm);
    SYNC(0);
    if (RUN(1)) { DenseOrder S; S.init(ws + WS_U, ws + WS_WIN, MTOK, IN_PAD, 2048, 2048); EpiZ E{(bf16_t*)(ws + WS_Z)}; gemm_phase<false>(lds, 1024, 1024, S, E); }
    SYNC(1);
    if (RUN(2)) phase_qknorm(P);
    SYNC(2);
    if (RUN(3)) phase_mixer(P, shm);
    SYNC(3);
    if (RUN(4)) { DenseOrder S; S.init(ws + WS_O, ws + WS_WOUT, MTOK, 1024, 2048, 2048); EpiH1 E{P.x, P.out}; gemm_phase<false>(lds, 1024, 1024, S, E); }
    SYNC(4);
    if (RUN(5)) phase_route(P, lds);
    SYNC(5);
    if (RUN(6)) { moe_tables(lds, (const unsigned*)(ws + WS_CTL) + CW_CNT);
        MoeOrder<8, true> S{(const char*)(ws + WS_U), (const char*)(ws + WS_W1), (size_t)2048 * 1024 * 2, 0, 128, (int)gridDim.x, (int)blockIdx.x, lds, (const int*)(ws + WS_LIST)};
        EpiMoe1 E{(bf16_t*)(ws + WS_Z), P.b1}; gemm_phase<false>(lds, 1024, 1024, S, E); }
    SYNC(6);
#define MOE2(k, s) if (RUN(k)) { moe_tables(lds, (const unsigned*)(ws + WS_CTL) + CW_CNT); \
        MoeOrder<4, false> S{(const char*)(ws + WS_Z), (const char*)(ws + WS_W2), (size_t)1024 * 1024 * 2, 32 * (s), 32, (int)gridDim.x, (int)blockIdx.x, lds, (const int*)(ws + WS_LIST)}; \
        EpiMoe2 E{P.out, (bf16_t*)(ws + WS_U), P.b2, (const int*)(ws + WS_LIST), (const float*)(ws + WS_GATE), (s)}; gemm_phase<false>(lds, 1024, 1024, S, E); } SYNC(k);
    MOE2(7, 0) MOE2(8, 1) MOE2(9, 2) MOE2(10, 3)
    if (RUN(11)) { DenseOrder S; S.init(ws + WS_PB, ws + WS_WPLE, MTOK, 1024, 512, 512); EpiPle E{(bf16_t*)(ws + WS_Z), (float*)(ws + WS_ESS)}; gemm_phase<true>(lds, 256, 256, S, E); }
    SYNC(11);
    if (RUN(12)) { DenseOrder S; S.init(ws + WS_U, ws + WS_WG, MTOK, 1024, 2048, 2048); EpiFinal E{P.out, (const bf16_t*)(ws + WS_Z), (const float*)(ws + WS_ESS), P.ple_norm_g}; gemm_phase<false>(lds, 1024, 1024, S, E); }
}

#ifndef MK_N_LAUNCHES
#define MK_N_LAUNCHES 1
#endif
extern "C" void kernel_launch(void* const* d_in, const int* in_sizes, int n_in, void* d_out, int out_size, void* d_ws, size_t ws_size, hipStream_t stream) {
    static int grid = 0;
    if (grid == 0) {
        if (n_in != 33 || in_sizes[0] != MTOK * D_MODEL || out_size != MTOK * D_MODEL || ws_size < WS_END) {
            fprintf(stderr, "kernel_launch: shape mismatch: n_in %d in0 %d out %d ws %zu (need %zu)\n", n_in, n_in > 0 ? in_sizes[0] : -1, out_size, ws_size, (size_t)WS_END); grid = -1; return; }
        int dev = 0, cus = 0, per_cu = 0;
        if (hipGetDevice(&dev) != hipSuccess || hipDeviceGetAttribute(&cus, hipDeviceAttributeMultiprocessorCount, dev) != hipSuccess) { grid = -1; return; }
        if (hipFuncSetAttribute((const void*)mega, hipFuncAttributeMaxDynamicSharedMemorySize, LDS_BYTES) != hipSuccess) { fprintf(stderr, "kernel_launch: hipFuncSetAttribute failed\n"); grid = -1; return; }
        if (hipOccupancyMaxActiveBlocksPerMultiprocessor(&per_cu, (const void*)mega, 512, LDS_BYTES) != hipSuccess || per_cu < 1) fprintf(stderr, "kernel_launch: occupancy query says %d\n", per_cu);
        (void)hipGetLastError();
        grid = cus;
    }
    if (grid < 0) return;
    (void)hipMemsetAsync((char*)d_ws + WS_CTL, 0, CTL_BYTES, stream);
    (void)hipMemsetAsync((char*)d_ws + WS_ESS, 0, (size_t)MTOK * 4, stream);
    Params p{};
    const float** f = (const float**)&p;
    for (int i = 0; i < 33; ++i) f[i] = (const float*)d_in[i];
    p.out = (float*)d_out; p.ws = (unsigned char*)d_ws;
    if (MK_N_LAUNCHES == 1) { p.ph_lo = 0; p.ph_hi = N_PHASES; hipLaunchKernelGGL(mega, dim3(grid), dim3(512), LDS_BYTES, stream, p); }
    else for (int k = 0; k < N_PHASES; ++k) { p.ph_lo = k; p.ph_hi = k + 1; hipLaunchKernelGGL(mega, dim3(grid), dim3(512), LDS_BYTES, stream, p); }
    const hipError_t le = hipPeekAtLastError();
    if (le != hipSuccess) fprintf(stderr, "kernel_launch: launch failed: %s\n", hipGetErrorName(le));
}
```

```cpp
#include <hip/hip_runtime.h>
#include <stdint.h>
#include <stdio.h>

#define LAS __attribute__((address_space(3)))
#define DI __device__ __forceinline__
typedef unsigned short bf16_t;
typedef short bf16x8 __attribute__((ext_vector_type(8)));
typedef short s16x4 __attribute__((ext_vector_type(4)));
typedef float f32x4 __attribute__((ext_vector_type(4)));
typedef float f32x2 __attribute__((ext_vector_type(2)));
typedef float f32x16 __attribute__((ext_vector_type(16)));
typedef unsigned u32x4 __attribute__((ext_vector_type(4)));
typedef unsigned u32x2 __attribute__((ext_vector_type(2)));
typedef __bf16 bf16x2_t __attribute__((ext_vector_type(2)));

constexpr int D_MODEL = 1024, BATCH = 8, SEQ = 8192, MTOK = BATCH * SEQ;
constexpr int PLE_DIM = 256;
constexpr int C_RW = 512, RW_HEAD = 64, RW_HEADS = 8, RW_COLS = 1920;
constexpr int C_DA = 512, DA_HEADS = 4, DA_V = 128, DA_QK = 64;
constexpr int IN_COLS = 3456, IN_PAD = 3584;
constexpr int N_EXP = 32, TOPK = 4, D_FF = 1024;
constexpr int ZR = 0, ZK = 512, ZV = 1024, ZWD = 1536, ZAD = 1664, ZGD = 1792, ZQ = 1920, ZKK = 2432, ZVV = 2944;
constexpr float NORM_EPS = 1e-6f;
constexpr float LOG2E = 1.4426950408889634f;

constexpr size_t MiB = 1024ull * 1024ull;
constexpr size_t WS_CTL = 0;
constexpr size_t CTL_BYTES = 64 * 1024;
constexpr size_t WS_WIN = WS_CTL + CTL_BYTES;
constexpr size_t WS_WOUT = WS_WIN + (size_t)IN_PAD * 1024 * 2;
constexpr size_t WS_W1 = WS_WOUT + 2 * MiB;
constexpr size_t WS_W2 = WS_W1 + 128 * MiB;
constexpr size_t WS_WPLE = WS_W2 + 64 * MiB;
constexpr size_t WS_WG = WS_WPLE + MiB / 2;
constexpr size_t WS_PB = WS_WG + 2 * MiB;
constexpr size_t WS_U = WS_PB + 32 * MiB;
constexpr size_t WS_Z = WS_U + 128 * MiB;
constexpr size_t WS_O = WS_Z + 432 * MiB;
constexpr size_t WS_LIST = WS_Z + 576 * MiB;
constexpr size_t WS_GATE = WS_LIST + 32 * MiB;
constexpr size_t WS_ESS = WS_GATE + MiB;
constexpr size_t WS_XL = WS_ESS + MiB / 4;
constexpr size_t WS_END = WS_XL + 48 * MiB;
constexpr int ACT_ROWS_MAX = 262144 + 128 * 256;

constexpr int CW_BAR = 0;
constexpr int CW_CNT = 4096;
constexpr int CW_QUEUE = 4352;
constexpr int CW_LAM = 4416;
constexpr int CW_RWFLAG = 4480;

struct Params {
    const float* x; const float* p; const float* norm_mix_g; const float* w_in; const float* rw_mu; const float* rw_w0; const float* rw_w2;
    const float* rw_a0; const float* rw_a2; const float* rw_g2; const float* rw_k_k; const float* rw_k_a; const float* rw_r_k; const float* rw_ln_g;
    const float* rw_ln_b; const float* da_q_norm_g; const float* da_k_norm_g; const float* da_lq1; const float* da_lk1; const float* da_lq2;
    const float* da_lk2; const float* da_subln_g; const float* w_out; const float* norm_ffn_g; const float* w_router; const float* b_router;
    const float* w1; const float* b1; const float* w2; const float* b2; const float* w_ple; const float* ple_norm_g; const float* w_ple_gate;
    float* out; unsigned char* ws; int ph_lo, ph_hi;
};

DI unsigned cvt_pk(float lo, float hi) { f32x2 v = {lo, hi}; bf16x2_t r = __builtin_convertvector(v, bf16x2_t); return __builtin_bit_cast(unsigned, r); }
DI float bf_lo(unsigned u) { return __uint_as_float(u << 16); }
DI float bf_hi(unsigned u) { return __uint_as_float(u & 0xffff0000u); }
DI float bf2f(bf16_t b) { return __uint_as_float(((unsigned)b) << 16); }
DI bf16_t f2bf(float f) { return (bf16_t)(cvt_pk(f, f) & 0xffffu); }
template <int CTRL, int RM> DI float dpp_mov0(float v) { return __builtin_bit_cast(float, __builtin_amdgcn_update_dpp(0, __builtin_bit_cast(int, v), CTRL, RM, 0xF, false)); }
DI float row_sum16(float v) {
    v += dpp_mov0<0x121, 0xF>(v); v += dpp_mov0<0x122, 0xF>(v); v += dpp_mov0<0x124, 0xF>(v); v += dpp_mov0<0x128, 0xF>(v); return v;
}
DI float wave_sum(float v) {
    v = row_sum16(v);
    v += dpp_mov0<0x142, 0xA>(v);
    v += dpp_mov0<0x143, 0xC>(v);
    return __builtin_bit_cast(float, __builtin_amdgcn_readlane(__builtin_bit_cast(int, v), 63));
}
DI float sigmoidf_(float x) { return __builtin_amdgcn_rcpf(1.f + __builtin_amdgcn_exp2f(-x * LOG2E)); }

#define XB_TMO      128
#define XB_XCNT(j)  (256  + 64 * (j))
#define XB_XSUB(j)  (1280 + 64 * (j))
#define XB_XGEN(j)  (2304 + 64 * (j))
#define XB_TOP      3328
#define XB_TOPGEN   3392
#define XCD_BAR_WORDS 3456
#define XB_SPIN_CAP (1u << 22)
DI unsigned xb_ld(unsigned* p)              { return __hip_atomic_load(p, __ATOMIC_RELAXED, __HIP_MEMORY_SCOPE_AGENT); }
DI unsigned xb_add(unsigned* p, unsigned v) { return __hip_atomic_fetch_add(p, v, __ATOMIC_RELAXED, __HIP_MEMORY_SCOPE_AGENT); }
DI unsigned xb_xcc_id() { return (unsigned)__builtin_amdgcn_s_getreg((3 << 11) | 20) & 0xFu; }
#define XB_SPIN(cond, bar) do { unsigned _sp = 0; while (cond) { __builtin_amdgcn_s_sleep(1); \
    if ((++_sp & 255u) == 0u) { if (xb_ld(&(bar)[XB_TMO])) break; if (_sp > XB_SPIN_CAP) { atomicAdd(&(bar)[XB_TMO], 1u); break; } } } } while (0)
struct XcdBarrier { unsigned* bar; unsigned x; volatile LAS unsigned* st; };
DI XcdBarrier xcd_barrier_post(unsigned* bar, volatile LAS unsigned* st) {
    XcdBarrier b; b.bar = bar; b.x = xb_xcc_id(); b.st = st;
    if (threadIdx.x == 0) (void)xb_add(&bar[XB_XCNT(b.x)], 1u);
    return b;
}
DI void xcd_barrier_complete(unsigned* bar, unsigned x, unsigned& nloc, unsigned& nx) {
    const unsigned G = gridDim.x * gridDim.y * gridDim.z;
    unsigned sum, cnt, mine, sp = 0u;
    for (;;) {
        sum = 0u; cnt = 0u; mine = 0u;
#pragma unroll
        for (unsigned j = 0; j < 16; ++j) { const unsigned c = xb_ld(&bar[XB_XCNT(j)]); sum += c; cnt += (c > 0u) ? 1u : 0u; mine = (j == x) ? c : mine; }
        if (sum == G) break;
        __builtin_amdgcn_s_sleep(1);
        if ((++sp & 255u) == 0u) { if (xb_ld(&bar[XB_TMO])) break; if (sp > XB_SPIN_CAP) { atomicAdd(&bar[XB_TMO], 1u); break; } }
    }
    nloc = mine > 0u ? mine : 1u; nx = cnt > 0u ? cnt : 1u;
}
DI void xcd_barrier(const XcdBarrier& b) {
    asm volatile("s_waitcnt vmcnt(0)" ::: "memory");
    __syncthreads();
    if (threadIdx.x == 0) {
        unsigned* bar = b.bar;
        __builtin_amdgcn_s_waitcnt(0);
        unsigned nloc = b.st[0], nx = b.st[1];
        if (nloc == 0u) { xcd_barrier_complete(bar, b.x, nloc, nx); b.st[0] = nloc; b.st[1] = nx; }
        const unsigned old = xb_add(&bar[XB_XSUB(b.x)], 1u);
        const unsigned gen = old / nloc;
        if (old + 1u == (gen + 1u) * nloc) {
            __builtin_amdgcn_fence(__ATOMIC_RELEASE, "agent");
            asm volatile("s_waitcnt vmcnt(0)" ::: "memory");
            const unsigned og = xb_add(&bar[XB_TOP], 1u);
            const unsigned tg = og / nx;
            if (og + 1u == (tg + 1u) * nx) xb_add(&bar[XB_TOPGEN], 1u);
            else XB_SPIN(xb_ld(&bar[XB_TOPGEN]) == tg, bar);
            __builtin_amdgcn_fence(__ATOMIC_ACQUIRE, "agent");
            xb_add(&bar[XB_XGEN(b.x)], 1u);
            asm volatile("s_waitcnt vmcnt(0)" ::: "memory");
        } else {
            XB_SPIN(xb_ld(&bar[XB_XGEN(b.x)]) == gen, bar);
            __builtin_amdgcn_fence(__ATOMIC_ACQUIRE, "agent");
            asm volatile("s_waitcnt vmcnt(0)" ::: "memory");
        }
    }
    __syncthreads();
}

constexpr int BM = 256, BK = 64, HALF = 128, HTB = HALF * BK * 2, STAGE_BYTES = 8 * HTB, NXCD = 8, WGM = 8;
constexpr int LDS_TAB = STAGE_BYTES;
constexpr int LDS_GRP = STAGE_BYTES + 2048;
constexpr int LDS_BYTES = 156 * 1024;
constexpr int LDS_XB = LDS_BYTES - 16;
constexpr int LDS_QW = LDS_BYTES - 32;

DI void tconv_tile(const float* __restrict__ src, int ldn, int k0, int ncol0, bool zero, bf16_t* __restrict__ dst, int K, int nrow0, float* tile  ) {
    const int t = threadIdx.x;
    {
        const int kk = t >> 4, c4 = (t & 15) * 4;
#pragma unroll
        for (int i = 0; i < 2; ++i) {
            const int k = kk + 32 * i;
            f32x4 v = {0.f, 0.f, 0.f, 0.f};
            if (!zero) v = *(const f32x4*)(src + (size_t)(k0 + k) * ldn + ncol0 + c4);
            tile[(c4 + 0) * 65 + k] = v[0]; tile[(c4 + 1) * 65 + k] = v[1]; tile[(c4 + 2) * 65 + k] = v[2]; tile[(c4 + 3) * 65 + k] = v[3];
        }
    }
    __syncthreads();
    {
        const int n = t >> 3, kc = (t & 7) * 8;
        const float* r = tile + n * 65 + kc;
        u32x4 o = {cvt_pk(r[0], r[1]), cvt_pk(r[2], r[3]), cvt_pk(r[4], r[5]), cvt_pk(r[6], r[7])};
        *(u32x4*)(dst + (size_t)(nrow0 + n) * K + k0 + kc) = o;
    }
    __syncthreads();
}

DI void phase_prep(const Params& P, unsigned char* lds_generic) {
    float* tile = (float*)lds_generic;
    const int wg = blockIdx.x, nwg = gridDim.x;
    unsigned char* ws = P.ws;
    constexpr int J0 = 16 * 56, J1 = J0 + 256, J2 = J1 + 32 * 16 * 32, J3 = J2 + 32 * 16 * 16, J4 = J3 + 64, J5 = J4 + 256;
    for (int j = wg; j < J5; j += nwg) {
        if (j < J0) { const int kt = j / 56, nt = j % 56; tconv_tile(P.w_in, IN_COLS, kt * 64, nt * 64, nt >= 54, (bf16_t*)(ws + WS_WIN), 1024, nt * 64, tile); }
        else if (j < J1) { const int q = j - J0, kt = q >> 4, nt = q & 15; tconv_tile(P.w_out, 1024, kt * 64, nt * 64, false, (bf16_t*)(ws + WS_WOUT), 1024, nt * 64, tile); }
        else if (j < J2) { const int q = j - J1, e = q >> 9, r = q & 511, kt = r >> 5, nt = r & 31; const int n0 = nt * 64;
            const int orig = ((n0 & 128) ? 1024 : 0) + (n0 >> 8) * 128 + (n0 & 127);
            tconv_tile(P.w1 + (size_t)e * 1024 * 2048, 2048, kt * 64, orig, false, (bf16_t*)(ws + WS_W1) + (size_t)e * 2048 * 1024, 1024, n0, tile); }
        else if (j < J3) { const int q = j - J2, e = q >> 8, r = q & 255, kt = r >> 4, nt = r & 15;
            tconv_tile(P.w2 + (size_t)e * 1024 * 1024, 1024, kt * 64, nt * 64, false, (bf16_t*)(ws + WS_W2) + (size_t)e * 1024 * 1024, 1024, nt * 64, tile); }
        else if (j < J4) { const int q = j - J3, kt = q >> 4, nt = q & 15; tconv_tile(P.w_ple, 1024, kt * 64, nt * 64, false, (bf16_t*)(ws + WS_WPLE), 256, nt * 64, tile); }
        else { const int q = j - J4, kt = q >> 4, nt = q & 15; tconv_tile(P.w_ple_gate, 1024, kt * 64, nt * 64, false, (bf16_t*)(ws + WS_WG), 1024, nt * 64, tile); }
    }
    {
        const int wid = threadIdx.x >> 6, lane = threadIdx.x & 63;
        f32x4 g[4];
#pragma unroll
        for (int i = 0; i < 4; ++i) g[i] = *(const f32x4*)(P.norm_mix_g + 4 * lane + 256 * i);
        bf16_t* U = (bf16_t*)(ws + WS_U);
        for (int row = wg * 8 + wid; row < MTOK; row += nwg * 8) {
            const float* xr = P.x + (size_t)row * 1024;
            f32x4 v[4]; float ss = 0.f;
#pragma unroll
            for (int i = 0; i < 4; ++i) { v[i] = *(const f32x4*)(xr + 4 * lane + 256 * i); ss += v[i][0] * v[i][0] + v[i][1] * v[i][1] + v[i][2] * v[i][2] + v[i][3] * v[i][3]; }
            ss = wave_sum(ss);
            const float rinv = __builtin_amdgcn_rsqf(ss * (1.f / 1024.f) + NORM_EPS);
#pragma unroll
            for (int i = 0; i < 4; ++i) {
                u32x2 o = {cvt_pk(v[i][0] * rinv * g[i][0], v[i][1] * rinv * g[i][1]), cvt_pk(v[i][2] * rinv * g[i][2], v[i][3] * rinv * g[i][3])};
                *(u32x2*)(U + (size_t)row * 1024 + 4 * lane + 256 * i) = o;
            }
        }
    }
    {
        bf16_t* PB = (bf16_t*)(ws + WS_PB);
        const size_t n8 = (size_t)MTOK * PLE_DIM / 8;
        for (size_t i = (size_t)wg * 512 + threadIdx.x; i < n8; i += (size_t)nwg * 512) {
            const f32x4 a = *(const f32x4*)(P.p + i * 8), b = *(const f32x4*)(P.p + i * 8 + 4);
            u32x4 o = {cvt_pk(a[0], a[1]), cvt_pk(a[2], a[3]), cvt_pk(b[0], b[1]), cvt_pk(b[2], b[3])};
            *(u32x4*)(PB + i * 8) = o;
        }
    }
}

DI int lds_byte(int r, int c) { const int st = (r >> 4) * 2 + (c >> 5), rr = r & 15, cc = c & 31, ob = rr * 64 + cc * 2; return st * 1024 + (ob ^ (((ob >> 9) & 1) << 5)); }
DI void stage_rc(int b, int& R, int& C) { const int st = b / 1024, sb = b % 1024, swz = sb ^ (((sb >> 9) & 1) << 5); R = (st >> 1) * 16 + swz / 64; C = (st & 1) * 32 + (swz % 64) / 2; }
DI int perm32(int rho) { const int n = rho >> 4, i = rho & 15; return 8 * (i >> 2) + 4 * n + (i & 3); }

struct Unit { const char* A; const char* B; int pm, pn, g, cnt, arow; };
typedef f32x4 AccT[2][2][4][2];

struct DenseOrder {
    const char* A; const char* B; int nM, nN, nwg, G, c; size_t astep, bstep;
    DI void init(const void* A_, const void* B_, int M, int N, int lda_bytes, int ldb_bytes) { A = (const char*)A_; B = (const char*)B_; nM = M / BM; nN = N / BM; nwg = nM * nN; G = gridDim.x; c = blockIdx.x; astep = (size_t)BM * lda_bytes; bstep = (size_t)BM * ldb_bytes; }
    static constexpr bool GATHER = false;
    DI bool next(int i, Unit& u) const {
        const long L = (long)i * G + c; if (L >= nwg) return false;
        int wgid = (int)L; { const int q = nwg / NXCD, r = nwg % NXCD, xcd = wgid % NXCD, off = wgid / NXCD; wgid = (xcd < r ? xcd * (q + 1) : r * (q + 1) + (xcd - r) * q) + off; }
        const int nig = WGM * nN, gid = wgid / nig, fm = gid * WGM, gsz = (nM - fm) < WGM ? (nM - fm) : WGM;
        u.pm = fm + ((wgid % nig) % gsz); u.pn = (wgid % nig) / gsz; u.A = A + (size_t)u.pm * astep; u.B = B + (size_t)u.pn * bstep; u.g = 0; u.cnt = 256; u.arow = u.pm * 256; return true;
    }
    DI void issue_table(const Unit&, LAS unsigned char*) const {}
    DI unsigned row_off(const Unit&, LAS unsigned char*, int) const { return 0u; }
};

#define G_WAIT_V(n) asm volatile("s_waitcnt vmcnt(" #n ")" ::: "memory")
#define G_WAIT_L(n) asm volatile("s_waitcnt lgkmcnt(" #n ")" ::: "memory")
#define G_BAR __builtin_amdgcn_s_barrier()
#define G_SCHED __builtin_amdgcn_sched_barrier(0)

template <bool OPQ, class Sched, class Epi>
DI void gemm_phase(LAS unsigned char* lds, const int K_  , const int lda_  , const Sched& S, const Epi& E) {
    int K = K_, lda = lda_; if constexpr (OPQ) asm volatile("" : "+s"(K), "+s"(lda));
    const int tid = threadIdx.x, wid = __builtin_amdgcn_readfirstlane(tid >> 6), lane = tid & 63, wr = wid >> 2, wc = wid & 3, fr = lane & 15, fq = lane >> 4;
    const int nt = K / BK;
    unsigned vA[2][2], voffB[2]; int R0 = 0, C0 = 0;
#pragma unroll
    for (int i = 0; i < 2; ++i) { int R, C; stage_rc(tid * 16 + i * 8192, R, C); const int Rb = Epi::PERM ? ((R & ~31) + perm32(R & 31)) : R;
        if (i == 0) { R0 = R; C0 = C; } voffB[i] = (unsigned)(Rb * K + C) * 2u;
        vA[0][i] = (unsigned)(R * lda + C) * 2u; vA[1][i] = (unsigned)((R + HALF) * lda + C) * 2u; }
    const size_t kstep = (size_t)(BK * 2);
    const size_t hstepB = (size_t)HALF * K * 2;
    const unsigned ldsw = (unsigned)wid * 1024u;
    const int aoff = lds_byte(wr * 64 + fr, fq * 8), boff = lds_byte(wc * 32 + fr, fq * 8);
#define G_SA(b, h) (((b) * 2 + (h)) * HTB)
#define G_SB(b, h) ((4 + (b) * 2 + (h)) * HTB)
#define G_STAGE(bufoff, gbase, v0, v1) do { \
        __builtin_amdgcn_global_load_lds((const unsigned*)((const char*)(gbase) + (v0)), (LAS unsigned*)(lds + (bufoff) + ldsw), 16, 0, 0); \
        __builtin_amdgcn_global_load_lds((const unsigned*)((const char*)(gbase) + (v1)), (LAS unsigned*)(lds + (bufoff) + ldsw + 8192), 16, 0, 0); } while (0)
#define G_LDA(dst, b, h) do { _Pragma("unroll") for (int m = 0; m < 4; ++m) _Pragma("unroll") for (int k = 0; k < 2; ++k) dst[m][k] = *(const LAS bf16x8*)(lds + G_SA(b, h) + aoff + m * 2048 + k * 1024); } while (0)
#define G_LDB(dst, b, h) do { _Pragma("unroll") for (int n = 0; n < 2; ++n) _Pragma("unroll") for (int k = 0; k < 2; ++k) dst[n][k] = *(const LAS bf16x8*)(lds + G_SB(b, h) + boff + n * 2048 + k * 1024); } while (0)
#define G_MMA(ai, bj, At, Bt) do { __builtin_amdgcn_s_setprio(1); _Pragma("unroll") for (int m = 0; m < 4; ++m) _Pragma("unroll") for (int n = 0; n < 2; ++n) _Pragma("unroll") for (int k = 0; k < 2; ++k) \
        acc[ai][bj][m][n] = __builtin_amdgcn_mfma_f32_16x16x32_bf16(Bt[n][k], At[m][k], acc[ai][bj][m][n], 0, 0, 0); __builtin_amdgcn_s_setprio(0); } while (0)
    Unit cur, nxt; int ui = 0;
    if (!S.next(0, cur)) return;
    AccT acc;
#pragma unroll
    for (int a = 0; a < 2; ++a)
#pragma unroll
        for (int b = 0; b < 2; ++b)
#pragma unroll
            for (int m = 0; m < 4; ++m)
#pragma unroll
                for (int n = 0; n < 2; ++n) acc[a][b][m][n] = (f32x4){0.f, 0.f, 0.f, 0.f};
    bf16x8 At[4][2], B0[2][2], B1[2][2];
    const char* cA = cur.A; const char* cB = cur.B;
    if constexpr (Sched::GATHER) {
        S.issue_table(cur, lds + LDS_TAB);
        G_WAIT_V(0); __syncthreads();
#pragma unroll
        for (int h = 0; h < 2; ++h)
#pragma unroll
            for (int i = 0; i < 2; ++i) { vA[h][i] = S.row_off(cur, lds + LDS_TAB, R0 + 64 * i + HALF * h) + (unsigned)C0 * 2u; }
    }
    G_STAGE(G_SB(0, 0), cB, voffB[0], voffB[1]); G_STAGE(G_SA(0, 0), cA, vA[0][0], vA[0][1]); G_STAGE(G_SB(0, 1), cB + hstepB, voffB[0], voffB[1]); G_STAGE(G_SA(0, 1), cA, vA[1][0], vA[1][1]);
    if (wr == 1) G_BAR;
    G_WAIT_V(4); G_BAR;
    G_STAGE(G_SB(1, 0), cB + kstep, voffB[0], voffB[1]); G_STAGE(G_SA(1, 0), cA + kstep, vA[0][0], vA[0][1]); G_STAGE(G_SB(1, 1), cB + hstepB + kstep, voffB[0], voffB[1]);
    G_WAIT_V(6); G_BAR;
    for (;;) {
        const bool has_next = S.next(ui + 1, nxt);
        const char* nA = has_next ? nxt.A : cA; const char* nB = has_next ? nxt.B : cB;
        for (int t = 0; t < nt; t += 2) {
            const bool last = (t == nt - 2);
            const char* a1 = cA + (size_t)(t + 1) * kstep;
            const char* a2 = last ? nA : cA + (size_t)(t + 2) * kstep; const char* b2 = last ? nB : cB + (size_t)(t + 2) * kstep;
            const char* a3 = a2 + kstep; const char* b3 = b2 + kstep;
            if constexpr (Sched::GATHER) {
                if (t == 0 && has_next) S.issue_table(nxt, lds + LDS_TAB + ((ui + 1) & 1) * 1024);
            }
            G_LDB(B0, 0, 0); G_SCHED; G_LDA(At, 0, 0); G_STAGE(G_SA(1, 1), a1, vA[1][0], vA[1][1]);
            if constexpr (Sched::GATHER) {
                if (last && has_next) {
                    int tz = threadIdx.x; asm volatile("" : "+v"(tz)); int Rz, Cz; stage_rc(tz * 16, Rz, Cz);
#pragma unroll
                    for (int h = 0; h < 2; ++h)
#pragma unroll
                        for (int i = 0; i < 2; ++i) vA[h][i] = S.row_off(nxt, lds + LDS_TAB + ((ui + 1) & 1) * 1024, Rz + 64 * i + HALF * h) + (unsigned)Cz * 2u;
                }
            }
            G_WAIT_L(8); G_BAR; G_WAIT_L(0); G_MMA(0, 0, At, B0); G_BAR; G_SCHED;
            G_LDB(B1, 0, 1); G_STAGE(G_SB(0, 0), b2, voffB[0], voffB[1]);
            G_BAR; G_WAIT_L(0); G_MMA(0, 1, At, B1); G_BAR;
            G_LDA(At, 0, 1); G_STAGE(G_SA(0, 0), a2, vA[0][0], vA[0][1]);
            G_BAR; G_WAIT_L(0); G_MMA(1, 0, At, B0); G_BAR; G_SCHED;
            G_STAGE(G_SB(0, 1), b2 + hstepB, voffB[0], voffB[1]);
            G_WAIT_V(6); G_BAR; G_MMA(1, 1, At, B1); G_BAR;
            G_LDB(B0, 1, 0); G_SCHED; G_LDA(At, 1, 0); G_STAGE(G_SA(0, 1), a2, vA[1][0], vA[1][1]);
            G_WAIT_L(8); G_BAR; G_WAIT_L(0); G_MMA(0, 0, At, B0); G_BAR; G_SCHED;
            G_LDB(B1, 1, 1); G_STAGE(G_SB(1, 0), b3, voffB[0], voffB[1]);
            G_BAR; G_WAIT_L(0); G_MMA(0, 1, At, B1); G_BAR;
            G_LDA(At, 1, 1); G_STAGE(G_SA(1, 0), a3, vA[0][0], vA[0][1]);
            G_BAR; G_WAIT_L(0); G_MMA(1, 0, At, B0); G_BAR; G_SCHED;
            G_STAGE(G_SB(1, 1), b3 + hstepB, voffB[0], voffB[1]);
            G_WAIT_V(6); G_BAR; G_MMA(1, 1, At, B1); G_BAR;
        }
        { int tz = threadIdx.x; asm volatile("" : "+v"(tz)); const int wz = tz >> 6, lz = tz & 63; E(acc, cur, wz >> 2, wz & 3, lz & 15, lz >> 4); }
        if (!has_next) break;
#pragma unroll
        for (int a = 0; a < 2; ++a)
#pragma unroll
            for (int b = 0; b < 2; ++b)
#pragma unroll
                for (int m = 0; m < 4; ++m)
#pragma unroll
                    for (int n = 0; n < 2; ++n) acc[a][b][m][n] = (f32x4){0.f, 0.f, 0.f, 0.f};
        cur = nxt; cA = nA; cB = nB; ++ui;
    }
    G_WAIT_V(0);
    if (wr == 0) G_BAR;
    G_BAR;
}

struct EpiZ {
    static constexpr bool PERM = true;
    bf16_t* Z;
    DI void operator()(const AccT& acc, const Unit& u, int wr, int wc, int fr, int fq) const {
        const int row0 = u.pm * BM + wr * 64 + fr, col0 = u.pn * BM + wc * 32 + 8 * fq;
#pragma unroll
        for (int ai = 0; ai < 2; ++ai)
#pragma unroll
            for (int m = 0; m < 4; ++m) { bf16_t* rowp = Z + (size_t)(row0 + ai * HALF + m * 16) * IN_COLS + col0;
#pragma unroll
                for (int bj = 0; bj < 2; ++bj) { if (col0 + bj * HALF < IN_COLS) { const f32x4 v0 = acc[ai][bj][m][0], v1 = acc[ai][bj][m][1];
                    u32x4 o = {cvt_pk(v0[0], v0[1]), cvt_pk(v0[2], v0[3]), cvt_pk(v1[0], v1[1]), cvt_pk(v1[2], v1[3])}; *(u32x4*)(rowp + bj * HALF) = o; } } }
    }
};
struct EpiH1 {
    static constexpr bool PERM = false;
    const float* X; float* H;
    DI void operator()(const AccT& acc, const Unit& u, int wr, int wc, int fr, int fq) const {
        const int row0 = u.pm * BM + wr * 64 + fr, col0 = u.pn * BM + wc * 32 + 4 * fq;
#pragma unroll
        for (int ai = 0; ai < 2; ++ai)
#pragma unroll
            for (int m = 0; m < 4; ++m) { const size_t ro = (size_t)(row0 + ai * HALF + m * 16) * 1024 + col0;
#pragma unroll
                for (int bj = 0; bj < 2; ++bj)
#pragma unroll
                    for (int n = 0; n < 2; ++n) { const f32x4 xv = *(const f32x4*)(X + ro + bj * HALF + n * 16); *(f32x4*)(H + ro + bj * HALF + n * 16) = xv + acc[ai][bj][m][n]; } }
    }
};
struct EpiMoe1 {
    static constexpr bool PERM = true;
    bf16_t* ACT; const float* b1;
    DI void operator()(const AccT& acc, const Unit& u, int wr, int wc, int fr, int fq) const {
        const int e = u.g & 31, cb = u.pn * 128 + wc * 32 + 8 * fq;
        const float* bg = b1 + (size_t)e * 2048 + cb; const float* bl = bg + 1024;
        const f32x4 bg0 = *(const f32x4*)bg, bg1 = *(const f32x4*)(bg + 4), bl0 = *(const f32x4*)bl, bl1 = *(const f32x4*)(bl + 4);
#pragma unroll
        for (int ai = 0; ai < 2; ++ai)
#pragma unroll
            for (int m = 0; m < 4; ++m) {
                const int rl = ai * HALF + wr * 64 + m * 16 + fr;
                float o[8];
#pragma unroll
                for (int n = 0; n < 2; ++n)
#pragma unroll
                    for (int j = 0; j < 4; ++j) {
                        float glu = acc[ai][0][m][n][j] + (n ? bg1[j] : bg0[j]); float lin = acc[ai][1][m][n][j] + (n ? bl1[j] : bl0[j]);
                        glu = fminf(glu, 7.0f); lin = fminf(fmaxf(lin, -7.0f), 7.0f);
                        o[n * 4 + j] = glu * sigmoidf_(1.702f * glu) * (lin + 1.0f);
                    }
                u32x4 ov = {cvt_pk(o[0], o[1]), cvt_pk(o[2], o[3]), cvt_pk(o[4], o[5]), cvt_pk(o[6], o[7])};
                *(u32x4*)(ACT + (size_t)(u.arow + rl) * 1024 + cb) = ov;
            }
    }
};
struct EpiMoe2 {
    static constexpr bool PERM = false;
    float* H; bf16_t* HB; const float* b2; const int* list; const float* gate; int slot;
    DI void operator()(const AccT& acc, const Unit& u, int wr, int wc, int fr, int fq) const {
        const int e = u.g & 31, col0 = u.pn * BM + wc * 32 + 4 * fq;
        f32x4 bv[2][2];
#pragma unroll
        for (int bj = 0; bj < 2; ++bj)
#pragma unroll
            for (int n = 0; n < 2; ++n) bv[bj][n] = *(const f32x4*)(b2 + (size_t)e * 1024 + col0 + bj * HALF + n * 16);
        const int* lp = list + (size_t)u.g * 65536 + (size_t)u.pm * 256;
#pragma unroll
        for (int ai = 0; ai < 2; ++ai)
#pragma unroll
            for (int m = 0; m < 4; ++m) {
                const int rl = ai * HALF + wr * 64 + m * 16 + fr;
                if (rl < u.cnt) {
                    const int tok = lp[rl]; const float gt = gate[(size_t)tok * 4 + slot];
                    float* hp = H + (size_t)tok * 1024 + col0;
#pragma unroll
                    for (int bj = 0; bj < 2; ++bj)
#pragma unroll
                        for (int n = 0; n < 2; ++n) {
                            f32x4 hv = *(const f32x4*)(hp + bj * HALF + n * 16);
                            hv = hv + gt * (acc[ai][bj][m][n] + bv[bj][n]);
                            *(f32x4*)(hp + bj * HALF + n * 16) = hv;
                            if (slot == 3) { u32x2 o = {cvt_pk(hv[0], hv[1]), cvt_pk(hv[2], hv[3])}; *(u32x2*)(HB + (size_t)tok * 1024 + col0 + bj * HALF + n * 16) = o; }
                        }
                }
            }
    }
};
struct EpiPle {
    static constexpr bool PERM = true;
    bf16_t* EB; float* ESS;
    DI void operator()(const AccT& acc, const Unit& u, int wr, int wc, int fr, int fq) const {
        const int row0 = u.pm * BM + wr * 64 + fr, col0 = u.pn * BM + wc * 32 + 8 * fq;
#pragma unroll
        for (int ai = 0; ai < 2; ++ai)
#pragma unroll
            for (int m = 0; m < 4; ++m) { const int row = row0 + ai * HALF + m * 16; bf16_t* rowp = EB + (size_t)row * 1024 + col0; float ss = 0.f;
#pragma unroll
                for (int bj = 0; bj < 2; ++bj) { const f32x4 v0 = acc[ai][bj][m][0], v1 = acc[ai][bj][m][1];
                    ss += v0[0] * v0[0] + v0[1] * v0[1] + v0[2] * v0[2] + v0[3] * v0[3] + v1[0] * v1[0] + v1[1] * v1[1] + v1[2] * v1[2] + v1[3] * v1[3];
                    u32x4 o = {cvt_pk(v0[0], v0[1]), cvt_pk(v0[2], v0[3]), cvt_pk(v1[0], v1[1]), cvt_pk(v1[2], v1[3])}; *(u32x4*)(rowp + bj * HALF) = o; }
                ss += __shfl_xor(ss, 16); ss += __shfl_xor(ss, 32);
                if (fq == 0) atomicAdd(ESS + row, ss);
            }
    }
};
struct EpiFinal {
    static constexpr bool PERM = false;
    float* H; const bf16_t* EB; const float* ESS; const float* g;
    DI void operator()(const AccT& acc, const Unit& u, int wr, int wc, int fr, int fq) const {
        const int row0 = u.pm * BM + wr * 64 + fr, col0 = u.pn * BM + wc * 32 + 4 * fq;
        f32x4 gv[2][2];
#pragma unroll
        for (int bj = 0; bj < 2; ++bj)
#pragma unroll
            for (int n = 0; n < 2; ++n) gv[bj][n] = *(const f32x4*)(g + col0 + bj * HALF + n * 16);
#pragma unroll
        for (int ai = 0; ai < 2; ++ai)
#pragma unroll
            for (int m = 0; m < 4; ++m) { const int row = row0 + ai * HALF + m * 16; const size_t ro = (size_t)row * 1024 + col0;
                const float rinv = __builtin_amdgcn_rsqf(ESS[row] * (1.f / 1024.f) + NORM_EPS);
#pragma unroll
                for (int bj = 0; bj < 2; ++bj)
#pragma unroll
                    for (int n = 0; n < 2; ++n) {
                        const size_t o = ro + bj * HALF + n * 16;
                        const u32x2 eb = *(const u32x2*)(EB + o); const f32x4 hv = *(const f32x4*)(H + o); const f32x4 a = acc[ai][bj][m][n];
                        f32x4 r;
                        r[0] = hv[0] + bf_lo(eb[0]) * rinv * gv[bj][n][0] * sigmoidf_(a[0]);
                        r[1] = hv[1] + bf_hi(eb[0]) * rinv * gv[bj][n][1] * sigmoidf_(a[1]);
                        r[2] = hv[2] + bf_lo(eb[1]) * rinv * gv[bj][n][2] * sigmoidf_(a[2]);
                        r[3] = hv[3] + bf_hi(eb[1]) * rinv * gv[bj][n][3] * sigmoidf_(a[3]);
                        *(f32x4*)(H + o) = r;
                    }
            }
    }
};

DI void moe_tables(LAS unsigned char* lds, const unsigned* cnt_g) {
    LAS int* cntL = (LAS int*)(lds + LDS_GRP); LAS int* pre = cntL + 128;
    __syncthreads();
    if (threadIdx.x < 128) cntL[threadIdx.x] = (int)cnt_g[threadIdx.x];
    __syncthreads();
    if (threadIdx.x == 0) { int s = 0; for (int g = 0; g < 128; ++g) { pre[g] = s; s += (cntL[g] + 255) >> 8; } pre[128] = s; }
    __syncthreads();
}
template <int NT, bool GATHER_>
struct MoeOrder {
    static constexpr bool GATHER = GATHER_;
    const char* A; const char* B; size_t bexp; int g0, ng, G, c; LAS unsigned char* lds; const int* list;
    DI bool next(int i, Unit& u) const {
        LAS int* cntL = (LAS int*)(lds + LDS_GRP); LAS int* pre = cntL + 128;
        const int L = i * G + c; const int base = __builtin_amdgcn_readfirstlane(pre[g0]), tot = __builtin_amdgcn_readfirstlane(pre[g0 + ng]) - base;
        const int rbg = L / NT; if (rbg >= tot) return false;
        const int ra = rbg + base; int lo = g0, hi = g0 + ng;
        while (hi - lo > 1) { const int mid = (lo + hi) >> 1; const int pm_ = __builtin_amdgcn_readfirstlane(pre[mid]); if (pm_ <= ra) lo = mid; else hi = mid; }
        const int g = lo, pg = __builtin_amdgcn_readfirstlane(pre[g]), rb = ra - pg, cg = __builtin_amdgcn_readfirstlane(cntL[g]);
        u.g = g; u.pm = rb; u.pn = L % NT; u.cnt = (cg - rb * 256) < 256 ? (cg - rb * 256) : 256; u.arow = ra * 256;
        u.A = GATHER ? A : A + (size_t)u.arow * 2048; u.B = B + (size_t)(g & 31) * bexp + (size_t)u.pn * (256 * 2048);
        return true;
    }
    DI void issue_table(const Unit& u, LAS unsigned char* tab) const {
        if (threadIdx.x < 256) { const int wid = __builtin_amdgcn_readfirstlane(threadIdx.x >> 6);
            __builtin_amdgcn_global_load_lds((const unsigned*)(list + (size_t)u.g * 65536 + (size_t)u.pm * 256 + threadIdx.x), (LAS unsigned*)(tab + wid * 256), 4, 0, 0); }
    }
    DI unsigned row_off(const Unit& u, LAS unsigned char* tab, int r) const { const unsigned t = *(const LAS unsigned*)(tab + r * 4); return (r < u.cnt) ? t * 2048u : 0u; }
};

DI void phase_qknorm(const Params& P) {
    bf16_t* Z = (bf16_t*)(P.ws + WS_Z);
    {
        bf16_t* XL = (bf16_t*)(P.ws + WS_XL);
        for (int it = blockIdx.x * 512 + threadIdx.x; it < MTOK * 48; it += gridDim.x * 512) {
            const int tok = it / 48, cg = it - tok * 48, t = tok & (SEQ - 1), col = ZWD + cg * 8;
            const bf16_t* zp = Z + (size_t)tok * IN_COLS + col;
            const u32x4 vc = *(const u32x4*)zp; u32x4 vp = {0u, 0u, 0u, 0u}, vn = {0u, 0u, 0u, 0u};
            if (t > 0) vp = *(const u32x4*)(zp - IN_COLS);
            if (t < SEQ - 1) vn = *(const u32x4*)(zp + IN_COLS);
            const f32x4 mu0 = *(const f32x4*)(P.rw_mu + col), mu1 = *(const f32x4*)(P.rw_mu + col + 4);
            float f[8];
#pragma unroll
            for (int q = 0; q < 4; ++q) {
                const float c0 = bf_lo(vc[q]), c1 = bf_hi(vc[q]);
                const float m0 = q < 2 ? mu0[2 * q] : mu1[2 * q - 4], m1 = q < 2 ? mu0[2 * q + 1] : mu1[2 * q - 3];
                f[2 * q] = c0 + (0.5f * (bf_lo(vp[q]) + bf_lo(vn[q])) - c0) * m0; f[2 * q + 1] = c1 + (0.5f * (bf_hi(vp[q]) + bf_hi(vn[q])) - c1) * m1;
            }
            if (cg < 16) {
#pragma unroll
                for (int q = 0; q < 8; ++q) { const float e = __builtin_amdgcn_exp2f(f[q] * (2.0f * LOG2E)); f[q] = 1.0f - 2.0f * __builtin_amdgcn_rcpf(e + 1.0f); }
            } else if (cg >= 32) {
#pragma unroll
                for (int q = 0; q < 8; ++q) f[q] = sigmoidf_(f[q]);
            }
            u32x4 ov = {cvt_pk(f[0], f[1]), cvt_pk(f[2], f[3]), cvt_pk(f[4], f[5]), cvt_pk(f[6], f[7])};
            *(u32x4*)(XL + (size_t)tok * 384 + cg * 8) = ov;
        }
    }
    const int t = threadIdx.x & 127, grp = t >> 3, sub = t & 7;
    const bool isq = grp < 8;
    const int col = (isq ? ZQ : ZKK) + (grp & 7) * 64 + sub * 8;
    const float* gp = (isq ? P.da_q_norm_g : P.da_k_norm_g) + sub * 8;
    float g[8];
#pragma unroll
    for (int j = 0; j < 8; ++j) g[j] = gp[j] * (isq ? (0.125f * LOG2E) : 1.0f);
    for (int tok = blockIdx.x * 4 + (threadIdx.x >> 7); tok < MTOK; tok += gridDim.x * 4) {
        bf16_t* zp = Z + (size_t)tok * IN_COLS + col;
        const u32x4 v = *(const u32x4*)zp;
        float f[8] = {bf_lo(v[0]), bf_hi(v[0]), bf_lo(v[1]), bf_hi(v[1]), bf_lo(v[2]), bf_hi(v[2]), bf_lo(v[3]), bf_hi(v[3])};
        float ss = 0.f;
#pragma unroll
        for (int j = 0; j < 8; ++j) ss += f[j] * f[j];
        ss += __shfl_xor(ss, 1); ss += __shfl_xor(ss, 2); ss += __shfl_xor(ss, 4);
        const float rinv = __builtin_amdgcn_rsqf(ss * (1.f / 64.f) + NORM_EPS);
        u32x4 o = {cvt_pk(f[0] * rinv * g[0], f[1] * rinv * g[1]), cvt_pk(f[2] * rinv * g[2], f[3] * rinv * g[3]),
                   cvt_pk(f[4] * rinv * g[4], f[5] * rinv * g[5]), cvt_pk(f[6] * rinv * g[6], f[7] * rinv * g[7])};
        *(u32x4*)zp = o;
    }
}

constexpr int LDS_RT_SEL = STAGE_BYTES;
DI void phase_route(const Params& P, LAS unsigned char* lds) {
    LAS float* wT = (LAS float*)lds;
    LAS int* sel_e = (LAS int*)(lds + LDS_RT_SEL); LAS float* sel_g = (LAS float*)(sel_e + 1024); LAS int* lpos = (LAS int*)(sel_g + 1024);
    LAS int* lcnt = lpos + 1024; LAS int* lbase = lcnt + 128;
    const int tid = threadIdx.x, wid = tid >> 6, lane = tid & 63;
    const float* H = P.out; bf16_t* Mb = (bf16_t*)(P.ws + WS_U);
    unsigned* cnt_g = (unsigned*)(P.ws + WS_CTL) + CW_CNT; int* list = (int*)(P.ws + WS_LIST); float* gate = (float*)(P.ws + WS_GATE);
    __syncthreads();
    for (int i = tid; i < 1024 * 32; i += 512) { const int k = i >> 5, e = i & 31; wT[e * 1024 + k] = P.w_router[i]; }
    __syncthreads();
    f32x4 g[4];
#pragma unroll
    for (int i = 0; i < 4; ++i) g[i] = *(const f32x4*)(P.norm_ffn_g + 4 * lane + 256 * i);
    int erev = 0;
#pragma unroll
    for (int b = 0; b < 5; ++b) erev |= ((lane >> b) & 1) << (4 - b);
    const float brt = P.b_router[erev];
    for (int blk = blockIdx.x; blk < MTOK / 256; blk += gridDim.x) {
        if (tid < 128) lcnt[tid] = 0;
        for (int rp = 0; rp < 32; ++rp) {
            const int r0 = wid * 32 + rp;
            f32x4 mv[4];
            {
                const int row = blk * 256 + r0; const float* hr = H + (size_t)row * 1024; float ss = 0.f; f32x4 v[4];
#pragma unroll
                for (int i = 0; i < 4; ++i) { v[i] = *(const f32x4*)(hr + 4 * lane + 256 * i); ss += v[i][0] * v[i][0] + v[i][1] * v[i][1] + v[i][2] * v[i][2] + v[i][3] * v[i][3]; }
                ss = wave_sum(ss);
                const float rinv = __builtin_amdgcn_rsqf(ss * (1.f / 1024.f) + NORM_EPS);
#pragma unroll
                for (int i = 0; i < 4; ++i) { mv[i] = v[i] * rinv * g[i];
                    u32x2 o = {cvt_pk(mv[i][0], mv[i][1]), cvt_pk(mv[i][2], mv[i][3])}; *(u32x2*)(Mb + (size_t)row * 1024 + 4 * lane + 256 * i) = o; }
            }
            float acc[32];
#pragma unroll
            for (int e = 0; e < 32; ++e) {
                float a0 = 0.f;
#pragma unroll
                for (int i = 0; i < 4; ++i) { const f32x4 w = *(const LAS f32x4*)(wT + e * 1024 + 256 * i + 4 * lane);
                    a0 += mv[i][0] * w[0] + mv[i][1] * w[1] + mv[i][2] * w[2] + mv[i][3] * w[3]; }
                acc[e] = a0;
            }
            {
#define TR_STAGE(HN, DD) do { const bool up = (lane & (DD)) != 0; _Pragma("unroll") for (int i = 0; i < (HN); ++i) { \
                    const float keep = up ? acc[i + (HN)] : acc[i], send = up ? acc[i] : acc[i + (HN)]; acc[i] = keep + __shfl_xor(send, (DD)); } } while (0)
                TR_STAGE(16, 1); TR_STAGE(8, 2); TR_STAGE(4, 4); TR_STAGE(2, 8); TR_STAGE(1, 16);
#undef TR_STAGE
                float v = acc[0] + __shfl_xor(acc[0], 32) + brt;
                float tv[4]; int te[4];
#pragma unroll
                for (int k = 0; k < 4; ++k) {
                    float mx = v;
#pragma unroll
                    for (int o = 32; o >= 1; o >>= 1) mx = fmaxf(mx, __shfl_xor(mx, o));
                    int ce = (v == mx) ? erev : 99;
#pragma unroll
                    for (int o = 32; o >= 1; o >>= 1) ce = min(ce, __shfl_xor(ce, o));
                    ce &= 31;
                    tv[k] = mx; te[k] = ce; if (erev == ce) v = -3.0e38f;
                }
                const float e1 = __expf(tv[1] - tv[0]), e2 = __expf(tv[2] - tv[0]), e3 = __expf(tv[3] - tv[0]); const float inv = 1.f / (1.f + e1 + e2 + e3);
                if (lane == 0) { const int r = r0; sel_e[r * 4 + 0] = te[0]; sel_e[r * 4 + 1] = te[1]; sel_e[r * 4 + 2] = te[2]; sel_e[r * 4 + 3] = te[3];
                    sel_g[r * 4 + 0] = inv; sel_g[r * 4 + 1] = e1 * inv; sel_g[r * 4 + 2] = e2 * inv; sel_g[r * 4 + 3] = e3 * inv; }
            }
        }
        __syncthreads();
        if (tid < 256) {
#pragma unroll
            for (int s = 0; s < 4; ++s) lpos[tid * 4 + s] = atomicAdd((int*)&lcnt[s * 32 + sel_e[tid * 4 + s]], 1);
        }
        __syncthreads();
        if (tid < 128) lbase[tid] = (int)atomicAdd(cnt_g + tid, (unsigned)lcnt[tid]);
        __syncthreads();
        if (tid < 256) { const int tok = blk * 256 + tid;
#pragma unroll
            for (int s = 0; s < 4; ++s) { const int gi = s * 32 + sel_e[tid * 4 + s]; list[(size_t)gi * 65536 + lbase[gi] + lpos[tid * 4 + s]] = tok; gate[(size_t)tok * 4 + s] = sel_g[tid * 4 + s]; }
        }
        __syncthreads();
    }
}

constexpr int AT_V = 0, AT_K = 32768, AT_WS = 65536;
#define KSWZ(row, colB) ((row) * 256 + ((colB) ^ (((row) & 7) << 4)))
DI int crow(int r, int hi) { return (r & 3) + 8 * (r >> 2) + 4 * hi; }
DI int v_st(int k, int c) { const int kk = (k & ~0xC) | ((k & 4) << 1) | ((k & 8) >> 1); return ((kk >> 3) * 4 + (c >> 5)) * 512 + ((kk & 7) * 32 + (c & 31)) * 2; }
DI int v_rd_base(int lane) { return ((lane & 3) << 3) | (((lane >> 2) & 3) << 6) | (((lane >> 4) & 1) << 5) | (((lane >> 5) & 1) << 8); }
constexpr int v_rd_off(int d0, int ks, int half) { return d0 * 512 + ks * 4096 + half * 2048; }
template <int OFF> DI s16x4 tr_read(int vb) { s16x4 r; asm volatile("ds_read_b64_tr_b16 %0, %1 offset:%2" : "=&v"(r) : "v"(vb), "i"(OFF) : "memory"); return r; }
#define AT_PK(L, H) (bf16x8){L[0], L[1], L[2], L[3], H[0], H[1], H[2], H[3]}
template <int D0> DI void pv_one(f32x16& od, int vb, bf16x8 pa0, bf16x8 pa1, bf16x8 pa2, bf16x8 pa3) {
    const s16x4 l0 = tr_read<v_rd_off(D0, 0, 0)>(vb), h0 = tr_read<v_rd_off(D0, 0, 1)>(vb), l1 = tr_read<v_rd_off(D0, 1, 0)>(vb), h1 = tr_read<v_rd_off(D0, 1, 1)>(vb);
    const s16x4 l2 = tr_read<v_rd_off(D0, 2, 0)>(vb), h2 = tr_read<v_rd_off(D0, 2, 1)>(vb), l3 = tr_read<v_rd_off(D0, 3, 0)>(vb), h3 = tr_read<v_rd_off(D0, 3, 1)>(vb);
    asm volatile("s_waitcnt lgkmcnt(0)" ::: "memory"); __builtin_amdgcn_sched_barrier(0);
    od = __builtin_amdgcn_mfma_f32_32x32x16_bf16(pa0, AT_PK(l0, h0), od, 0, 0, 0);
    od = __builtin_amdgcn_mfma_f32_32x32x16_bf16(pa1, AT_PK(l1, h1), od, 0, 0, 0);
    od = __builtin_amdgcn_mfma_f32_32x32x16_bf16(pa2, AT_PK(l2, h2), od, 0, 0, 0);
    od = __builtin_amdgcn_mfma_f32_32x32x16_bf16(pa3, AT_PK(l3, h3), od, 0, 0, 0);
}
DI void at_softmax(f32x16& p0, f32x16& p1, float& l_reg, bf16x8& pa0, bf16x8& pa1, bf16x8& pa2, bf16x8& pa3) {
#pragma unroll
    for (int r = 0; r < 16; ++r) { p0[r] = __builtin_amdgcn_exp2f(p0[r]); p1[r] = __builtin_amdgcn_exp2f(p1[r]); }
    float ps = 0.f;
#pragma unroll
    for (int r = 0; r < 16; ++r) ps += p0[r] + p1[r];
    l_reg += ps;
#define AT_PK4(Pv, BASE, OUT) do { unsigned a0 = cvt_pk(Pv[BASE + 0], Pv[BASE + 1]), a1 = cvt_pk(Pv[BASE + 2], Pv[BASE + 3]); \
    unsigned b0 = cvt_pk(Pv[BASE + 4], Pv[BASE + 5]), b1 = cvt_pk(Pv[BASE + 6], Pv[BASE + 7]); \
    auto r0 = __builtin_amdgcn_permlane32_swap(a0, b0, false, false); auto r1 = __builtin_amdgcn_permlane32_swap(a1, b1, false, false); \
    u32x4 w = {r0[0], r1[0], r0[1], r1[1]}; OUT = __builtin_bit_cast(bf16x8, w); } while (0)
    AT_PK4(p0, 0, pa0); AT_PK4(p0, 8, pa1); AT_PK4(p1, 0, pa2); AT_PK4(p1, 8, pa3);
#undef AT_PK4
}

DI void attn_unit(const Params& P, unsigned char* lds, int b, int h, int qb, float lam, float smax2, int W) {
    int tid_ = threadIdx.x; asm volatile("" : "+v"(tid_));
    const int tid = tid_, wid = __builtin_amdgcn_readfirstlane(tid >> 6), lane = tid & 63, r32 = lane & 31, hi = lane >> 5, grp = wid >> 1, c = wid & 1;
    const bf16_t* Zb = (const bf16_t*)(P.ws + WS_Z) + (size_t)b * SEQ * IN_COLS;
    const int i0 = qb * 128, qi = i0 + grp * 32 + r32;
    const float slope2 = exp2f(-2.0f * (float)(h + 1)) * LOG2E;
    bf16x8 qr[4];
    { const bf16_t* qp = Zb + (size_t)qi * IN_COLS + ZQ + h * 128 + c * 64 + hi * 8;
#pragma unroll
      for (int d0 = 0; d0 < 4; ++d0) qr[d0] = *(const bf16x8*)(qp + d0 * 16); }
    const bf16_t* Kh = Zb + ZKK + h * 128; const bf16_t* Vh = Zb + ZVV + h * 128;
    const int sr = tid >> 4, sc = (tid & 15) * 8, vst0 = v_st(sr, sc), vst1 = v_st(32 + sr, sc);
    const int vb0 = (int)(uintptr_t)(lds + AT_V) + v_rd_base(lane);
    int jlo = i0 - W; if (jlo < 0) jlo = 0; jlo >>= 6;
    int jhi = i0 + 127 + W; if (jhi > SEQ - 1) jhi = SEQ - 1; jhi >>= 6;
    const int NT = jhi - jlo + 1;
    f32x16 o[4];
#pragma unroll
    for (int d = 0; d < 4; ++d)
#pragma unroll
        for (int r = 0; r < 16; ++r) o[d][r] = 0.f;
    float l = 0.f;
    bf16x8 vs0, vs1, ks0, ks1;
#define AT_LOAD(k0) do { vs0 = *(const bf16x8*)(Vh + (size_t)((k0) + sr) * IN_COLS + sc); vs1 = *(const bf16x8*)(Vh + (size_t)((k0) + 32 + sr) * IN_COLS + sc); \
    ks0 = *(const bf16x8*)(Kh + (size_t)((k0) + sr) * IN_COLS + sc); ks1 = *(const bf16x8*)(Kh + (size_t)((k0) + 32 + sr) * IN_COLS + sc); } while (0)
#define AT_WRITE(bf) do { *(bf16x8*)(lds + AT_V + (bf) * 16384 + vst0) = vs0; *(bf16x8*)(lds + AT_V + (bf) * 16384 + vst1) = vs1; \
    *(bf16x8*)(lds + AT_K + (bf) * 16384 + KSWZ(sr, sc * 2)) = ks0; *(bf16x8*)(lds + AT_K + (bf) * 16384 + KSWZ(32 + sr, sc * 2)) = ks1; } while (0)
    __syncthreads();
    AT_LOAD(jlo * 64); AT_WRITE(0); __syncthreads();
    for (int j = 0; j < NT; ++j) {
        const int buf = j & 1, j0 = (jlo + j) * 64;
        if (j + 1 < NT) AT_LOAD(j0 + 64);
        const unsigned char* Ks = lds + AT_K + buf * 16384;
        const float x = (float)(qi - j0 - 4 * hi);
        f32x16 p0, p1;
#pragma unroll
        for (int r = 0; r < 16; ++r) { const float c0 = (float)((r & 3) + 8 * (r >> 2));
            p0[r] = fmaf(fabsf(x - c0), -slope2, -smax2); p1[r] = fmaf(fabsf(x - (c0 + 32.f)), -slope2, -smax2); }
#pragma unroll
        for (int d0 = 0; d0 < 4; ++d0) { const int cb = (c * 64 + d0 * 16 + hi * 8) * 2;
            const bf16x8 k0 = *(const bf16x8*)(Ks + KSWZ(r32, cb)), k1 = *(const bf16x8*)(Ks + KSWZ(32 + r32, cb));
            p0 = __builtin_amdgcn_mfma_f32_32x32x16_bf16(k0, qr[d0], p0, 0, 0, 0);
            p1 = __builtin_amdgcn_mfma_f32_32x32x16_bf16(k1, qr[d0], p1, 0, 0, 0); }
        bf16x8 pa0, pa1, pa2, pa3;
        at_softmax(p0, p1, l, pa0, pa1, pa2, pa3);
        const int vb = vb0 + buf * 16384;
        pv_one<0>(o[0], vb, pa0, pa1, pa2, pa3); pv_one<1>(o[1], vb, pa0, pa1, pa2, pa3); pv_one<2>(o[2], vb, pa0, pa1, pa2, pa3); pv_one<3>(o[3], vb, pa0, pa1, pa2, pa3);
        if (j + 1 < NT) AT_WRITE(buf ^ 1);
        __syncthreads();
    }
#undef AT_LOAD
#undef AT_WRITE
    l += __shfl_xor(l, 32);
    float* wsf = (float*)(lds + AT_WS) + wid * 32;
    float* exch = (float*)lds + grp * 4096;
    if (hi == 0) wsf[r32] = l;
    asm volatile("s_waitcnt lgkmcnt(0)" ::: "memory");
    float rl[16];
#pragma unroll
    for (int r = 0; r < 16; ++r) rl[r] = __builtin_amdgcn_rcpf(wsf[crow(r, hi)]) * (c ? lam : 1.0f);
    if (c == 1) {
#pragma unroll
        for (int d = 0; d < 4; ++d)
#pragma unroll
            for (int r = 0; r < 16; ++r) exch[(d * 16 + r) * 64 + lane] = o[d][r] * rl[r];
    }
    __syncthreads();
    if (c == 0) {
        float ss[16];
#pragma unroll
        for (int r = 0; r < 16; ++r) { float sacc = 0.f;
#pragma unroll
            for (int d = 0; d < 4; ++d) { const float v = o[d][r] * rl[r] - exch[(d * 16 + r) * 64 + lane]; o[d][r] = v; sacc += v * v; }
            ss[r] = sacc; }
#pragma unroll
        for (int r = 0; r < 16; ++r) {
#pragma unroll
            for (int m = 16; m >= 1; m >>= 1) ss[r] += __shfl_xor(ss[r], m);
        }
        bf16_t* Ob = (bf16_t*)(P.ws + WS_O) + (size_t)(b * SEQ + i0 + grp * 32) * 1024 + C_RW + h * 128;
        float sg[4];
#pragma unroll
        for (int d = 0; d < 4; ++d) sg[d] = P.da_subln_g[d * 32 + r32] * 0.8f;
#pragma unroll
        for (int r = 0; r < 16; ++r) { const float rn = __builtin_amdgcn_rsqf(ss[r] * (1.f / 128.f) + NORM_EPS); bf16_t* op = Ob + (size_t)crow(r, hi) * 1024 + r32;
#pragma unroll
            for (int d = 0; d < 4; ++d) op[d * 32] = f2bf(o[d][r] * rn * sg[d]); }
    }
}

constexpr int SL_SZ = 19712, SL_AT = 0, SL_RT = 2304, SL_BT = 4608, SL_KT = 6912, SL_BH = 9216, SL_KH = 11776, SL_VT = 14336, SL_PC = 16896,
              SL_AAK = 17152, SL_TT = 17792, SL_ARB = 18432, SL_ARK = 19072;
constexpr int RW_SLOT = 0, RW_EX = 78848, RW_FG = 79872, RW_MU = 96256, RW_WFW = 98560, RW_WFA = 106752, RW_WFG = 123136, RW_AAB = 139520;
DI bf16x8 pack8(float a0, float a1, float a2, float a3, float a4, float a5, float a6, float a7) { u32x4 w = {cvt_pk(a0, a1), cvt_pk(a2, a3), cvt_pk(a4, a5), cvt_pk(a6, a7)}; return __builtin_bit_cast(bf16x8, w); }
DI bf16x8 lo_hi(u32x2 lo, u32x2 hi) { u32x4 w = {lo[0], lo[1], hi[0], hi[1]}; return __builtin_bit_cast(bf16x8, w); }
DI float tanh_fast(float x) { const float t = __builtin_amdgcn_exp2f(x * (2.0f * LOG2E)); return 1.0f - 2.0f * __builtin_amdgcn_rcpf(t + 1.0f); }
template <int CTRL> DI unsigned dpp_keep(unsigned old, unsigned v) { return (unsigned)__builtin_amdgcn_update_dpp((int)old, (int)v, CTRL, 0xF, 0xF, false); }
DI void shift8(const u32x4 cur, const u32x4 bnd, const float* mu, float (&f)[8]) {
    const f32x4 m0 = *(const f32x4*)mu, m1 = *(const f32x4*)(mu + 4);
#pragma unroll
    for (int q = 0; q < 4; ++q) {
        const unsigned na = dpp_keep<0x111>(bnd[q], cur[q]), nb = dpp_keep<0x101>(bnd[q], cur[q]);
        const float c0 = bf_lo(cur[q]), c1 = bf_hi(cur[q]);
        const float mm0 = q < 2 ? m0[2 * q] : m1[2 * q - 4], mm1 = q < 2 ? m0[2 * q + 1] : m1[2 * q - 3];
        f[2 * q] = c0 + (0.5f * (bf_lo(na) + bf_lo(nb)) - c0) * mm0; f[2 * q + 1] = c1 + (0.5f * (bf_hi(na) + bf_hi(nb)) - c1) * mm1;
    }
}

#define RW_BAR() do { asm volatile("s_waitcnt lgkmcnt(0)" ::: "memory"); __builtin_amdgcn_s_barrier(); asm volatile("" ::: "memory"); } while (0)
DI void rwkv_task(const Params& P, unsigned char* lds, int b, int h, int wd) {
    int tid_ = threadIdx.x; asm volatile("" : "+v"(tid_));
    const int tid = tid_, wid = __builtin_amdgcn_readfirstlane(tid >> 6), lane = tid & 63, n16 = lane & 15, q4 = lane >> 4, cp = wid >> 1, hf = wid & 1, vt = wid & 3;
    const bf16_t* Zb = (const bf16_t*)(P.ws + WS_Z) + (size_t)b * SEQ * IN_COLS;
    float* Ysc = (float*)(P.ws + WS_U) + (size_t)b * SEQ * 512 + h * 64;
    bf16_t* Ob = (bf16_t*)(P.ws + WS_O) + (size_t)b * SEQ * 1024 + h * 64;
    const bf16_t* XLb = (const bf16_t*)(P.ws + WS_XL) + (size_t)b * SEQ * 384;
    unsigned* flags = (unsigned*)(P.ws + WS_CTL) + CW_RWFLAG;
    const int hc = h * 64, task = (b * 8 + h) * 2 + wd;
    __syncthreads();
    float* MU = (float*)(lds + RW_MU);
    for (int i = tid; i < 192; i += 512) { const int col = (i < 64 ? ZR : i < 128 ? ZK - 64 : ZV - 128) + hc + i; MU[i] = P.rw_mu[col]; }
    float w0c[2], a0c[2], a0oc[2], kkc[2], kac[2], rkc[2];
    bf16x8* wfw = (bf16x8*)(lds + RW_WFW) + (size_t)(hf * 4) * 64 + lane;
    bf16x8* wfa = (bf16x8*)(lds + RW_WFA) + (size_t)(hf * 4) * 64 + lane;
    bf16x8* wfo = (bf16x8*)(lds + RW_WFA) + (size_t)(8 + hf * 4) * 64 + lane;
    bf16x8* wfg = (bf16x8*)(lds + RW_WFG) + (size_t)(hf * 8) * 64 + lane;
#pragma unroll
    for (int u = 0; u < 2; ++u) {
        const int col = hc + hf * 32 + u * 16 + n16;
        w0c[u] = P.rw_w0[wd * 512 + col]; a0c[u] = P.rw_a0[wd * 512 + col]; a0oc[u] = P.rw_a0[(1 - wd) * 512 + col]; kkc[u] = P.rw_k_k[col]; kac[u] = P.rw_k_a[col]; rkc[u] = P.rw_r_k[col];
        if (cp == 0) {
#pragma unroll
            for (int s = 0; s < 2; ++s) {
                float x[8], y[8], z[8];
#pragma unroll
                for (int j = 0; j < 8; ++j) { const int r = s * 32 + q4 * 8 + j; x[j] = P.rw_w2[(size_t)(wd * 64 + r) * 512 + col]; y[j] = P.rw_a2[(size_t)(wd * 64 + r) * 512 + col]; z[j] = P.rw_a2[(size_t)((1 - wd) * 64 + r) * 512 + col]; }
                wfw[(u * 2 + s) * 64] = pack8(x[0], x[1], x[2], x[3], x[4], x[5], x[6], x[7]); wfa[(u * 2 + s) * 64] = pack8(y[0], y[1], y[2], y[3], y[4], y[5], y[6], y[7]);
                wfo[(u * 2 + s) * 64] = pack8(z[0], z[1], z[2], z[3], z[4], z[5], z[6], z[7]);
            }
#pragma unroll
            for (int s = 0; s < 4; ++s) { float x[8];
#pragma unroll
                for (int j = 0; j < 8; ++j) x[j] = P.rw_g2[(size_t)(s * 32 + q4 * 8 + j) * 512 + col];
                wfg[(u * 4 + s) * 64] = pack8(x[0], x[1], x[2], x[3], x[4], x[5], x[6], x[7]); }
        }
    }
    const f32x4 lng4 = *(const f32x4*)(P.rw_ln_g + hc + n16 * 4), lnb4 = *(const f32x4*)(P.rw_ln_b + hc + n16 * 4);
    f32x4 ST[4];
#pragma unroll
    for (int t = 0; t < 4; ++t) ST[t] = (f32x4){0.f, 0.f, 0.f, 0.f};
    unsigned char* slot = lds + RW_SLOT + cp * SL_SZ;
    float* scr = (float*)(slot + hf * 6912);
    float* ex = (float*)(lds + RW_EX);
    bf16_t* fgb = (bf16_t*)(lds + RW_FG) + cp * 2048;
    const int sgn = wd ? -1 : 1;
    for (int s = 0; s < SEQ / 64; ++s) {
        const bool fin = s >= SEQ / 128;
        const int sc = wd ? (SEQ / 64 - 1 - s) : s;
        const int T0 = wd ? (sc * 64 + 63 - 16 * cp) : (sc * 64 + 16 * cp);
        if (s == SEQ / 128) {
            if (tid < 64) {
                unsigned spins = 0;
                while (__builtin_amdgcn_readfirstlane(__hip_atomic_load(flags + (task ^ 1) * 16, __ATOMIC_RELAXED, __HIP_MEMORY_SCOPE_AGENT)) == 0u) { __builtin_amdgcn_s_sleep(8); if (++spins > (1u << 24)) break; }
                __builtin_amdgcn_fence(__ATOMIC_ACQUIRE, "agent");
                asm volatile("s_waitcnt vmcnt(0)" ::: "memory");
            }
        }
        RW_BAR();
        const bf16_t* zrow = Zb + (size_t)(T0 + sgn * n16) * IN_COLS + q4 * 8;
        const int tb = (n16 == 0) ? (T0 - sgn) : (T0 + 16 * sgn); const bool bok = (n16 == 0 || n16 == 15) && tb >= 0 && tb < SEQ;
        const bf16_t* zbnd = Zb + (size_t)(bok ? tb : 0) * IN_COLS + q4 * 8;
        const u32x4 z4 = {0u, 0u, 0u, 0u};
        const bf16_t* xl = XLb + (size_t)(T0 + sgn * n16) * 384 + q4 * 8;
        const bf16x8 xw0 = *(const bf16x8*)(xl + wd * 64), xw1 = *(const bf16x8*)(xl + wd * 64 + 32), xa0 = *(const bf16x8*)(xl + 128 + wd * 64), xa1 = *(const bf16x8*)(xl + 128 + wd * 64 + 32);
        const bf16x8 xo0 = *(const bf16x8*)(xl + 128 + (1 - wd) * 64), xo1 = *(const bf16x8*)(xl + 128 + (1 - wd) * 64 + 32);
        const bf16x8 xg0 = *(const bf16x8*)(xl + 256), xg1 = *(const bf16x8*)(xl + 288), xg2 = *(const bf16x8*)(xl + 320), xg3 = *(const bf16x8*)(xl + 352);
        u32x4 zc[3], zb[3];
#pragma unroll
        for (int arr = 0; arr < 3; ++arr) { const int col = (arr == 0 ? ZR : arr == 1 ? ZK : ZV) + hc + hf * 32; zc[arr] = *(const u32x4*)(zrow + col); zb[arr] = *(const u32x4*)(zbnd + col); }
        f32x4 ysp[2] = {(f32x4){0.f, 0.f, 0.f, 0.f}, (f32x4){0.f, 0.f, 0.f, 0.f}};
        if (fin) {
#pragma unroll
            for (int jt = 0; jt < 2; ++jt) ysp[jt] = *(const f32x4*)(Ysc + (size_t)(T0 + sgn * (hf * 8 + q4 * 2 + jt)) * 512 + n16 * 4);
        }
        f32x4 lw[2], la[2], lo[2], lg[2];
#pragma unroll
        for (int u = 0; u < 2; ++u) { lw[u] = (f32x4){0.f, 0.f, 0.f, 0.f}; la[u] = lw[u]; lo[u] = lw[u]; lg[u] = lw[u]; }
#define RW_MM(acc, af, wf, nks, ks) acc[0] = __builtin_amdgcn_mfma_f32_16x16x32_bf16(af, wf[(ks) * 64], acc[0], 0, 0, 0); acc[1] = __builtin_amdgcn_mfma_f32_16x16x32_bf16(af, wf[((nks) + (ks)) * 64], acc[1], 0, 0, 0);
        RW_MM(lw, xw0, wfw, 2, 0) RW_MM(lw, xw1, wfw, 2, 1) RW_MM(la, xa0, wfa, 2, 0) RW_MM(la, xa1, wfa, 2, 1)
        RW_MM(lo, xo0, wfo, 2, 0) RW_MM(lo, xo1, wfo, 2, 1) RW_MM(lg, xg0, wfg, 4, 0) RW_MM(lg, xg1, wfg, 4, 1) RW_MM(lg, xg2, wfg, 4, 2) RW_MM(lg, xg3, wfg, 4, 3)
#undef RW_MM
#pragma unroll
        for (int arr = 0; arr < 3; ++arr) { float f[8]; u32x4 bnd = bok ? zb[arr] : z4; shift8(zc[arr], bnd, MU + arr * 64 + hf * 32 + q4 * 8, f);
            float* dst = scr + (arr * 16 + n16) * 36 + q4 * 8; *(f32x4*)dst = (f32x4){f[0], f[1], f[2], f[3]}; *(f32x4*)(dst + 4) = (f32x4){f[4], f[5], f[6], f[7]}; }
        float rr[2][4], kr[2][4], vv[2][4];
#pragma unroll
        for (int u = 0; u < 2; ++u)
#pragma unroll
            for (int j = 0; j < 4; ++j) { const int o = (q4 * 4 + j) * 36 + u * 16 + n16; rr[u][j] = scr[o]; kr[u][j] = scr[576 + o]; vv[u][j] = scr[1152 + o]; }
        float lgw[2][4], aa[2][4], kkr[2][4], gg[2][4], n2p[4], bnp[4];
#pragma unroll
        for (int j = 0; j < 4; ++j) { n2p[j] = 0.f; bnp[j] = 0.f; }
#pragma unroll
        for (int u = 0; u < 2; ++u)
#pragma unroll
            for (int j = 0; j < 4; ++j) {
                const float wl = w0c[u] + lw[u][j];
                lgw[u][j] = -0.6065306597f * sigmoidf_(wl);
                const float a = sigmoidf_(a0c[u] + la[u][j]); aa[u][j] = a;
                const float k = kr[u][j], kk = k * kkc[u]; kkr[u][j] = kk; n2p[j] += kk * kk;
                gg[u][j] = 0.f;
                if (fin) { const float ao = sigmoidf_(a0oc[u] + lo[u][j]); const float kb = k * (1.f + (0.5f * (a + ao) - 1.f) * kac[u]); bnp[j] += rr[u][j] * kb * rkc[u]; gg[u][j] = lg[u][j]; }
            }
#pragma unroll
        for (int j = 0; j < 4; ++j) { n2p[j] = row_sum16(n2p[j]); bnp[j] = row_sum16(bnp[j]); }
        if (n16 == 0) {
#pragma unroll
            for (int j = 0; j < 4; ++j) { float* e = ex + ((cp * 2 + hf) * 16 + q4 * 4 + j) * 2; e[0] = n2p[j]; e[1] = bnp[j]; }
        }
        RW_BAR();
        {
            float bon[4], rsn[4];
#pragma unroll
            for (int j = 0; j < 4; ++j) { const float* e = ex + ((cp * 2 + (1 - hf)) * 16 + q4 * 4 + j) * 2; rsn[j] = __builtin_amdgcn_rsqf(n2p[j] + e[0] + 1e-12f); bon[j] = bnp[j] + e[1]; }
#pragma unroll
            for (int u = 0; u < 2; ++u) {
                const int ch = hf * 32 + u * 16 + n16;
                float L[4];
                L[0] = lgw[u][0]; L[1] = L[0] + lgw[u][1]; L[2] = L[1] + lgw[u][2]; L[3] = L[2] + lgw[u][3];
                float tot = L[3];
                const float t1 = __shfl_up(tot, 16); if (q4 >= 1) tot += t1;
                const float t2 = __shfl_up(tot, 32); if (q4 >= 2) tot += t2;
                const float excl = tot - L[3];
                const float LC = __shfl(tot, 48 + n16);
                const float PC = __expf(LC);
                float bhv[4], khv[4];
#pragma unroll
                for (int j = 0; j < 4; ++j) { const int i = q4 * 4 + j;
                    const float Li = excl + L[j], Lp = Li - lgw[u][j];
                    const float eL = __expf(Li), eLp = __expf(Lp), emL = __builtin_amdgcn_rcpf(eL);
                    const float kk = kkr[u][j] * rsn[j], a = aa[u][j], k = kr[u][j];
                    const float bt = kk * a * emL, kt = k * (1.f + (a - 1.f) * kac[u]) * emL;
                    ((bf16_t*)(slot + SL_AT))[i * 72 + ch] = f2bf(-kk * eLp); ((bf16_t*)(slot + SL_RT))[i * 72 + ch] = f2bf(rr[u][j] * eL);
                    ((bf16_t*)(slot + SL_BT))[i * 72 + ch] = f2bf(bt); ((bf16_t*)(slot + SL_KT))[i * 72 + ch] = f2bf(kt);
                    bhv[j] = bt * PC; khv[j] = kt * PC;
                    if (fin) { fgb[i * 64 + ch] = f2bf(gg[u][j]); fgb[1024 + i * 64 + ch] = f2bf(bon[j] * vv[u][j] * gg[u][j]); }
                }
                *(u32x2*)(slot + SL_BH + (ch * 20 + q4 * 4) * 2) = (u32x2){cvt_pk(bhv[0], bhv[1]), cvt_pk(bhv[2], bhv[3])};
                *(u32x2*)(slot + SL_KH + (ch * 20 + q4 * 4) * 2) = (u32x2){cvt_pk(khv[0], khv[1]), cvt_pk(khv[2], khv[3])};
                *(u32x2*)(slot + SL_VT + (ch * 20 + q4 * 4) * 2) = (u32x2){cvt_pk(vv[u][0], vv[u][1]), cvt_pk(vv[u][2], vv[u][3])};
                if (q4 == 0) ((float*)(slot + SL_PC))[ch] = PC;
            }
        }
        RW_BAR();
        {
            const bf16_t* X = (const bf16_t*)(slot + (hf ? SL_RT : SL_AT)) + n16 * 72 + q4 * 8;
            const bf16_t* YB = (const bf16_t*)(slot + SL_BT) + n16 * 72 + q4 * 8; const bf16_t* YK = (const bf16_t*)(slot + SL_KT) + n16 * 72 + q4 * 8;
            const bf16x8 x0 = *(const bf16x8*)X, x1 = *(const bf16x8*)(X + 32);
            f32x4 mb = {0.f, 0.f, 0.f, 0.f}, mk = mb;
            mb = __builtin_amdgcn_mfma_f32_16x16x32_bf16(x0, *(const bf16x8*)YB, mb, 0, 0, 0); mb = __builtin_amdgcn_mfma_f32_16x16x32_bf16(x1, *(const bf16x8*)(YB + 32), mb, 0, 0, 0);
            mk = __builtin_amdgcn_mfma_f32_16x16x32_bf16(x0, *(const bf16x8*)YK, mk, 0, 0, 0); mk = __builtin_amdgcn_mfma_f32_16x16x32_bf16(x1, *(const bf16x8*)(YK + 32), mk, 0, 0, 0);
            float* aab = (float*)(lds + RW_AAB) + cp * 256;
#pragma unroll
            for (int jj = 0; jj < 4; ++jj) { const int i = q4 * 4 + jj; const bool keep = hf ? (n16 <= i) : (n16 < i); const float vb = keep ? mb[jj] : 0.f, vk = keep ? mk[jj] : 0.f;
                ((bf16_t*)(slot + (hf ? SL_ARK : SL_AAK)))[i * 20 + n16] = f2bf(vk);
                if (hf) ((bf16_t*)(slot + SL_ARB))[i * 20 + n16] = f2bf(vb); else aab[i * 16 + n16] = vb; }
            if (hf == 0 && lane < 16) {
                float t[16];
#pragma unroll
                for (int i = 0; i < 16; ++i) { float acc = (i == lane) ? 1.f : 0.f;
#pragma unroll
                    for (int jb = 0; jb < (i + 3) / 4; ++jb) { const f32x4 nv = *(const f32x4*)(aab + i * 16 + jb * 4);
#pragma unroll
                        for (int jj = 0; jj < 4; ++jj) if (jb * 4 + jj < i) acc += nv[jj] * t[jb * 4 + jj]; }
                    t[i] = acc; ((bf16_t*)(slot + SL_TT))[i * 20 + lane] = f2bf(acc); }
            }
        }
        RW_BAR();
        if (wid < 4) {
#pragma unroll
            for (int c2 = 0; c2 < 4; ++c2) {
                const unsigned char* sl = lds + RW_SLOT + c2 * SL_SZ;
                const bf16x8 sf0 = pack8(ST[0][0], ST[0][1], ST[0][2], ST[0][3], ST[1][0], ST[1][1], ST[1][2], ST[1][3]);
                const bf16x8 sf1 = pack8(ST[2][0], ST[2][1], ST[2][2], ST[2][3], ST[3][0], ST[3][1], ST[3][2], ST[3][3]);
                const u32x2 zero2 = {0u, 0u};
                const bf16_t* AT = (const bf16_t*)(sl + SL_AT) + n16 * 72 + q4 * 4; const bf16_t* RT = (const bf16_t*)(sl + SL_RT) + n16 * 72 + q4 * 4;
                const int mo = (n16 * 20 + q4 * 4) * 2;
                const u32x2 vmf = *(const u32x2*)(sl + SL_VT + ((vt * 16 + n16) * 20 + q4 * 4) * 2);
                f32x4 X = {0.f, 0.f, 0.f, 0.f};
                X = __builtin_amdgcn_mfma_f32_16x16x32_bf16(lo_hi(*(const u32x2*)(AT), *(const u32x2*)(AT + 16)), sf0, X, 0, 0, 0);
                X = __builtin_amdgcn_mfma_f32_16x16x32_bf16(lo_hi(*(const u32x2*)(AT + 32), *(const u32x2*)(AT + 48)), sf1, X, 0, 0, 0);
                X = __builtin_amdgcn_mfma_f32_16x16x32_bf16(lo_hi(zero2, *(const u32x2*)(sl + SL_AAK + mo)), lo_hi(zero2, vmf), X, 0, 0, 0);
                f32x4 U = {0.f, 0.f, 0.f, 0.f};
                U = __builtin_amdgcn_mfma_f32_16x16x32_bf16(lo_hi(*(const u32x2*)(sl + SL_TT + mo), zero2), lo_hi((u32x2){cvt_pk(X[0], X[1]), cvt_pk(X[2], X[3])}, zero2), U, 0, 0, 0);
                const bf16x8 uv = lo_hi((u32x2){cvt_pk(U[0], U[1]), cvt_pk(U[2], U[3])}, vmf);
                f32x4 Y = {0.f, 0.f, 0.f, 0.f};
                Y = __builtin_amdgcn_mfma_f32_16x16x32_bf16(lo_hi(*(const u32x2*)(RT), *(const u32x2*)(RT + 16)), sf0, Y, 0, 0, 0);
                Y = __builtin_amdgcn_mfma_f32_16x16x32_bf16(lo_hi(*(const u32x2*)(RT + 32), *(const u32x2*)(RT + 48)), sf1, Y, 0, 0, 0);
                Y = __builtin_amdgcn_mfma_f32_16x16x32_bf16(lo_hi(*(const u32x2*)(sl + SL_ARB + mo), *(const u32x2*)(sl + SL_ARK + mo)), uv, Y, 0, 0, 0);
#pragma unroll
                for (int t = 0; t < 4; ++t) {
                    const f32x4 pc = *(const f32x4*)(sl + SL_PC + (t * 16 + q4 * 4) * 4);
                    const int kro = ((t * 16 + n16) * 20 + q4 * 4) * 2;
                    ST[t] = __builtin_amdgcn_mfma_f32_16x16x32_bf16(lo_hi(*(const u32x2*)(sl + SL_BH + kro), *(const u32x2*)(sl + SL_KH + kro)), uv, ST[t] * pc, 0, 0, 0);
                }
                float* yo = (float*)(lds + RW_SLOT + c2 * SL_SZ + SL_BT);
#pragma unroll
                for (int j = 0; j < 4; ++j) yo[(q4 * 4 + j) * 64 + vt * 16 + n16] = Y[j];
            }
        }
        RW_BAR();
        {
            const float* yo = (const float*)(slot + SL_BT);
#pragma unroll
            for (int jt = 0; jt < 2; ++jt) { const int i = hf * 8 + q4 * 2 + jt, o = i * 64 + n16 * 4; const int t = T0 + sgn * i;
                f32x4 y = *(const f32x4*)(yo + o);
                if (!fin) *(f32x4*)(Ysc + (size_t)t * 512 + n16 * 4) = y;
                else {
                    y = y + ysp[jt];
                    const float s1 = row_sum16(y[0] + y[1] + y[2] + y[3]), s2 = row_sum16(y[0] * y[0] + y[1] * y[1] + y[2] * y[2] + y[3] * y[3]);
                    const float mean = s1 * (1.f / 64.f), var = s2 * (1.f / 64.f) - mean * mean; const float rs = __builtin_amdgcn_rsqf(var + 64e-5f);
                    const u32x2 g2 = *(const u32x2*)(fgb + o), v2 = *(const u32x2*)(fgb + 1024 + o);
                    const float o0 = ((y[0] - mean) * rs * lng4[0] + lnb4[0]) * bf_lo(g2[0]) + bf_lo(v2[0]), o1 = ((y[1] - mean) * rs * lng4[1] + lnb4[1]) * bf_hi(g2[0]) + bf_hi(v2[0]);
                    const float o2 = ((y[2] - mean) * rs * lng4[2] + lnb4[2]) * bf_lo(g2[1]) + bf_lo(v2[1]), o3 = ((y[3] - mean) * rs * lng4[3] + lnb4[3]) * bf_hi(g2[1]) + bf_hi(v2[1]);
                    *(u32x2*)(Ob + (size_t)t * 1024 + n16 * 4) = (u32x2){cvt_pk(o0, o1), cvt_pk(o2, o3)};
                }
            }
        }
        if (s == SEQ / 128 - 1) {
            asm volatile("s_waitcnt vmcnt(0)" ::: "memory");
            __syncthreads();
            if (tid == 0) { __builtin_amdgcn_fence(__ATOMIC_RELEASE, "agent"); asm volatile("s_waitcnt vmcnt(0)" ::: "memory"); __hip_atomic_store(flags + task * 16, 1u, __ATOMIC_RELAXED, __HIP_MEMORY_SCOPE_AGENT); }
        }
    }
}

DI void phase_mixer(const Params& P, unsigned char* lds, int qsel, int mode = 0) {
    const int lane = threadIdx.x & 63;
    const float lam = __expf(wave_sum(P.da_lq1[lane] * P.da_lk1[lane])) - __expf(wave_sum(P.da_lq2[lane] * P.da_lk2[lane])) + 0.2f;
    float mq = fabsf(P.da_q_norm_g[lane]), mk = fabsf(P.da_k_norm_g[lane]);
#pragma unroll
    for (int o = 32; o >= 1; o >>= 1) { mq = fmaxf(mq, __shfl_xor(mq, o)); mk = fmaxf(mk, __shfl_xor(mk, o)); }
    const float smax_ = 8.0f * mq * mk * 1.01f;
    unsigned* qhead = (unsigned*)(P.ws + WS_CTL) + CW_QUEUE + qsel;
    volatile unsigned* qw = (volatile unsigned*)(lds + LDS_QW);
    volatile float* pw = (volatile float*)(lds + LDS_QW + 4);
    if (threadIdx.x == 0) { pw[0] = lam; pw[1] = smax_; }
    for (;;) {
        __syncthreads();
        if (threadIdx.x == 0) *qw = atomicAdd(qhead, 1u) + (mode == 2 ? 128u : 0u);
        __syncthreads();
        const unsigned idx = *qw;
#ifndef AT_REP
#define AT_REP 1
#endif
        if (idx >= 128u + 2048u * AT_REP || (mode == 1 && idx >= 128u)) break;
#if !defined(MIX_ONLY) || MIX_ONLY == 1
        if (idx < 128u) rwkv_task(P, lds, (int)(idx >> 4), (int)((idx >> 1) & 7), (int)(idx & 1));
#endif
#if !defined(MIX_ONLY) || MIX_ONLY == 2
        if (idx >= 128u) { const unsigned u = (idx - 128u) & 2047u; const int h = 3 - (int)(u >> 9), b = (int)((u >> 6) & 7), qb = (int)(u & 63);
            const float lam_ = pw[0], smax = pw[1];
            const float slope = exp2f(-2.0f * (float)(h + 1)); int W = (int)ceilf((25.65f + 2.0f * smax) / slope); if (W > SEQ) W = SEQ;
            attn_unit(P, lds, b, h, qb, lam_, smax * LOG2E, W); }
#endif
    }
}

constexpr int N_PHASES = 13;
__global__ void __launch_bounds__(512, 2) mega(Params P) {
    extern __shared__ __attribute__((aligned(16))) unsigned char shm[];
    LAS unsigned char* lds = (LAS unsigned char*)shm;
    unsigned char* ws = P.ws;
    if (threadIdx.x == 0) *(LAS u32x4*)(lds + LDS_XB) = (u32x4){0u, 0u, 0u, 0u};
    __syncthreads();
    XcdBarrier bar = xcd_barrier_post((unsigned*)(ws + WS_CTL) + CW_BAR + (size_t)P.ph_lo * 0, (volatile LAS unsigned*)(lds + LDS_XB));
#ifndef ONLY_PHASE
#define RUN(k) (P.ph_lo <= (k) && (k) < P.ph_hi)
#else
#define RUN(k) ((k) == ONLY_PHASE && P.ph_lo <= (k) && (k) < P.ph_hi)
#endif
#define SYNC(k) do { if (P.ph_lo <= (k) && (k) + 1 < P.ph_hi) xcd_barrier(bar); } while (0)
    if (RUN(0)) phase_prep(P, shm);
#if defined(REP_PHASE) && REP_PHASE == 0
    xcd_barrier(bar); phase_prep(P, shm);
#endif
    SYNC(0);
    if (RUN(1)) { DenseOrder S; S.init(ws + WS_U, ws + WS_WIN, MTOK, IN_PAD, 2048, 2048); EpiZ E{(bf16_t*)(ws + WS_Z)}; gemm_phase<false>(lds, 1024, 1024, S, E);
#if defined(REP_PHASE) && REP_PHASE == 1
        xcd_barrier(bar); gemm_phase<false>(lds, 1024, 1024, S, E);
#endif
    }
    SYNC(1);
    if (RUN(2)) phase_qknorm(P);
    SYNC(2);
#if defined(REP_PHASE) && REP_PHASE == 3
    if (RUN(3)) for (int rep = 0; rep < 2; ++rep) { if (rep) xcd_barrier(bar); phase_mixer(P, shm, rep, rep ? REP_MODE : 0); }
#else
    if (RUN(3)) phase_mixer(P, shm, 0);
#endif
    SYNC(3);
    if (RUN(4)) { DenseOrder S; S.init(ws + WS_O, ws + WS_WOUT, MTOK, 1024, 2048, 2048); EpiH1 E{P.x, P.out}; gemm_phase<false>(lds, 1024, 1024, S, E);
#if defined(REP_PHASE) && REP_PHASE == 4
        xcd_barrier(bar); gemm_phase<false>(lds, 1024, 1024, S, E);
#endif
    }
    SYNC(4);
    if (RUN(5)) phase_route(P, lds);
    SYNC(5);
    if (RUN(6)) { moe_tables(lds, (const unsigned*)(ws + WS_CTL) + CW_CNT);
        MoeOrder<8, true> S{(const char*)(ws + WS_U), (const char*)(ws + WS_W1), (size_t)2048 * 1024 * 2, 0, 128, (int)gridDim.x, (int)blockIdx.x, lds, (const int*)(ws + WS_LIST)};
        EpiMoe1 E{(bf16_t*)(ws + WS_Z), P.b1}; gemm_phase<false>(lds, 1024, 1024, S, E);
#if defined(REP_PHASE) && REP_PHASE == 6
        xcd_barrier(bar); gemm_phase<false>(lds, 1024, 1024, S, E);
#endif
    }
    SYNC(6);
#define MOE2(k, s) if (RUN(k)) { moe_tables(lds, (const unsigned*)(ws + WS_CTL) + CW_CNT); \
        MoeOrder<4, false> S{(const char*)(ws + WS_Z), (const char*)(ws + WS_W2), (size_t)1024 * 1024 * 2, 32 * (s), 32, (int)gridDim.x, (int)blockIdx.x, lds, (const int*)(ws + WS_LIST)}; \
        EpiMoe2 E{P.out, (bf16_t*)(ws + WS_U), P.b2, (const int*)(ws + WS_LIST), (const float*)(ws + WS_GATE), (s)}; gemm_phase<false>(lds, 1024, 1024, S, E); } SYNC(k);
    MOE2(7, 0) MOE2(8, 1) MOE2(9, 2) MOE2(10, 3)
    if (RUN(11)) { DenseOrder S; S.init(ws + WS_PB, ws + WS_WPLE, MTOK, 1024, 512, 512); EpiPle E{(bf16_t*)(ws + WS_Z), (float*)(ws + WS_ESS)}; gemm_phase<true>(lds, 256, 256, S, E); }
    SYNC(11);
    if (RUN(12)) { DenseOrder S; S.init(ws + WS_U, ws + WS_WG, MTOK, 1024, 2048, 2048); EpiFinal E{P.out, (const bf16_t*)(ws + WS_Z), (const float*)(ws + WS_ESS), P.ple_norm_g}; gemm_phase<false>(lds, 1024, 1024, S, E); }
}

#ifndef MK_N_LAUNCHES
#define MK_N_LAUNCHES 1
#endif
extern "C" void kernel_launch(void* const* d_in, const int* in_sizes, int n_in, void* d_out, int out_size, void* d_ws, size_t ws_size, hipStream_t stream) {
    static int grid = 0;
    if (grid == 0) {
        if (n_in != 33 || in_sizes[0] != MTOK * D_MODEL || out_size != MTOK * D_MODEL || ws_size < WS_END) {
            fprintf(stderr, "kernel_launch: shape mismatch: n_in %d in0 %d out %d ws %zu (need %zu)\n", n_in, n_in > 0 ? in_sizes[0] : -1, out_size, ws_size, (size_t)WS_END); grid = -1; return; }
        int dev = 0, cus = 0, per_cu = 0;
        if (hipGetDevice(&dev) != hipSuccess || hipDeviceGetAttribute(&cus, hipDeviceAttributeMultiprocessorCount, dev) != hipSuccess) { grid = -1; return; }
        if (hipFuncSetAttribute((const void*)mega, hipFuncAttributeMaxDynamicSharedMemorySize, LDS_BYTES) != hipSuccess) { fprintf(stderr, "kernel_launch: hipFuncSetAttribute failed\n"); grid = -1; return; }
        if (hipOccupancyMaxActiveBlocksPerMultiprocessor(&per_cu, (const void*)mega, 512, LDS_BYTES) != hipSuccess || per_cu < 1) fprintf(stderr, "kernel_launch: occupancy query says %d\n", per_cu);
        (void)hipGetLastError();
        grid = cus;
    }
    if (grid < 0) return;
    (void)hipMemsetAsync((char*)d_ws + WS_CTL, 0, CTL_BYTES, stream);
    (void)hipMemsetAsync((char*)d_ws + WS_ESS, 0, (size_t)MTOK * 4, stream);
    Params p{};
    const float** f = (const float**)&p;
    for (int i = 0; i < 33; ++i) f[i] = (const float*)d_in[i];
    p.out = (float*)d_out; p.ws = (unsigned char*)d_ws;
    if (MK_N_LAUNCHES == 1) { p.ph_lo = 0; p.ph_hi = N_PHASES; hipLaunchKernelGGL(mega, dim3(grid), dim3(512), LDS_BYTES, stream, p); }
    else for (int k = 0; k < N_PHASES; ++k) { p.ph_lo = k; p.ph_hi = k + 1; hipLaunchKernelGGL(mega, dim3(grid), dim3(512), LDS_BYTES, stream, p); }
    const hipError_t le = hipPeekAtLastError();
    if (le != hipSuccess) fprintf(stderr, "kernel_launch: launch failed: %s\n", hipGetErrorName(le));
}
```

```cpp
#include <hip/hip_runtime.h>
#include <stdint.h>
#include <stdio.h>

#define LAS __attribute__((address_space(3)))
#define DI __device__ __forceinline__
typedef unsigned short bf16_t;
typedef short bf16x8 __attribute__((ext_vector_type(8)));
typedef short s16x4 __attribute__((ext_vector_type(4)));
typedef float f32x4 __attribute__((ext_vector_type(4)));
typedef float f32x2 __attribute__((ext_vector_type(2)));
typedef float f32x16 __attribute__((ext_vector_type(16)));
typedef unsigned u32x4 __attribute__((ext_vector_type(4)));
typedef unsigned u32x2 __attribute__((ext_vector_type(2)));
typedef __bf16 bf16x2_t __attribute__((ext_vector_type(2)));

constexpr int D_MODEL = 1024, BATCH = 8, SEQ = 8192, MTOK = BATCH * SEQ;
constexpr int PLE_DIM = 256;
constexpr int C_RW = 512, RW_HEAD = 64, RW_HEADS = 8, RW_COLS = 1920;
constexpr int C_DA = 512, DA_HEADS = 4, DA_V = 128, DA_QK = 64;
constexpr int IN_COLS = 3456, IN_PAD = 3584;
constexpr int N_EXP = 32, TOPK = 4, D_FF = 1024;
constexpr int ZR = 0, ZK = 512, ZV = 1024, ZWD = 1536, ZAD = 1664, ZGD = 1792, ZQ = 1920, ZKK = 2432, ZVV = 2944;
constexpr float NORM_EPS = 1e-6f;
constexpr float LOG2E = 1.4426950408889634f;

constexpr size_t MiB = 1024ull * 1024ull;
constexpr size_t WS_CTL = 0;
constexpr size_t CTL_BYTES = 64 * 1024;
constexpr size_t WS_WIN = WS_CTL + CTL_BYTES;
constexpr size_t WS_WOUT = WS_WIN + (size_t)IN_PAD * 1024 * 2;
constexpr size_t WS_W1 = WS_WOUT + 2 * MiB;
constexpr size_t WS_W2 = WS_W1 + 128 * MiB;
constexpr size_t WS_WPLE = WS_W2 + 64 * MiB;
constexpr size_t WS_WG = WS_WPLE + MiB / 2;
constexpr size_t WS_PB = WS_WG + 2 * MiB;
constexpr size_t WS_U = WS_PB + 32 * MiB;
constexpr size_t WS_Z = WS_U + 128 * MiB;
constexpr size_t WS_Y8 = WS_Z + 288 * MiB;
constexpr size_t WS_HB = WS_W1;
constexpr size_t WS_O = WS_Z + 432 * MiB;
constexpr size_t WS_LIST = WS_Z + 576 * MiB;
constexpr size_t WS_GATE = WS_LIST + 32 * MiB;
constexpr size_t WS_ESS = WS_GATE + MiB;
constexpr size_t WS_XL = WS_ESS + MiB / 4;
constexpr size_t WS_TOKPOS = WS_XL;
constexpr size_t WS_END = WS_XL + 48 * MiB;
constexpr int ACT_ROWS_MAX = 262144 + 128 * 256;

constexpr int CW_BAR = 0;
constexpr int CW_CNT = 4096;
constexpr int CW_QUEUE = 4352;
constexpr int CW_LAM = 4416;
constexpr int CW_RWFLAG = 4480;

struct Params {
    const float* x; const float* p; const float* norm_mix_g; const float* w_in; const float* rw_mu; const float* rw_w0; const float* rw_w2;
    const float* rw_a0; const float* rw_a2; const float* rw_g2; const float* rw_k_k; const float* rw_k_a; const float* rw_r_k; const float* rw_ln_g;
    const float* rw_ln_b; const float* da_q_norm_g; const float* da_k_norm_g; const float* da_lq1; const float* da_lk1; const float* da_lq2;
    const float* da_lk2; const float* da_subln_g; const float* w_out; const float* norm_ffn_g; const float* w_router; const float* b_router;
    const float* w1; const float* b1; const float* w2; const float* b2; const float* w_ple; const float* ple_norm_g; const float* w_ple_gate;
    float* out; unsigned char* ws; int ph_lo, ph_hi;
};

DI unsigned cvt_pk(float lo, float hi) { f32x2 v = {lo, hi}; bf16x2_t r = __builtin_convertvector(v, bf16x2_t); return __builtin_bit_cast(unsigned, r); }
DI unsigned pk4_fp8(float a, float b, float c, float d) { int v = __builtin_amdgcn_cvt_pk_fp8_f32(a, b, 0, false); v = __builtin_amdgcn_cvt_pk_fp8_f32(c, d, v, true); return (unsigned)v; }
DI bf16x8 pack8(float a0, float a1, float a2, float a3, float a4, float a5, float a6, float a7) { u32x4 w = {cvt_pk(a0, a1), cvt_pk(a2, a3), cvt_pk(a4, a5), cvt_pk(a6, a7)}; return __builtin_bit_cast(bf16x8, w); }
DI float bf_lo(unsigned u) { return __uint_as_float(u << 16); }
DI float bf_hi(unsigned u) { return __uint_as_float(u & 0xffff0000u); }
DI float bf2f(bf16_t b) { return __uint_as_float(((unsigned)b) << 16); }
DI bf16_t f2bf(float f) { return (bf16_t)(cvt_pk(f, f) & 0xffffu); }
template <int CTRL, int RM> DI float dpp_mov0(float v) { return __builtin_bit_cast(float, __builtin_amdgcn_update_dpp(0, __builtin_bit_cast(int, v), CTRL, RM, 0xF, false)); }
DI float row_sum16(float v) {
    v += dpp_mov0<0x121, 0xF>(v); v += dpp_mov0<0x122, 0xF>(v); v += dpp_mov0<0x124, 0xF>(v); v += dpp_mov0<0x128, 0xF>(v); return v;
}
DI float wave_sum(float v) {
    v = row_sum16(v);
    v += dpp_mov0<0x142, 0xA>(v);
    v += dpp_mov0<0x143, 0xC>(v);
    return __builtin_bit_cast(float, __builtin_amdgcn_readlane(__builtin_bit_cast(int, v), 63));
}
DI float xsum16(float v) { const unsigned u = __builtin_bit_cast(unsigned, v); auto r = __builtin_amdgcn_permlane16_swap(u, u, false, false); return __builtin_bit_cast(float, (unsigned)r[0]) + __builtin_bit_cast(float, (unsigned)r[1]); }
DI float xsum32(float v) { const unsigned u = __builtin_bit_cast(unsigned, v); auto r = __builtin_amdgcn_permlane32_swap(u, u, false, false); return __builtin_bit_cast(float, (unsigned)r[0]) + __builtin_bit_cast(float, (unsigned)r[1]); }
DI float wave_max(float v) {
    v = fmaxf(v, dpp_mov0<0x121, 0xF>(v)); v = fmaxf(v, dpp_mov0<0x122, 0xF>(v)); v = fmaxf(v, dpp_mov0<0x124, 0xF>(v)); v = fmaxf(v, dpp_mov0<0x128, 0xF>(v));
    const unsigned u = __builtin_bit_cast(unsigned, v); auto r = __builtin_amdgcn_permlane16_swap(u, u, false, false); v = fmaxf(__builtin_bit_cast(float, (unsigned)r[0]), __builtin_bit_cast(float, (unsigned)r[1]));
    const unsigned w = __builtin_bit_cast(unsigned, v); auto q = __builtin_amdgcn_permlane32_swap(w, w, false, false); return fmaxf(__builtin_bit_cast(float, (unsigned)q[0]), __builtin_bit_cast(float, (unsigned)q[1]));
}
DI float sigmoidf_(float x) { return __builtin_amdgcn_rcpf(1.f + __builtin_amdgcn_exp2f(-x * LOG2E)); }

#define XB_TMO      128
#define XB_XCNT(j)  (256  + 64 * (j))
#define XB_XSUB(j)  (1280 + 64 * (j))
#define XB_XGEN(j)  (2304 + 64 * (j))
#define XB_TOP      3328
#define XB_TOPGEN   3392
#define XCD_BAR_WORDS 3456
#define XB_SPIN_CAP (1u << 22)
DI unsigned xb_ld(unsigned* p)              { return __hip_atomic_load(p, __ATOMIC_RELAXED, __HIP_MEMORY_SCOPE_AGENT); }
DI unsigned xb_add(unsigned* p, unsigned v) { return __hip_atomic_fetch_add(p, v, __ATOMIC_RELAXED, __HIP_MEMORY_SCOPE_AGENT); }
DI unsigned xb_xcc_id() { return (unsigned)__builtin_amdgcn_s_getreg((3 << 11) | 20) & 0xFu; }
#define XB_SPIN(cond, bar) do { unsigned _sp = 0; while (cond) { __builtin_amdgcn_s_sleep(1); \
    if ((++_sp & 255u) == 0u) { if (xb_ld(&(bar)[XB_TMO])) break; if (_sp > XB_SPIN_CAP) { atomicAdd(&(bar)[XB_TMO], 1u); break; } } } } while (0)
__device__ unsigned g_xbar[XCD_BAR_WORDS + 64];
struct XcdBarrier { unsigned* bar; unsigned x; volatile LAS unsigned* st; };
DI XcdBarrier xcd_barrier_post(unsigned* bar, volatile LAS unsigned* st) {
    XcdBarrier b; b.bar = bar; b.x = xb_xcc_id(); b.st = st;
    if (threadIdx.x == 0) (void)xb_add(&bar[XB_XCNT(b.x)], 1u);
    return b;
}
DI void xcd_barrier_complete(unsigned* bar, unsigned x, unsigned& nloc, unsigned& nx) {
    const unsigned G = gridDim.x * gridDim.y * gridDim.z;
    unsigned sum, cnt, mine, sp = 0u;
    for (;;) {
        sum = 0u; cnt = 0u; mine = 0u;
#pragma unroll
        for (unsigned j = 0; j < 16; ++j) { const unsigned c = xb_ld(&bar[XB_XCNT(j)]); sum += c; cnt += (c > 0u) ? 1u : 0u; mine = (j == x) ? c : mine; }
        if (sum == G) break;
        __builtin_amdgcn_s_sleep(1);
        if ((++sp & 255u) == 0u) { if (xb_ld(&bar[XB_TMO])) break; if (sp > XB_SPIN_CAP) { atomicAdd(&bar[XB_TMO], 1u); break; } }
    }
    nloc = mine > 0u ? mine : 1u; nx = cnt > 0u ? cnt : 1u;
}
DI void xcd_barrier(const XcdBarrier& b) {
    asm volatile("s_waitcnt vmcnt(0)" ::: "memory");
    __syncthreads();
    if (threadIdx.x == 0) {
        unsigned* bar = b.bar;
        __builtin_amdgcn_s_waitcnt(0);
        unsigned nloc = b.st[0], nx = b.st[1];
        if (nloc == 0u) { xcd_barrier_complete(bar, b.x, nloc, nx); b.st[0] = nloc; b.st[1] = nx; }
        const unsigned old = xb_add(&bar[XB_XSUB(b.x)], 1u);
        const unsigned gen = old / nloc;
        if (old + 1u == (gen + 1u) * nloc) {
            __builtin_amdgcn_fence(__ATOMIC_RELEASE, "agent");
            asm volatile("s_waitcnt vmcnt(0)" ::: "memory");
            const unsigned og = xb_add(&bar[XB_TOP], 1u);
            const unsigned tg = og / nx;
            if (og + 1u == (tg + 1u) * nx) xb_add(&bar[XB_TOPGEN], 1u);
            else XB_SPIN(xb_ld(&bar[XB_TOPGEN]) == tg, bar);
            __builtin_amdgcn_fence(__ATOMIC_ACQUIRE, "agent");
            xb_add(&bar[XB_XGEN(b.x)], 1u);
            asm volatile("s_waitcnt vmcnt(0)" ::: "memory");
        } else {
            XB_SPIN(xb_ld(&bar[XB_XGEN(b.x)]) == gen, bar);
            __builtin_amdgcn_fence(__ATOMIC_ACQUIRE, "agent");
            asm volatile("s_waitcnt vmcnt(0)" ::: "memory");
        }
    }
    __syncthreads();
}

constexpr int BM = 256, BK = 64, HALF = 128, HTB = HALF * BK * 2, STAGE_BYTES = 8 * HTB, NXCD = 8, WGM = 8;
constexpr int LDS_TAB = STAGE_BYTES;
constexpr int LDS_GRP = STAGE_BYTES + 2048;
constexpr int LDS_BYTES = 156 * 1024;
constexpr int LDS_XB = LDS_BYTES - 16;
constexpr int LDS_QW = LDS_BYTES - 32;

DI void tconv_tile(const float* __restrict__ src, int ldn, int k0, int ncol0, bool zero, bf16_t* __restrict__ dst, int K, int nrow0, float* tile  ) {
    const int t = threadIdx.x;
    {
        const int kk = t >> 4, c4 = (t & 15) * 4;
#pragma unroll
        for (int i = 0; i < 2; ++i) {
            const int k = kk + 32 * i;
            f32x4 v = {0.f, 0.f, 0.f, 0.f};
            if (!zero) v = *(const f32x4*)(src + (size_t)(k0 + k) * ldn + ncol0 + c4);
            tile[(c4 + 0) * 65 + k] = v[0]; tile[(c4 + 1) * 65 + k] = v[1]; tile[(c4 + 2) * 65 + k] = v[2]; tile[(c4 + 3) * 65 + k] = v[3];
        }
    }
    __syncthreads();
    {
        const int n = t >> 3, kc = (t & 7) * 8;
        const float* r = tile + n * 65 + kc;
        u32x4 o = {cvt_pk(r[0], r[1]), cvt_pk(r[2], r[3]), cvt_pk(r[4], r[5]), cvt_pk(r[6], r[7])};
        *(u32x4*)(dst + (size_t)(nrow0 + n) * K + k0 + kc) = o;
    }
    __syncthreads();
}

DI void tconv_tile8(const float* __restrict__ src, int ldn, int k0, int ncol0, unsigned char* __restrict__ dst, int K, int nrow0, float sc, float* tile) {
    const int t = threadIdx.x;
    {
        const int kk = t >> 4, c4 = (t & 15) * 4;
#pragma unroll
        for (int i = 0; i < 2; ++i) {
            const int k = kk + 32 * i;
            const f32x4 v = *(const f32x4*)(src + (size_t)(k0 + k) * ldn + ncol0 + c4);
            tile[(c4 + 0) * 65 + k] = v[0]; tile[(c4 + 1) * 65 + k] = v[1]; tile[(c4 + 2) * 65 + k] = v[2]; tile[(c4 + 3) * 65 + k] = v[3];
        }
    }
    __syncthreads();
    {
        const int n = t >> 3, kc = (t & 7) * 8;
        const float* r = tile + n * 65 + kc;
        u32x2 o = {pk4_fp8(r[0] * sc, r[1] * sc, r[2] * sc, r[3] * sc), pk4_fp8(r[4] * sc, r[5] * sc, r[6] * sc, r[7] * sc)};
        *(u32x2*)(dst + (size_t)(nrow0 + n) * K + k0 + kc) = o;
    }
    __syncthreads();
}
constexpr float W8_SCALE = 64.0f, M8_SCALE = 16.0f, A8_SCALE = 4.0f, Y8_SCALE = 16.0f;

struct TJob { const float* src; unsigned char* dst; int ldn, K, kind; bool zero; };
constexpr int PJ0 = 16 * 56, PJ1 = PJ0 + 256, PJ2 = PJ1 + 32 * 16 * 32, PJ3 = PJ2 + 32 * 16 * 16, PJ4 = PJ3 + 64, PJ5 = PJ4 + 256;
DI TJob prep_job(const Params& P, int j) {
    unsigned char* ws = P.ws; TJob r; r.zero = false;
    if (j < PJ0) { const int kt = j / 56, nt = j % 56; r.src = P.w_in + (size_t)kt * 64 * IN_COLS + nt * 64; r.ldn = IN_COLS; r.dst = ws + WS_WIN + ((size_t)nt * 64 * 1024 + kt * 64) * 2; r.K = 1024; r.kind = 0; r.zero = nt >= 54; }
    else if (j < PJ1) { const int q = j - PJ0, kt = q >> 4, nt = q & 15; r.src = P.w_out + (size_t)kt * 64 * 1024 + nt * 64; r.ldn = 1024; r.dst = ws + WS_WOUT + ((size_t)nt * 64 * 1024 + kt * 64) * 2; r.K = 1024; r.kind = 0; }
    else if (j < PJ2) { const int q = j - PJ1, e = q >> 9, rr = q & 511, kt = rr >> 5, nt = rr & 31; const int n0 = nt * 64;
        const int orig = ((n0 & 128) ? 1024 : 0) + (n0 >> 8) * 128 + (n0 & 127);
        r.src = P.w1 + (size_t)e * 1024 * 2048 + (size_t)kt * 64 * 2048 + orig; r.ldn = 2048; r.dst = ws + WS_W1 + (size_t)e * 2048 * 1024 + (size_t)n0 * 1024 + kt * 64; r.K = 1024; r.kind = 1; }
    else if (j < PJ3) { const int q = j - PJ2, e = q >> 8, rr = q & 255, kt = rr >> 4, nt = rr & 15;
        r.src = P.w2 + (size_t)e * 1024 * 1024 + (size_t)kt * 64 * 1024 + nt * 64; r.ldn = 1024; r.dst = ws + WS_W2 + (size_t)e * 1024 * 1024 + (size_t)nt * 64 * 1024 + kt * 64; r.K = 1024; r.kind = 1; }
    else if (j < PJ4) { const int q = j - PJ3, kt = q >> 4, nt = q & 15; r.src = P.w_ple + (size_t)kt * 64 * 1024 + nt * 64; r.ldn = 1024; r.dst = ws + WS_WPLE + ((size_t)nt * 64 * 256 + kt * 64) * 2; r.K = 256; r.kind = 0; }
    else { const int q = j - PJ4, kt = q >> 4, nt = q & 15; r.src = P.w_ple_gate + (size_t)kt * 64 * 1024 + nt * 64; r.ldn = 1024; r.dst = ws + WS_WG + (size_t)nt * 64 * 1024 + kt * 64; r.K = 1024; r.kind = 1; }
    return r;
}

DI void phase_prep(const Params& P, unsigned char* lds_generic) {
    float* tile = (float*)lds_generic;
    const int wg = blockIdx.x, nwg = gridDim.x;
    unsigned char* ws = P.ws;
    {
        constexpr int TB = 4, TSZ = 64 * 65;
        const int t = threadIdx.x, kk = t >> 4, c4 = (t & 15) * 4, n = t >> 3, kc = (t & 7) * 8;
        f32x4 v[TB][2];
#define PREP_LOAD(jb_) do { _Pragma("unroll") for (int u_ = 0; u_ < TB; ++u_) { const int j_ = (jb_) + u_ * nwg; if (j_ < PJ5) { const TJob J_ = prep_job(P, j_); \
            _Pragma("unroll") for (int i_ = 0; i_ < 2; ++i_) { v[u_][i_] = (f32x4){0.f, 0.f, 0.f, 0.f}; if (!J_.zero) v[u_][i_] = *(const f32x4*)(J_.src + (size_t)(kk + 32 * i_) * J_.ldn + c4); } } } } while (0)
        int set = 0;
        PREP_LOAD(wg);
        for (int jb = wg; jb < PJ5; jb += TB * nwg) {
            float* tl = tile + set * TB * TSZ;
#pragma unroll
            for (int u = 0; u < TB; ++u) if (jb + u * nwg < PJ5) {
#pragma unroll
                for (int i = 0; i < 2; ++i) { const int k = kk + 32 * i; float* w = tl + u * TSZ + c4 * 65 + k; w[0] = v[u][i][0]; w[65] = v[u][i][1]; w[130] = v[u][i][2]; w[195] = v[u][i][3]; }
            }
            __syncthreads();
            if (jb + TB * nwg < PJ5) PREP_LOAD(jb + TB * nwg);
#pragma unroll
            for (int u = 0; u < TB; ++u) { const int j = jb + u * nwg; if (j < PJ5) { const TJob J = prep_job(P, j);
                const float* r = tl + u * TSZ + n * 65 + kc;
                if (J.kind == 0) { u32x4 o = {cvt_pk(r[0], r[1]), cvt_pk(r[2], r[3]), cvt_pk(r[4], r[5]), cvt_pk(r[6], r[7])}; *(u32x4*)(J.dst + ((size_t)n * J.K + kc) * 2) = o; }
                else { const float sc = W8_SCALE; u32x2 o = {pk4_fp8(r[0] * sc, r[1] * sc, r[2] * sc, r[3] * sc), pk4_fp8(r[4] * sc, r[5] * sc, r[6] * sc, r[7] * sc)}; *(u32x2*)(J.dst + (size_t)n * J.K + kc) = o; } } }
            set ^= 1;
        }
#undef PREP_LOAD
    }
    {
        const int wid = __builtin_amdgcn_readfirstlane(threadIdx.x >> 6), lane = threadIdx.x & 63;
        f32x4 g[4];
#pragma unroll
        for (int i = 0; i < 4; ++i) g[i] = *(const f32x4*)(P.norm_mix_g + 4 * lane + 256 * i);
        bf16_t* U = (bf16_t*)(ws + WS_U);
        const int rstep = nwg * 8; int row = wg * 8 + wid;
        f32x4 vn[4];
#pragma unroll
        for (int i = 0; i < 4; ++i) vn[i] = (row < MTOK) ? *(const f32x4*)(P.x + (size_t)row * 1024 + 4 * lane + 256 * i) : (f32x4){0.f, 0.f, 0.f, 0.f};
        for (; row < MTOK; row += rstep) {
            f32x4 v[4]; float ss = 0.f;
#pragma unroll
            for (int i = 0; i < 4; ++i) { v[i] = vn[i]; ss += v[i][0] * v[i][0] + v[i][1] * v[i][1] + v[i][2] * v[i][2] + v[i][3] * v[i][3]; }
            const int rn = row + rstep;
            if (rn < MTOK) {
#pragma unroll
                for (int i = 0; i < 4; ++i) vn[i] = *(const f32x4*)(P.x + (size_t)rn * 1024 + 4 * lane + 256 * i);
            }
            ss = wave_sum(ss);
            const float rinv = __builtin_amdgcn_rsqf(ss * (1.f / 1024.f) + NORM_EPS);
#pragma unroll
            for (int i = 0; i < 4; ++i) {
                u32x2 o = {cvt_pk(v[i][0] * rinv * g[i][0], v[i][1] * rinv * g[i][1]), cvt_pk(v[i][2] * rinv * g[i][2], v[i][3] * rinv * g[i][3])};
                *(u32x2*)(U + (size_t)row * 1024 + 4 * lane + 256 * i) = o;
            }
        }
    }
    { unsigned* ctl = (unsigned*)(ws + WS_CTL); for (int i = wg * 512 + (int)threadIdx.x; i < (int)(CTL_BYTES / 4) - CW_CNT; i += nwg * 512) ctl[CW_CNT + i] = 0u; }
    { float* ESS = (float*)(ws + WS_ESS); for (int i = wg * 512 + (int)threadIdx.x; i < MTOK; i += nwg * 512) ESS[i] = 0.f; }
    {
        bf16_t* PB = (bf16_t*)(ws + WS_PB);
        const size_t n8 = (size_t)MTOK * PLE_DIM / 8, st = (size_t)nwg * 512;
        for (size_t i0 = (size_t)wg * 512 + threadIdx.x; i0 < n8; i0 += 4 * st) {
            f32x4 a[4], b[4];
#pragma unroll
            for (int u = 0; u < 4; ++u) { const size_t i = i0 + u * st; if (i < n8) { a[u] = *(const f32x4*)(P.p + i * 8); b[u] = *(const f32x4*)(P.p + i * 8 + 4); } }
#pragma unroll
            for (int u = 0; u < 4; ++u) { const size_t i = i0 + u * st; if (i < n8) {
                u32x4 o = {cvt_pk(a[u][0], a[u][1]), cvt_pk(a[u][2], a[u][3]), cvt_pk(b[u][0], b[u][1]), cvt_pk(b[u][2], b[u][3])};
                *(u32x4*)(PB + i * 8) = o; } }
        }
    }
}

DI int lds_byte(int r, int c) { const int st = (r >> 4) * 2 + (c >> 5), rr = r & 15, cc = c & 31, ob = rr * 64 + cc * 2; return st * 1024 + (ob ^ (((ob >> 9) & 1) << 5)); }
DI void stage_rc(int b, int& R, int& C) { const int st = b / 1024, sb = b % 1024, swz = sb ^ (((sb >> 9) & 1) << 5); R = (st >> 1) * 16 + swz / 64; C = (st & 1) * 32 + (swz % 64) / 2; }
DI int perm32(int rho) { const int n = rho >> 4, i = rho & 15; return 8 * (i >> 2) + 4 * n + (i & 3); }

struct Unit { unsigned ao, bo; int pm, pn, g, cnt, arow; };
typedef f32x4 AccT[2][2][4][2];

struct DenseOrder {
    const char* A; const char* B; int nM, nN, nwg, G, c; size_t astep, bstep; int shift = 0;
    DI void init(const void* A_, const void* B_, int M, int N, int lda_bytes, int ldb_bytes) { A = (const char*)A_; B = (const char*)B_; nM = M / BM; nN = N / BM; nwg = nM * nN; G = gridDim.x; c = blockIdx.x; astep = (size_t)BM * lda_bytes; bstep = (size_t)BM * ldb_bytes; }
    static constexpr bool GATHER = false;
    DI bool next(int i, Unit& u) const {
        const long L = (long)i * G + c + shift; if (L >= nwg) return false;
        int wgid = (int)L; { const int q = nwg / NXCD, r = nwg % NXCD, xcd = wgid % NXCD, off = wgid / NXCD; wgid = (xcd < r ? xcd * (q + 1) : r * (q + 1) + (xcd - r) * q) + off; }
        const int nig = WGM * nN, gid = wgid / nig, fm = gid * WGM, gsz = (nM - fm) < WGM ? (nM - fm) : WGM;
        u.pm = fm + ((wgid % nig) % gsz); u.pn = (wgid % nig) / gsz; u.ao = (unsigned)((size_t)u.pm * astep); u.bo = (unsigned)((size_t)u.pn * bstep); u.g = 0; u.cnt = 256; u.arow = u.pm * 256; return true;
    }
    DI void issue_table(const Unit&, LAS unsigned char*) const {}
    DI unsigned row_off(const Unit&, LAS unsigned char*, int) const { return 0u; }
};

struct PleTailOrder {
    const char* A; const char* B; int u0, u1, u2;
    static constexpr bool GATHER = false;
    DI void init(const void* A_, const void* B_, int sl, int moe_units) {
        A = (const char*)A_; B = (const char*)B_; const int G = gridDim.x, c = blockIdx.x, r = moe_units % G, nidle = G - r, k = c - r;
        u0 = u1 = u2 = -1;
        if (k >= 0) { if (k < 256) u0 = 256 * sl + k; if (k + nidle < 256) u1 = 256 * sl + k + nidle; }
        const int rest0 = 2 * nidle;
        if (rest0 + c < 256) u2 = 256 * sl + rest0 + c;
        if (u0 < 0) { u0 = u1; u1 = -1; } if (u0 < 0) { u0 = u2; u2 = -1; } if (u1 < 0) { u1 = u2; u2 = -1; }
    }
    DI bool next(int i, Unit& u) const {
        const int L = i == 0 ? u0 : i == 1 ? u1 : i == 2 ? u2 : -1; if (L < 0) return false;
        u.pm = L >> 2; u.pn = L & 3; u.ao = (unsigned)u.pm * (256u * 512u); u.bo = (unsigned)u.pn * (256u * 512u); u.g = 0; u.cnt = 256; u.arow = u.pm * 256; return true;
    }
    DI void issue_table(const Unit&, LAS unsigned char*) const {}
    DI unsigned row_off(const Unit&, LAS unsigned char*, int) const { return 0u; }
};

#define G_WAIT_V(n) asm volatile("s_waitcnt vmcnt(" #n ")" ::: "memory")
#define G_WAIT_L(n) asm volatile("s_waitcnt lgkmcnt(" #n ")" ::: "memory")
#define G_BAR __builtin_amdgcn_s_barrier()
#define G_SCHED __builtin_amdgcn_sched_barrier(0)

typedef int i32x8 __attribute__((ext_vector_type(8)));
typedef unsigned u32x8 __attribute__((ext_vector_type(8)));
template <bool OPQ, int EB, class Sched, class Epi>
DI void gemm_phase(LAS unsigned char* lds, const int K_  , const int lda_  , const Sched& S, const Epi& E) {
    int K = K_, lda = lda_; if constexpr (OPQ) asm volatile("" : "+s"(K), "+s"(lda));
    const int tid = threadIdx.x, wid = __builtin_amdgcn_readfirstlane(tid >> 6), lane = tid & 63, wr = wid >> 2, wc = wid & 3, fr = lane & 15, fq = lane >> 4;
    const int nt = K * EB / (BK * 2);
    unsigned vA[2][2], voffB[2]; int R0 = 0, C0 = 0;
#pragma unroll
    for (int i = 0; i < 2; ++i) { int R, C; stage_rc(tid * 16 + i * 8192, R, C); const int Rb = Epi::REMAP ? (64 * (R >> 5) + perm32(R & 31)) : Epi::PERM ? ((R & ~31) + perm32(R & 31)) : R;
        if (i == 0) { R0 = R; C0 = C; } voffB[i] = (unsigned)(Rb * K * EB + C * 2);
        vA[0][i] = (unsigned)(R * lda * EB + C * 2); vA[1][i] = (unsigned)((R + HALF) * lda * EB + C * 2); }
    const unsigned kstep = BK * 2;
    const unsigned hstepB = (unsigned)((Epi::REMAP ? 32 : HALF) * K * EB);
    const __amdgpu_buffer_rsrc_t rsA = __builtin_amdgcn_make_buffer_rsrc((void*)S.A, 0, 0x7ffffff0, 0x00020000), rsB = __builtin_amdgcn_make_buffer_rsrc((void*)S.B, 0, 0x7ffffff0, 0x00020000);
    const unsigned ldsw = (unsigned)wid * 1024u;
    const int aoff = lds_byte(wr * 64 + fr, fq * 8), boff = lds_byte(wc * 32 + fr, fq * 8);
#define G_SA(b, h) (((b) * 2 + (h)) * HTB)
#define G_SB(b, h) ((4 + (b) * 2 + (h)) * HTB)
#define G_STAGE(bufoff, rs, so, v0, v1) do { \
        __builtin_amdgcn_raw_ptr_buffer_load_lds(rs, (LAS void*)(lds + (bufoff) + ldsw), 16, (int)(v0), (int)(so), 0, 0); \
        __builtin_amdgcn_raw_ptr_buffer_load_lds(rs, (LAS void*)(lds + (bufoff) + ldsw + 8192), 16, (int)(v1), (int)(so), 0, 0); } while (0)
#define G_LD16(off) (*(const LAS u32x4*)(lds + (off)))
#define G_LDA(dst, b, h) do { _Pragma("unroll") for (int m = 0; m < 4; ++m) { if constexpr (EB == 2) { dst[m].pq[0] = G_LD16(G_SA(b, h) + aoff + m * 2048); dst[m].pq[1] = G_LD16(G_SA(b, h) + aoff + m * 2048 + 1024); } \
        else dst[m].w8 = __builtin_shufflevector(G_LD16(G_SA(b, h) + aoff + m * 2048), G_LD16(G_SA(b, h) + aoff + m * 2048 + 1024), 0, 1, 2, 3, 4, 5, 6, 7); } } while (0)
#define G_LDB(dst, b, h) do { _Pragma("unroll") for (int n = 0; n < 2; ++n) { if constexpr (EB == 2) { dst[n].pq[0] = G_LD16(G_SB(b, h) + boff + n * 2048); dst[n].pq[1] = G_LD16(G_SB(b, h) + boff + n * 2048 + 1024); } \
        else dst[n].w8 = __builtin_shufflevector(G_LD16(G_SB(b, h) + boff + n * 2048), G_LD16(G_SB(b, h) + boff + n * 2048 + 1024), 0, 1, 2, 3, 4, 5, 6, 7); } } while (0)
#define G_MMA(ai, bj, At, Bt) do { __builtin_amdgcn_s_setprio(1); _Pragma("unroll") for (int m = 0; m < 4; ++m) _Pragma("unroll") for (int n = 0; n < 2; ++n) { \
        if constexpr (EB == 2) { _Pragma("unroll") for (int k = 0; k < 2; ++k) acc[ai][bj][m][n] = __builtin_amdgcn_mfma_f32_16x16x32_bf16(__builtin_bit_cast(bf16x8, Bt[n].pq[k]), __builtin_bit_cast(bf16x8, At[m].pq[k]), acc[ai][bj][m][n], 0, 0, 0); } \
        else acc[ai][bj][m][n] = __builtin_amdgcn_mfma_scale_f32_16x16x128_f8f6f4(__builtin_bit_cast(i32x8, Bt[n].w8), __builtin_bit_cast(i32x8, At[m].w8), acc[ai][bj][m][n], 0, 0, 0, 0, 0, 0); } \
        __builtin_amdgcn_s_setprio(0); } while (0)
    Unit cur, nxt; int ui = 0;
    if (!S.next(0, cur)) return;
#ifndef GEMM_STAGGER_TICKS
#define GEMM_STAGGER_TICKS 0
#endif
    if (GEMM_STAGGER_TICKS > 0) {
        const unsigned long long t0 = __builtin_amdgcn_s_memrealtime(), wait = (unsigned long long)((blockIdx.x >> 3) & 3) * GEMM_STAGGER_TICKS;
        while (__builtin_amdgcn_s_memrealtime() - t0 < wait) __builtin_amdgcn_s_sleep(16);
    }
    AccT acc;
#pragma unroll
    for (int a = 0; a < 2; ++a)
#pragma unroll
        for (int b = 0; b < 2; ++b)
#pragma unroll
            for (int m = 0; m < 4; ++m)
#pragma unroll
                for (int n = 0; n < 2; ++n) { acc[a][b][m][n] = (f32x4){0.f, 0.f, 0.f, 0.f}; if constexpr (EB == 1) asm volatile("" : "+v"(acc[a][b][m][n])); }
    union Frag { u32x4 pq[2]; u32x8 w8; };
    Frag At[4], B0[2], B1[2];
    unsigned cA = cur.ao, cB = cur.bo;
    if constexpr (Sched::GATHER) {
        S.issue_table(cur, lds + LDS_TAB);
        G_WAIT_V(0); __syncthreads();
#pragma unroll
        for (int h = 0; h < 2; ++h)
#pragma unroll
            for (int i = 0; i < 2; ++i) { vA[h][i] = S.row_off(cur, lds + LDS_TAB, R0 + 64 * i + HALF * h) + (unsigned)C0 * 2u; }
    }
    G_STAGE(G_SB(0, 0), rsB, cB, voffB[0], voffB[1]); G_STAGE(G_SA(0, 0), rsA, cA, vA[0][0], vA[0][1]); G_STAGE(G_SB(0, 1), rsB, cB + hstepB, voffB[0], voffB[1]); G_STAGE(G_SA(0, 1), rsA, cA, vA[1][0], vA[1][1]);
    if (wr == 1) G_BAR;
    G_WAIT_V(4); G_BAR;
    G_STAGE(G_SB(1, 0), rsB, cB + kstep, voffB[0], voffB[1]); G_STAGE(G_SA(1, 0), rsA, cA + kstep, vA[0][0], vA[0][1]); G_STAGE(G_SB(1, 1), rsB, cB + hstepB + kstep, voffB[0], voffB[1]);
    G_WAIT_V(6); G_BAR;
    for (;;) {
        const bool has_next = S.next(ui + 1, nxt);
        const unsigned nA = has_next ? nxt.ao : cA, nB = has_next ? nxt.bo : cB;
        for (int t = 0; t < nt; t += 2) {
            const bool last = (t == nt - 2);
            const unsigned a1 = cA + (unsigned)(t + 1) * kstep;
            const unsigned a2 = last ? nA : cA + (unsigned)(t + 2) * kstep, b2 = last ? nB : cB + (unsigned)(t + 2) * kstep;
            const unsigned a3 = a2 + kstep, b3 = b2 + kstep;
            if constexpr (Sched::GATHER) {
                if (t == 0 && has_next) S.issue_table(nxt, lds + LDS_TAB + ((ui + 1) & 1) * 1024);
            }
            G_LDB(B0, 0, 0); G_SCHED; G_LDA(At, 0, 0); G_STAGE(G_SA(1, 1), rsA, a1, vA[1][0], vA[1][1]);
            if (last && has_next) {
                int tz = threadIdx.x; asm volatile("" : "+v"(tz)); int Rz, Cz; stage_rc(tz * 16, Rz, Cz);
#pragma unroll
                for (int h = 0; h < 2; ++h)
#pragma unroll
                    for (int i = 0; i < 2; ++i) {
                        if constexpr (Sched::GATHER) vA[h][i] = S.row_off(nxt, lds + LDS_TAB + ((ui + 1) & 1) * 1024, Rz + 64 * i + HALF * h) + (unsigned)Cz * 2u;
                        else vA[h][i] = (unsigned)((Rz + 64 * i + HALF * h) * lda * EB + Cz * 2);
                    }
            }
            G_WAIT_L(8); G_BAR; G_WAIT_L(0); G_MMA(0, 0, At, B0); G_BAR; G_SCHED;
            G_LDB(B1, 0, 1); G_STAGE(G_SB(0, 0), rsB, b2, voffB[0], voffB[1]);
            G_BAR; G_WAIT_L(0); G_MMA(0, 1, At, B1); G_BAR;
            G_LDA(At, 0, 1); G_STAGE(G_SA(0, 0), rsA, a2, vA[0][0], vA[0][1]);
            G_BAR; G_WAIT_L(0); G_MMA(1, 0, At, B0); G_BAR; G_SCHED;
            G_STAGE(G_SB(0, 1), rsB, b2 + hstepB, voffB[0], voffB[1]);
            G_WAIT_V(6); G_BAR; G_MMA(1, 1, At, B1); G_BAR;
            G_LDB(B0, 1, 0); G_SCHED; G_LDA(At, 1, 0); G_STAGE(G_SA(0, 1), rsA, a2, vA[1][0], vA[1][1]);
            G_WAIT_L(8); G_BAR; G_WAIT_L(0); G_MMA(0, 0, At, B0); G_BAR; G_SCHED;
            G_LDB(B1, 1, 1); G_STAGE(G_SB(1, 0), rsB, b3, voffB[0], voffB[1]);
            G_BAR; G_WAIT_L(0); G_MMA(0, 1, At, B1); G_BAR;
            G_LDA(At, 1, 1); G_STAGE(G_SA(1, 0), rsA, a3, vA[0][0], vA[0][1]);
            G_BAR; G_WAIT_L(0); G_MMA(1, 0, At, B0); G_BAR; G_SCHED;
            G_STAGE(G_SB(1, 1), rsB, b3 + hstepB, voffB[0], voffB[1]);
            G_WAIT_V(6); G_BAR; G_MMA(1, 1, At, B1); G_BAR;
        }
        { int tz = threadIdx.x; asm volatile("" : "+v"(tz)); const int wz = tz >> 6, lz = tz & 63; E(acc, cur, wz >> 2, wz & 3, lz & 15, lz >> 4); }
        if (!has_next) break;
#pragma unroll
        for (int a = 0; a < 2; ++a)
#pragma unroll
            for (int b = 0; b < 2; ++b)
#pragma unroll
                for (int m = 0; m < 4; ++m)
#pragma unroll
                    for (int n = 0; n < 2; ++n) { acc[a][b][m][n] = (f32x4){0.f, 0.f, 0.f, 0.f}; if constexpr (EB == 1) asm volatile("" : "+v"(acc[a][b][m][n])); }
        cur = nxt; cA = nA; cB = nB; ++ui;
    }
    G_WAIT_V(0);
    if (wr == 0) G_BAR;
    G_BAR;
}

struct EpiZ {
    static constexpr bool PERM = true, REMAP = true;
    bf16_t* Z; const float* gq; const float* gk;
    DI void operator()(const AccT& acc, const Unit& u, int wr, int wc, int fr, int fq) const {
        const int row0 = u.pm * BM + wr * 64 + fr, colw = u.pn * BM + wc * 64;
        if (colw >= IN_COLS) return;
        const bool isq = colw >= ZQ && colw < ZKK, isk = colw >= ZKK && colw < ZVV;
        float g[2][8];
        if (isq || isk) { const float* gp = (isq ? gq : gk) + 8 * fq; const float sc = isq ? 0.125f * LOG2E : 1.0f;
#pragma unroll
            for (int bj = 0; bj < 2; ++bj)
#pragma unroll
                for (int j = 0; j < 8; ++j) g[bj][j] = gp[32 * bj + j] * sc; }
#pragma unroll
        for (int ai = 0; ai < 2; ++ai)
#pragma unroll
            for (int m = 0; m < 4; ++m) { bf16_t* rowp = Z + (size_t)(row0 + ai * HALF + m * 16) * IN_COLS + colw + 8 * fq;
                float v[2][8];
#pragma unroll
                for (int bj = 0; bj < 2; ++bj)
#pragma unroll
                    for (int j = 0; j < 8; ++j) v[bj][j] = acc[ai][bj][m][j >> 2][j & 3];
                if (isq || isk) { float ss = 0.f;
#pragma unroll
                    for (int bj = 0; bj < 2; ++bj)
#pragma unroll
                        for (int j = 0; j < 8; ++j) ss += v[bj][j] * v[bj][j];
                    ss = xsum32(xsum16(ss));
                    const float rinv = __builtin_amdgcn_rsqf(ss * (1.f / 64.f) + NORM_EPS);
#pragma unroll
                    for (int bj = 0; bj < 2; ++bj)
#pragma unroll
                        for (int j = 0; j < 8; ++j) v[bj][j] *= rinv * g[bj][j]; }
#pragma unroll
                for (int bj = 0; bj < 2; ++bj) *(u32x4*)(rowp + 32 * bj) = (u32x4){cvt_pk(v[bj][0], v[bj][1]), cvt_pk(v[bj][2], v[bj][3]), cvt_pk(v[bj][4], v[bj][5]), cvt_pk(v[bj][6], v[bj][7])};
            }
    }
};
struct EpiNone {
    static constexpr bool PERM = true, REMAP = false;
    float* sink;
    DI void operator()(const AccT& acc, const Unit& u, int wr, int wc, int fr, int fq) const {
        float t = 0.f;
#pragma unroll
        for (int ai = 0; ai < 2; ++ai)
#pragma unroll
            for (int bj = 0; bj < 2; ++bj)
#pragma unroll
                for (int m = 0; m < 4; ++m)
#pragma unroll
                    for (int n = 0; n < 2; ++n) t += acc[ai][bj][m][n][0] + acc[ai][bj][m][n][1] + acc[ai][bj][m][n][2] + acc[ai][bj][m][n][3];
        if (t == 123456.789f) sink[0] = t;
    }
};
struct EpiH1 {
    static constexpr bool PERM = true, REMAP = true;
    const float* X; bf16_t* H;
    DI void operator()(const AccT& acc, const Unit& u, int wr, int wc, int fr, int fq) const {
        const int row0 = u.pm * BM + wr * 64 + fr, col0 = u.pn * BM + wc * 64 + 8 * fq;
#pragma unroll
        for (int ai = 0; ai < 2; ++ai)
#pragma unroll
            for (int m = 0; m < 4; ++m) { const size_t ro = (size_t)(row0 + ai * HALF + m * 16) * 1024 + col0;
#pragma unroll
                for (int bj = 0; bj < 2; ++bj) { const f32x4 x0 = *(const f32x4*)(X + ro + bj * 32), x1 = *(const f32x4*)(X + ro + bj * 32 + 4);
                    const f32x4 h0 = x0 + acc[ai][bj][m][0], h1 = x1 + acc[ai][bj][m][1];
                    *(u32x4*)(H + ro + bj * 32) = (u32x4){cvt_pk(h0[0], h0[1]), cvt_pk(h0[2], h0[3]), cvt_pk(h1[0], h1[1]), cvt_pk(h1[2], h1[3])}; } }
    }
};
struct EpiMoe1 {
    static constexpr bool PERM = true, REMAP = false;
    unsigned char* ACT; const float* b1;
    DI void operator()(const AccT& acc, const Unit& u, int wr, int wc, int fr, int fq) const {
        const int e = u.g & 31, cb = u.pn * 128 + wc * 32 + 8 * fq;
        const float* bg = b1 + (size_t)e * 2048 + cb; const float* bl = bg + 1024;
        const f32x4 bg0 = *(const f32x4*)bg, bg1 = *(const f32x4*)(bg + 4), bl0 = *(const f32x4*)bl, bl1 = *(const f32x4*)(bl + 4);
        constexpr float sc = 1.0f / (W8_SCALE * M8_SCALE);
#pragma unroll
        for (int ai = 0; ai < 2; ++ai) {
            unsigned pw_[4][2];
#pragma unroll
            for (int m = 0; m < 4; ++m) {
                float o[8];
#pragma unroll
                for (int n = 0; n < 2; ++n)
#pragma unroll
                    for (int pj = 0; pj < 2; ++pj) {
                        const f32x4 ag = acc[ai][0][m][n], al = acc[ai][1][m][n], bgv = n ? bg1 : bg0, blv = n ? bl1 : bl0;
                        f32x2 glu = (f32x2){ag[2 * pj], ag[2 * pj + 1]} * sc + (f32x2){bgv[2 * pj], bgv[2 * pj + 1]};
                        f32x2 lin = (f32x2){al[2 * pj], al[2 * pj + 1]} * sc + (f32x2){blv[2 * pj], blv[2 * pj + 1]};
                        glu = (f32x2){fminf(glu[0], 7.0f), fminf(glu[1], 7.0f)}; lin = (f32x2){fminf(fmaxf(lin[0], -7.0f), 7.0f), fminf(fmaxf(lin[1], -7.0f), 7.0f)};
                        const f32x2 ex = glu * (-1.702f * LOG2E);
                        const f32x2 den = (f32x2){__builtin_amdgcn_exp2f(ex[0]), __builtin_amdgcn_exp2f(ex[1])} + 1.0f;
                        const f32x2 sg = {__builtin_amdgcn_rcpf(den[0]), __builtin_amdgcn_rcpf(den[1])};
                        const f32x2 r = (glu * sg) * (lin * A8_SCALE + A8_SCALE);
                        o[n * 4 + 2 * pj] = r[0]; o[n * 4 + 2 * pj + 1] = r[1];
                    }
                pw_[m][0] = pk4_fp8(o[0], o[1], o[2], o[3]); pw_[m][1] = pk4_fp8(o[4], o[5], o[6], o[7]);
            }
#pragma unroll
            for (int mp = 0; mp < 4; mp += 2) {
                auto s0 = __builtin_amdgcn_permlane16_swap(pw_[mp][0], pw_[mp + 1][0], false, false);
                auto s1 = __builtin_amdgcn_permlane16_swap(pw_[mp][1], pw_[mp + 1][1], false, false);
                const int rl = ai * HALF + wr * 64 + (mp + (fq & 1)) * 16 + fr;
                *(u32x4*)(ACT + (size_t)(u.arow + rl) * 1024 + u.pn * 128 + wc * 32 + (fq >> 1) * 16) = (u32x4){(unsigned)s0[0], (unsigned)s1[0], (unsigned)s0[1], (unsigned)s1[1]};
            }
        }
    }
};
struct EpiMoe2 {
    static constexpr bool PERM = true, REMAP = true;
    unsigned char* Y8;
    DI void operator()(const AccT& acc, const Unit& u, int wr, int wc, int fr, int fq) const {
        const int col0 = u.pn * BM + wc * 64 + (fq & 1) * 32 + (fq >> 1) * 16;
        constexpr float sc = Y8_SCALE / (W8_SCALE * A8_SCALE);
#pragma unroll
        for (int ai = 0; ai < 2; ++ai)
#pragma unroll
            for (int m = 0; m < 4; ++m) {
                unsigned char* yp = Y8 + (size_t)(u.arow + ai * HALF + wr * 64 + m * 16 + fr) * 1024 + col0;
                unsigned w[2][2];
#pragma unroll
                for (int bj = 0; bj < 2; ++bj) { const f32x4 a0 = acc[ai][bj][m][0] * sc, a1 = acc[ai][bj][m][1] * sc; w[bj][0] = pk4_fp8(a0[0], a0[1], a0[2], a0[3]); w[bj][1] = pk4_fp8(a1[0], a1[1], a1[2], a1[3]); }
                auto s0 = __builtin_amdgcn_permlane16_swap(w[0][0], w[1][0], false, false);
                auto s1 = __builtin_amdgcn_permlane16_swap(w[0][1], w[1][1], false, false);
                *(u32x4*)yp = (u32x4){(unsigned)s0[0], (unsigned)s1[0], (unsigned)s0[1], (unsigned)s1[1]};
            }
    }
};
struct EpiPle {
    static constexpr bool PERM = true, REMAP = true;
    bf16_t* EB; float* ESS;
    DI void operator()(const AccT& acc, const Unit& u, int wr, int wc, int fr, int fq) const {
        const int row0 = u.pm * BM + wr * 64 + fr, col0 = u.pn * BM + wc * 64 + 8 * fq;
#pragma unroll
        for (int ai = 0; ai < 2; ++ai)
#pragma unroll
            for (int m = 0; m < 4; ++m) { const int row = row0 + ai * HALF + m * 16; bf16_t* rowp = EB + (size_t)row * 1024 + col0; float ss = 0.f;
#pragma unroll
                for (int bj = 0; bj < 2; ++bj) { const f32x4 v0 = acc[ai][bj][m][0], v1 = acc[ai][bj][m][1];
                    ss += v0[0] * v0[0] + v0[1] * v0[1] + v0[2] * v0[2] + v0[3] * v0[3] + v1[0] * v1[0] + v1[1] * v1[1] + v1[2] * v1[2] + v1[3] * v1[3];
                    u32x4 o = {cvt_pk(v0[0], v0[1]), cvt_pk(v0[2], v0[3]), cvt_pk(v1[0], v1[1]), cvt_pk(v1[2], v1[3])}; *(u32x4*)(rowp + bj * 32) = o; }
                ss = xsum32(xsum16(ss));
                if (fq == 0) atomicAdd(ESS + row, ss);
            }
    }
};
struct EpiFinal {
    static constexpr bool PERM = true, REMAP = true;
    float* OUT; const bf16_t* HB; const bf16_t* EB; const float* ESS; const float* g;
    DI void operator()(const AccT& acc, const Unit& u, int wr, int wc, int fr, int fq) const {
        const int row0 = u.pm * BM + wr * 64 + fr, col0 = u.pn * BM + wc * 64 + 8 * fq;
        constexpr float gsc = 1.0f / (W8_SCALE * M8_SCALE);
        f32x4 gv[2][2];
#pragma unroll
        for (int bj = 0; bj < 2; ++bj)
#pragma unroll
            for (int n = 0; n < 2; ++n) gv[bj][n] = *(const f32x4*)(g + col0 + bj * 32 + n * 4);
#pragma unroll
        for (int ai = 0; ai < 2; ++ai)
#pragma unroll
            for (int m = 0; m < 4; ++m) { const int row = row0 + ai * HALF + m * 16; const size_t ro = (size_t)row * 1024 + col0;
                const float rinv = __builtin_amdgcn_rsqf(ESS[row] * (1.f / 1024.f) + NORM_EPS);
#pragma unroll
                for (int bj = 0; bj < 2; ++bj) {
                    const size_t o = ro + bj * 32;
                    const u32x4 eb = *(const u32x4*)(EB + o), hb = *(const u32x4*)(HB + o);
#pragma unroll
                    for (int n = 0; n < 2; ++n) { const f32x4 a = acc[ai][bj][m][n], rg = gv[bj][n] * rinv; f32x4 r;
#pragma unroll
                        for (int pj = 0; pj < 2; ++pj) {
                            const unsigned ew = eb[2 * n + pj], hw = hb[2 * n + pj];
                            const f32x2 ex = (f32x2){a[2 * pj], a[2 * pj + 1]} * (-gsc * LOG2E);
                            const f32x2 den = (f32x2){__builtin_amdgcn_exp2f(ex[0]), __builtin_amdgcn_exp2f(ex[1])} + 1.0f;
                            const f32x2 sg = {__builtin_amdgcn_rcpf(den[0]), __builtin_amdgcn_rcpf(den[1])};
                            const f32x2 v = ((f32x2){bf_lo(ew), bf_hi(ew)} * (f32x2){rg[2 * pj], rg[2 * pj + 1]}) * sg + (f32x2){bf_lo(hw), bf_hi(hw)};
                            r[2 * pj] = v[0]; r[2 * pj + 1] = v[1];
                        }
                        *(f32x4*)(OUT + o + n * 4) = r; }
                }
            }
    }
};

DI void moe_tables(LAS unsigned char* lds, const unsigned* cnt_g) {
    LAS int* cntL = (LAS int*)(lds + LDS_GRP); LAS int* pre = cntL + 128;
    __syncthreads();
    if (threadIdx.x < 128) cntL[threadIdx.x] = (int)cnt_g[threadIdx.x];
    __syncthreads();
    if (threadIdx.x == 0) { int s = 0; for (int g = 0; g < 128; ++g) { pre[g] = s; s += (cntL[g] + 255) >> 8; } pre[128] = s; }
    __syncthreads();
}
template <int NT, bool GATHER_, int EB>
struct MoeOrder {
    static constexpr bool GATHER = GATHER_;
    const char* A; const char* B; size_t bexp; int g0, ng, G, c; LAS unsigned char* lds; const int* list;
    DI bool next(int i, Unit& u) const {
        LAS int* cntL = (LAS int*)(lds + LDS_GRP); LAS int* pre = cntL + 128;
        const int base = __builtin_amdgcn_readfirstlane(pre[g0]), tot = __builtin_amdgcn_readfirstlane(pre[g0 + ng]) - base;
        int rbg, pn_;
        if (G == 256) { const int x = c & 7, q = c >> 3;
            if (NT == 8) { rbg = i * 32 + (x >> 1) * 8 + (q >> 2); pn_ = (x & 1) * 4 + (q & 3); }
            else { rbg = i * 64 + x * 8 + (q >> 2); pn_ = q & 3; } }
        else { const int L = i * G + c; rbg = L / NT; pn_ = L % NT; }
        if (rbg >= tot) return false;
        const int ra = rbg + base; int lo = g0, hi = g0 + ng;
        while (hi - lo > 1) { const int mid = (lo + hi) >> 1; const int pm_ = __builtin_amdgcn_readfirstlane(pre[mid]); if (pm_ <= ra) lo = mid; else hi = mid; }
        const int g = lo, pg = __builtin_amdgcn_readfirstlane(pre[g]), rb = ra - pg, cg = __builtin_amdgcn_readfirstlane(cntL[g]);
        u.g = g; u.pm = rb; u.pn = pn_; u.cnt = (cg - rb * 256) < 256 ? (cg - rb * 256) : 256; u.arow = ra * 256;
        u.ao = GATHER ? 0u : (unsigned)u.arow * (1024u * EB); u.bo = (unsigned)((size_t)(g & 31) * bexp) + (unsigned)u.pn * (256u * 1024u * EB);
        return true;
    }
    DI void issue_table(const Unit& u, LAS unsigned char* tab) const {
        if (threadIdx.x < 256) { const int wid = __builtin_amdgcn_readfirstlane(threadIdx.x >> 6);
            __builtin_amdgcn_global_load_lds((const unsigned*)(list + (size_t)u.g * 262144 + (size_t)u.pm * 256 + threadIdx.x), (LAS unsigned*)(tab + wid * 256), 4, 0, 0); }
    }
    DI unsigned row_off(const Unit& u, LAS unsigned char* tab, int r) const { const unsigned t = *(const LAS unsigned*)(tab + r * 4); return (r < u.cnt) ? t * (1024u * EB) : 0u; }
};

DI void phase_qknorm(const Params& P) {
    bf16_t* Z = (bf16_t*)(P.ws + WS_Z);
    {
        bf16_t* XL = (bf16_t*)(P.ws + WS_XL);
        for (int it = blockIdx.x * 512 + threadIdx.x; it < (MTOK / 16) * 48; it += gridDim.x * 512) {
            const int chunk = it / 48, cg = it - chunk * 48, tok0 = chunk * 16, t0 = tok0 & (SEQ - 1), col = ZWD + cg * 8;
            const bf16_t* zp = Z + (size_t)tok0 * IN_COLS + col;
            const f32x4 mu0 = *(const f32x4*)(P.rw_mu + col), mu1 = *(const f32x4*)(P.rw_mu + col + 4);
            u32x4 vp = {0u, 0u, 0u, 0u}; if (t0 > 0) vp = *(const u32x4*)(zp - IN_COLS);
            u32x4 vc = *(const u32x4*)zp;
#pragma unroll 4
            for (int i = 0; i < 16; ++i) {
                u32x4 vn = {0u, 0u, 0u, 0u}; if (t0 + i < SEQ - 1) vn = *(const u32x4*)(zp + (size_t)(i + 1) * IN_COLS);
                float f[8];
#pragma unroll
                for (int q = 0; q < 4; ++q) {
                    const float c0 = bf_lo(vc[q]), c1 = bf_hi(vc[q]);
                    const float m0 = q < 2 ? mu0[2 * q] : mu1[2 * q - 4], m1 = q < 2 ? mu0[2 * q + 1] : mu1[2 * q - 3];
                    f[2 * q] = c0 + (0.5f * (bf_lo(vp[q]) + bf_lo(vn[q])) - c0) * m0; f[2 * q + 1] = c1 + (0.5f * (bf_hi(vp[q]) + bf_hi(vn[q])) - c1) * m1;
                }
                if (cg < 16) {
#pragma unroll
                    for (int q = 0; q < 8; ++q) { const float e = __builtin_amdgcn_exp2f(f[q] * (2.0f * LOG2E)); f[q] = 1.0f - 2.0f * __builtin_amdgcn_rcpf(e + 1.0f); }
                } else if (cg >= 32) {
#pragma unroll
                    for (int q = 0; q < 8; ++q) f[q] = sigmoidf_(f[q]);
                }
                u32x4 ov = {cvt_pk(f[0], f[1]), cvt_pk(f[2], f[3]), cvt_pk(f[4], f[5]), cvt_pk(f[6], f[7])};
                *(u32x4*)(XL + (size_t)(tok0 + i) * 384 + cg * 8) = ov;
                vp = vc; vc = vn;
            }
        }
    }
}

constexpr int LDS_RT_SEL = STAGE_BYTES;
DI float row_max16(float v) { v = fmaxf(v, dpp_mov0<0x121, 0xF>(v)); v = fmaxf(v, dpp_mov0<0x122, 0xF>(v)); v = fmaxf(v, dpp_mov0<0x124, 0xF>(v)); v = fmaxf(v, dpp_mov0<0x128, 0xF>(v)); return v; }
template <int CTRL> DI int dpp_movi(int v) { return __builtin_amdgcn_update_dpp(0, v, CTRL, 0xF, 0xF, false); }
DI int row_min16(int v) { v = min(v, dpp_movi<0x121>(v)); v = min(v, dpp_movi<0x122>(v)); v = min(v, dpp_movi<0x124>(v)); v = min(v, dpp_movi<0x128>(v)); return v; }
DI void phase_route(const Params& P, LAS unsigned char* lds) {
    LAS int* sel_e = (LAS int*)(lds + LDS_RT_SEL); LAS float* sel_g = (LAS float*)(sel_e + 1024); LAS int* lpos = (LAS int*)(sel_g + 1024);
    LAS int* lcnt = lpos + 1024; LAS int* lbase = lcnt + 128;
    const int tid = threadIdx.x, wid = tid >> 6, lane = tid & 63, n16 = lane & 15, q4 = lane >> 4;
    const bf16_t* H = (const bf16_t*)P.out; unsigned char* Mb = P.ws + WS_U;
    int* tokpos = (int*)(P.ws + WS_TOKPOS);
    unsigned* cnt_g = (unsigned*)(P.ws + WS_CTL) + CW_CNT; int* list = (int*)(P.ws + WS_LIST); float* gate = (float*)(P.ws + WS_GATE);
    __syncthreads();
    for (int it = tid; it < 64 * 64; it += 512) { const int ln = it & 63, f2 = it >> 6, ks = f2 >> 1, nt = f2 & 1, n = ln & 15, kq = ln >> 4; const int k0 = ks * 32 + kq * 8, e = nt * 16 + n;
        float hi[8], lo[8];
#pragma unroll
        for (int i = 0; i < 8; ++i) { const float v = P.norm_ffn_g[k0 + i] * P.w_router[(size_t)(k0 + i) * 32 + e]; const float h = bf2f(f2bf(v)); hi[i] = h; lo[i] = v - h; }
        *(LAS bf16x8*)(lds + (size_t)(f2 * 2) * 1024 + ln * 16) = pack8(hi[0], hi[1], hi[2], hi[3], hi[4], hi[5], hi[6], hi[7]);
        *(LAS bf16x8*)(lds + (size_t)(f2 * 2 + 1) * 1024 + ln * 16) = pack8(lo[0], lo[1], lo[2], lo[3], lo[4], lo[5], lo[6], lo[7]);
    }
    __syncthreads();
    f32x4 g[4];
#pragma unroll
    for (int i = 0; i < 4; ++i) g[i] = *(const f32x4*)(P.norm_ffn_g + 4 * lane + 256 * i);
    const float br0 = P.b_router[n16], br1 = P.b_router[16 + n16];
    for (int blk = blockIdx.x; blk < MTOK / 256; blk += gridDim.x) {
        if (tid < 128) lcnt[tid] = 0;
        {
            const bf16_t* hr0 = H + (size_t)(blk * 256 + wid * 32) * 1024 + 4 * lane;
            u32x2 hn[4];
#pragma unroll
            for (int i = 0; i < 4; ++i) hn[i] = *(const u32x2*)(hr0 + 256 * i);
            for (int rp = 0; rp < 32; ++rp) {
                const int row = blk * 256 + wid * 32 + rp; float ss = 0.f; f32x4 v[4];
#pragma unroll
                for (int i = 0; i < 4; ++i) { const u32x2 hb_ = hn[i]; v[i] = (f32x4){bf_lo(hb_[0]), bf_hi(hb_[0]), bf_lo(hb_[1]), bf_hi(hb_[1])}; ss += v[i][0] * v[i][0] + v[i][1] * v[i][1] + v[i][2] * v[i][2] + v[i][3] * v[i][3]; }
                if (rp + 1 < 32) {
#pragma unroll
                    for (int i = 0; i < 4; ++i) hn[i] = *(const u32x2*)(hr0 + (size_t)(rp + 1) * 1024 + 256 * i);
                }
                ss = wave_sum(ss);
                const float rinv = __builtin_amdgcn_rsqf(ss * (1.f / 1024.f) + NORM_EPS);
#pragma unroll
                for (int i = 0; i < 4; ++i) { const f32x4 mv = v[i] * rinv * g[i];
                    *(unsigned*)(Mb + (size_t)row * 1024 + 4 * lane + 256 * i) = pk4_fp8(mv[0] * M8_SCALE, mv[1] * M8_SCALE, mv[2] * M8_SCALE, mv[3] * M8_SCALE); }
            }
        }
#pragma unroll 1
        for (int rg = 0; rg < 2; ++rg) {
            const int rb = wid * 32 + rg * 16;
            const bf16_t* hp = H + (size_t)(blk * 256 + rb + n16) * 1024 + q4 * 8;
            const LAS bf16x8* wf = (const LAS bf16x8*)lds + lane;
            f32x4 a0h = {0.f, 0.f, 0.f, 0.f}, a0l = a0h, a1h = a0h, a1l = a0h;
            float ssq = 0.f;
#pragma unroll 8
            for (int ks = 0; ks < 32; ++ks) { const bf16x8 a = *(const bf16x8*)(hp + ks * 32);
                { const u32x4 aw = __builtin_bit_cast(u32x4, a);
#pragma unroll
                  for (int i = 0; i < 4; ++i) { const float x0 = bf_lo(aw[i]), x1 = bf_hi(aw[i]); ssq += x0 * x0 + x1 * x1; } }
                a0h = __builtin_amdgcn_mfma_f32_16x16x32_bf16(a, wf[(ks * 4 + 0) * 64], a0h, 0, 0, 0); a0l = __builtin_amdgcn_mfma_f32_16x16x32_bf16(a, wf[(ks * 4 + 1) * 64], a0l, 0, 0, 0);
                a1h = __builtin_amdgcn_mfma_f32_16x16x32_bf16(a, wf[(ks * 4 + 2) * 64], a1h, 0, 0, 0); a1l = __builtin_amdgcn_mfma_f32_16x16x32_bf16(a, wf[(ks * 4 + 3) * 64], a1l, 0, 0, 0); }
            ssq = xsum32(xsum16(ssq));
            const float rmine = __builtin_amdgcn_rsqf(ssq * (1.f / 1024.f) + NORM_EPS);
            f32x4 ri;
#pragma unroll
            for (int j = 0; j < 4; ++j) ri[j] = __shfl(rmine, q4 * 4 + j);
#pragma unroll
            for (int j = 0; j < 4; ++j) {
                float v0 = (a0h[j] + a0l[j]) * ri[j] + br0, v1 = (a1h[j] + a1l[j]) * ri[j] + br1;
                float tv[4]; int te[4];
#pragma unroll
                for (int k = 0; k < 4; ++k) {
                    const float mx = row_max16(fmaxf(v0, v1));
                    int ce = (v0 == mx) ? n16 : (v1 == mx) ? 16 + n16 : 99;
                    ce = row_min16(ce) & 31;
                    tv[k] = mx; te[k] = ce; if (ce == n16) v0 = -3.0e38f; if (ce == 16 + n16) v1 = -3.0e38f;
                }
                const float e1 = __expf(tv[1] - tv[0]), e2 = __expf(tv[2] - tv[0]), e3 = __expf(tv[3] - tv[0]); const float inv = 1.f / (1.f + e1 + e2 + e3);
                if (n16 == 0) { const int r = rb + q4 * 4 + j; sel_e[r * 4 + 0] = te[0]; sel_e[r * 4 + 1] = te[1]; sel_e[r * 4 + 2] = te[2]; sel_e[r * 4 + 3] = te[3];
                    sel_g[r * 4 + 0] = inv; sel_g[r * 4 + 1] = e1 * inv; sel_g[r * 4 + 2] = e2 * inv; sel_g[r * 4 + 3] = e3 * inv; }
            }
        }
        __syncthreads();
        if (tid < 256) {
#pragma unroll
            for (int s = 0; s < 4; ++s) lpos[tid * 4 + s] = atomicAdd((int*)&lcnt[sel_e[tid * 4 + s]], 1);
        }
        __syncthreads();
        if (tid < 128) lbase[tid] = (int)atomicAdd(cnt_g + tid, (unsigned)lcnt[tid]);
        __syncthreads();
        if (tid < 256) { const int tok = blk * 256 + tid;
#pragma unroll
            for (int s = 0; s < 4; ++s) { const int gi = sel_e[tid * 4 + s]; const int pos = lbase[gi] + lpos[tid * 4 + s]; list[(size_t)gi * 262144 + pos] = tok; gate[(size_t)tok * 4 + s] = sel_g[tid * 4 + s]; tokpos[(size_t)tok * 4 + s] = (gi << 20) | pos; }
        }
        __syncthreads();
    }
}

DI void phase_combine(const Params& P, LAS unsigned char* lds) {
    moe_tables(lds, (const unsigned*)(P.ws + WS_CTL) + CW_CNT);
    const LAS int* pre = (const LAS int*)(lds + LDS_GRP) + 128;
    const int wid = __builtin_amdgcn_readfirstlane(threadIdx.x >> 6), lane = threadIdx.x & 63;
    const bf16_t* H = (const bf16_t*)P.out; bf16_t* HB = (bf16_t*)(P.ws + WS_HB); const unsigned char* Y8 = P.ws + WS_Y8; unsigned char* H8 = P.ws + WS_W2;
    const int* tokpos = (const int*)(P.ws + WS_TOKPOS); const float* gate = (const float*)(P.ws + WS_GATE);
    for (int i = threadIdx.x; i < N_EXP * 1024 / 4; i += 512) ((LAS f32x4*)lds)[i] = ((const f32x4*)P.b2)[i];
    __syncthreads();
    const int tstep = gridDim.x * 8; int tok = blockIdx.x * 8 + wid;
    u32x4 hb0 = {0u, 0u, 0u, 0u}, hb1 = hb0; int4 tp = {0, 0, 0, 0}; f32x4 gt = {0.f, 0.f, 0.f, 0.f};
    if (tok < MTOK) { hb0 = *(const u32x4*)(H + (size_t)tok * 1024 + 16 * lane); hb1 = *(const u32x4*)(H + (size_t)tok * 1024 + 16 * lane + 8); tp = *(const int4*)(tokpos + (size_t)tok * 4); gt = *(const f32x4*)(gate + (size_t)tok * 4); }
    for (; tok < MTOK; tok += tstep) {
        float h[16];
#pragma unroll
        for (int q = 0; q < 4; ++q) { h[2 * q] = bf_lo(hb0[q]); h[2 * q + 1] = bf_hi(hb0[q]); h[8 + 2 * q] = bf_lo(hb1[q]); h[8 + 2 * q + 1] = bf_hi(hb1[q]); }
        const int tpv[4] = {tp.x, tp.y, tp.z, tp.w}; const f32x4 gc = gt;
        u32x4 yv[4];
#pragma unroll
        for (int s = 0; s < 4; ++s) { const int g = tpv[s] >> 20, pos = tpv[s] & 0xfffff; const size_t prow = (size_t)pre[g] * 256 + pos; yv[s] = *(const u32x4*)(Y8 + prow * 1024 + 16 * lane); }
        const int tn = tok + tstep;
        if (tn < MTOK) { hb0 = *(const u32x4*)(H + (size_t)tn * 1024 + 16 * lane); hb1 = *(const u32x4*)(H + (size_t)tn * 1024 + 16 * lane + 8); tp = *(const int4*)(tokpos + (size_t)tn * 4); gt = *(const f32x4*)(gate + (size_t)tn * 4); }
#pragma unroll
        for (int s = 0; s < 4; ++s) {
            const int e = (tpv[s] >> 20) & 31; const float gs = gc[s], ys = gs * (1.0f / Y8_SCALE);
            const LAS f32x4* bl = (const LAS f32x4*)(lds + (size_t)e * 4096 + lane * 64);
#pragma unroll
            for (int q = 0; q < 4; ++q) { const f32x4 bv = bl[q]; const f32x2 lo = __builtin_amdgcn_cvt_pk_f32_fp8((int)yv[s][q], false), hi = __builtin_amdgcn_cvt_pk_f32_fp8((int)yv[s][q], true);
                h[4 * q + 0] += ys * lo[0] + gs * bv[0]; h[4 * q + 1] += ys * lo[1] + gs * bv[1]; h[4 * q + 2] += ys * hi[0] + gs * bv[2]; h[4 * q + 3] += ys * hi[1] + gs * bv[3]; }
        }
        *(u32x4*)(HB + (size_t)tok * 1024 + 16 * lane) = (u32x4){cvt_pk(h[0], h[1]), cvt_pk(h[2], h[3]), cvt_pk(h[4], h[5]), cvt_pk(h[6], h[7])};
        *(u32x4*)(HB + (size_t)tok * 1024 + 16 * lane + 8) = (u32x4){cvt_pk(h[8], h[9]), cvt_pk(h[10], h[11]), cvt_pk(h[12], h[13]), cvt_pk(h[14], h[15])};
        *(u32x4*)(H8 + (size_t)tok * 1024 + 16 * lane) = (u32x4){pk4_fp8(h[0] * M8_SCALE, h[1] * M8_SCALE, h[2] * M8_SCALE, h[3] * M8_SCALE), pk4_fp8(h[4] * M8_SCALE, h[5] * M8_SCALE, h[6] * M8_SCALE, h[7] * M8_SCALE),
                                                                pk4_fp8(h[8] * M8_SCALE, h[9] * M8_SCALE, h[10] * M8_SCALE, h[11] * M8_SCALE), pk4_fp8(h[12] * M8_SCALE, h[13] * M8_SCALE, h[14] * M8_SCALE, h[15] * M8_SCALE)};
    }
    __syncthreads();
}

constexpr int AT_V = 0, AT_WS = 98304;
#define KSWZ(row, colB) ((row) * 256 + ((colB) ^ (((row) & 7) << 4)))
DI int crow(int r, int hi) { return (r & 3) + 8 * (r >> 2) + 4 * hi; }
DI int v_st(int k, int c) { const int kk = (k & ~0xC) | ((k & 4) << 1) | ((k & 8) >> 1); return ((kk >> 3) * 4 + (c >> 5)) * 512 + ((kk & 7) * 32 + (c & 31)) * 2; }
DI int v_rd_base(int lane) { return ((lane & 3) << 3) | (((lane >> 2) & 3) << 6) | (((lane >> 4) & 1) << 5) | (((lane >> 5) & 1) << 8); }
constexpr int v_rd_off(int d0, int ks, int half) { return d0 * 512 + ks * 4096 + half * 2048; }
template <int OFF> DI s16x4 tr_read(int vb) { s16x4 r; asm volatile("ds_read_b64_tr_b16 %0, %1 offset:%2" : "=&v"(r) : "v"(vb), "i"(OFF) : "memory"); return r; }
#define AT_PK(L, H) (bf16x8){L[0], L[1], L[2], L[3], H[0], H[1], H[2], H[3]}
template <int D0> DI void pv_one(f32x16& od, int vb, bf16x8 pa0, bf16x8 pa1, bf16x8 pa2, bf16x8 pa3) {
    const s16x4 l0 = tr_read<v_rd_off(D0, 0, 0)>(vb), h0 = tr_read<v_rd_off(D0, 0, 1)>(vb), l1 = tr_read<v_rd_off(D0, 1, 0)>(vb), h1 = tr_read<v_rd_off(D0, 1, 1)>(vb);
    const s16x4 l2 = tr_read<v_rd_off(D0, 2, 0)>(vb), h2 = tr_read<v_rd_off(D0, 2, 1)>(vb), l3 = tr_read<v_rd_off(D0, 3, 0)>(vb), h3 = tr_read<v_rd_off(D0, 3, 1)>(vb);
    asm volatile("s_waitcnt lgkmcnt(0)" ::: "memory"); __builtin_amdgcn_sched_barrier(0);
    od = __builtin_amdgcn_mfma_f32_32x32x16_bf16(pa0, AT_PK(l0, h0), od, 0, 0, 0);
    od = __builtin_amdgcn_mfma_f32_32x32x16_bf16(pa1, AT_PK(l1, h1), od, 0, 0, 0);
    od = __builtin_amdgcn_mfma_f32_32x32x16_bf16(pa2, AT_PK(l2, h2), od, 0, 0, 0);
    od = __builtin_amdgcn_mfma_f32_32x32x16_bf16(pa3, AT_PK(l3, h3), od, 0, 0, 0);
}
DI void at_softmax(f32x16& p0, f32x16& p1, float& l_reg, bf16x8& pa0, bf16x8& pa1, bf16x8& pa2, bf16x8& pa3) {
#pragma unroll
    for (int r = 0; r < 16; ++r) { p0[r] = __builtin_amdgcn_exp2f(p0[r]); p1[r] = __builtin_amdgcn_exp2f(p1[r]); }
    float ps = 0.f;
#pragma unroll
    for (int r = 0; r < 16; ++r) ps += p0[r] + p1[r];
    l_reg += ps;
#define AT_PK4(Pv, BASE, OUT) do { unsigned a0 = cvt_pk(Pv[BASE + 0], Pv[BASE + 1]), a1 = cvt_pk(Pv[BASE + 2], Pv[BASE + 3]); \
    unsigned b0 = cvt_pk(Pv[BASE + 4], Pv[BASE + 5]), b1 = cvt_pk(Pv[BASE + 6], Pv[BASE + 7]); \
    auto r0 = __builtin_amdgcn_permlane32_swap(a0, b0, false, false); auto r1 = __builtin_amdgcn_permlane32_swap(a1, b1, false, false); \
    u32x4 w = {r0[0], r1[0], r0[1], r1[1]}; OUT = __builtin_bit_cast(bf16x8, w); } while (0)
    AT_PK4(p0, 0, pa0); AT_PK4(p0, 8, pa1); AT_PK4(p1, 0, pa2); AT_PK4(p1, 8, pa3);
#undef AT_PK4
}

DI void at_bias(f32x16& p0, f32x16& p1, float x, float slope2, float smax2, int side  ) {
    if (side != 0) {
        const float ss = (float)side * slope2, base = fmaf(-ss, x, -smax2);
#pragma unroll
        for (int r = 0; r < 16; ++r) { const float c0 = (float)((r & 3) + 8 * (r >> 2)); p0[r] = fmaf(ss, c0, base); p1[r] = fmaf(ss, c0 + 32.f, base); }
    } else {
#pragma unroll
        for (int r = 0; r < 16; ++r) { const float c0 = (float)((r & 3) + 8 * (r >> 2)); p0[r] = fmaf(fabsf(x - c0), -slope2, -smax2); p1[r] = fmaf(fabsf(x - (c0 + 32.f)), -slope2, -smax2); }
    }
}
DI void attn_unit(const Params& P, unsigned char* lds, int b, int h, int qb, float lam, float smax2, int W) {
    int tid_ = threadIdx.x; asm volatile("" : "+v"(tid_));
    const int tid = tid_, wid = __builtin_amdgcn_readfirstlane(tid >> 6), lane = tid & 63, r32 = lane & 31, hi = lane >> 5, grp = wid >> 1, c = wid & 1;
    const bf16_t* Zb = (const bf16_t*)(P.ws + WS_Z) + (size_t)b * SEQ * IN_COLS;
    LAS unsigned char* L3 = (LAS unsigned char*)lds;
    const int i0 = qb * 128, qbase = i0 + grp * 32, qi = qbase + r32;
    const float slope2 = exp2f(-2.0f * (float)(h + 1)) * LOG2E;
    bf16x8 qr[4];
    { const bf16_t* qp = Zb + (size_t)qi * IN_COLS + ZQ + h * 128 + c * 64 + hi * 8;
#pragma unroll
      for (int d0 = 0; d0 < 4; ++d0) qr[d0] = *(const bf16x8*)(qp + d0 * 16); }
    const __amdgpu_buffer_rsrc_t rsZ = __builtin_amdgcn_make_buffer_rsrc((void*)Zb, 0, 0x7ffffff0, 0x00020000);
    unsigned voK[2], voV[2];
#pragma unroll
    for (int i = 0; i < 2; ++i) {
        const int u = tid + 512 * i;
        const int krow = u >> 4, kch = (u & 15) ^ (krow & 7);
        voK[i] = (unsigned)((krow * IN_COLS + ZKK + h * 128 + kch * 8) * 2);
        const int sub = u >> 5, kkl = (u >> 2) & 7, cq = u & 3, kk = (sub >> 2) * 8 + kkl, vkey = (kk & ~0xC) | ((kk & 4) << 1) | ((kk & 8) >> 1), vc = (sub & 3) * 32 + cq * 8;
        voV[i] = (unsigned)((vkey * IN_COLS + ZVV + h * 128 + vc) * 2);
    }
    const int vb0 = (int)(uintptr_t)(lds + AT_V) + v_rd_base(lane);
    f32x16 o[4];
#pragma unroll
    for (int d = 0; d < 4; ++d)
#pragma unroll
        for (int r = 0; r < 16; ++r) o[d][r] = 0.f;
    float l = 0.f;
#define AT_TI(t) ((t) < n1 ? a1 + (t) : a2 + ((t) - n1))
#define AT_DMA(t, bf) do { const int so_ = AT_TI(t) * 64 * IN_COLS * 2; LAS unsigned char* d_ = L3 + (bf) * 32768 + wid * 1024; \
    __builtin_amdgcn_raw_ptr_buffer_load_lds(rsZ, (LAS void*)(d_), 16, (int)voK[0], so_, 0, 0); __builtin_amdgcn_raw_ptr_buffer_load_lds(rsZ, (LAS void*)(d_ + 8192), 16, (int)voK[1], so_, 0, 0); \
    __builtin_amdgcn_raw_ptr_buffer_load_lds(rsZ, (LAS void*)(d_ + 16384), 16, (int)voV[0], so_, 0, 0); __builtin_amdgcn_raw_ptr_buffer_load_lds(rsZ, (LAS void*)(d_ + 24576), 16, (int)voV[1], so_, 0, 0); } while (0)
#define AT_QK(p0, p1, bf, t) do { const int j0_ = AT_TI(t) * 64; const int side_ = (j0_ + 63 < qbase) ? 1 : (j0_ > qbase + 31 ? -1 : 0); \
    at_bias(p0, p1, (float)(qi - j0_ - 4 * hi), slope2, smax2, side_); const LAS unsigned char* Ks_ = L3 + (bf) * 32768; \
    _Pragma("unroll") for (int d0 = 0; d0 < 4; ++d0) { const int cb = (c * 64 + d0 * 16 + hi * 8) * 2; \
        const bf16x8 k0 = *(const LAS bf16x8*)(Ks_ + KSWZ(r32, cb)), k1 = *(const LAS bf16x8*)(Ks_ + KSWZ(32 + r32, cb)); \
        p0 = __builtin_amdgcn_mfma_f32_32x32x16_bf16(k0, qr[d0], p0, 0, 0, 0); p1 = __builtin_amdgcn_mfma_f32_32x32x16_bf16(k1, qr[d0], p1, 0, 0, 0); } } while (0)
#define AT_PV(bf) do { const int vb = vb0 + (bf) * 32768 + 16384; pv_one<0>(o[0], vb, pa0, pa1, pa2, pa3); pv_one<1>(o[1], vb, pa0, pa1, pa2, pa3); pv_one<2>(o[2], vb, pa0, pa1, pa2, pa3); pv_one<3>(o[3], vb, pa0, pa1, pa2, pa3); } while (0)
#define AT_SB() do {} while (0)
#define AT_SYNC() do { asm volatile("s_waitcnt vmcnt(0) lgkmcnt(0)" ::: "memory"); __builtin_amdgcn_s_barrier(); asm volatile("" ::: "memory"); } while (0)
    f32x16 pA0, pA1, pB0, pB1; bf16x8 pa0, pa1, pa2, pa3;
    int a1 = 2 * qb, n1 = 2, a2 = 0, NT = 2;
#define AT_RUN() do { \
        AT_DMA(0, 0); AT_DMA(1, 1); \
        asm volatile("s_waitcnt vmcnt(4)" ::: "memory"); __builtin_amdgcn_s_barrier(); asm volatile("" ::: "memory"); \
        AT_QK(pA0, pA1, 0, 0); \
        int b0 = 0, b1 = 1, b2 = 2;                          \
        for (int t = 0; t + 1 < NT; t += 2) { \
            AT_SYNC(); if (t + 2 < NT) AT_DMA(t + 2, b2); \
            __builtin_amdgcn_s_setprio(1); AT_QK(pB0, pB1, b1, t + 1); \
            at_softmax(pA0, pA1, l, pa0, pa1, pa2, pa3); __builtin_amdgcn_s_setprio(0); \
            AT_PV(b0); \
            AT_SYNC(); if (t + 3 < NT) AT_DMA(t + 3, b0); \
            __builtin_amdgcn_s_setprio(1); if (t + 2 < NT) AT_QK(pA0, pA1, b2, t + 2); \
            at_softmax(pB0, pB1, l, pa0, pa1, pa2, pa3); __builtin_amdgcn_s_setprio(0); \
            AT_PV(b1); \
            { const int nb0 = b2, nb1 = b0, nb2 = b1; b0 = nb0; b1 = nb1; b2 = nb2; } \
        } } while (0)
    __syncthreads();
    AT_RUN();
    {
        const float lc = xsum32(l), lmn = -wave_max(-lc);
        LAS float* sml = (LAS float*)(lds + AT_WS + 1024);
        if (lane == 0) sml[wid] = lmn;
        __syncthreads();
        const f32x4 m0 = *(const LAS f32x4*)sml, m1 = *(const LAS f32x4*)(sml + 4);
        float tmin = fminf(fminf(fminf(m0[0], m0[1]), fminf(m0[2], m0[3])), fminf(fminf(m1[0], m1[1]), fminf(m1[2], m1[3])));
        tmin = __builtin_bit_cast(float, __builtin_amdgcn_readfirstlane(__builtin_bit_cast(int, fmaxf(tmin, 1e-36f))));
        const float lcnt2 = fminf(13.0f, 1.0f - __builtin_amdgcn_logf(1.0f - __builtin_amdgcn_exp2f(-slope2)));
        const int Wt = (int)ceilf((lcnt2 + 24.02f - __builtin_amdgcn_logf(tmin)) / slope2);
        if (Wt < W) W = Wt;
        if (W < 0) W = 0;
        int jlo = i0 - W; if (jlo < 0) jlo = 0; jlo >>= 6;
        int jhi = i0 + 127 + W; if (jhi > SEQ - 1) jhi = SEQ - 1; jhi >>= 6;
        if (((jhi - jlo) & 1) == 0) { if (jhi < SEQ / 64 - 1) ++jhi; else --jlo; }
        a1 = jlo; n1 = 2 * qb - jlo; a2 = 2 * qb + 2; NT = n1 + (jhi - 2 * qb - 1);
    }
    if (NT > 0) AT_RUN();
#undef AT_RUN
    __syncthreads();
#undef AT_DMA
#undef AT_TI
#undef AT_QK
#undef AT_PV
#undef AT_SB
#undef AT_SYNC
    l = xsum32(l);
    float* wsf = (float*)(lds + AT_WS) + wid * 32;
    float* exch = (float*)lds + grp * 4096;
    if (hi == 0) wsf[r32] = l;
    asm volatile("s_waitcnt lgkmcnt(0)" ::: "memory");
    float rl[16];
#pragma unroll
    for (int r = 0; r < 16; ++r) rl[r] = __builtin_amdgcn_rcpf(wsf[crow(r, hi)]) * (c ? lam : 1.0f);
    if (c == 1) {
#pragma unroll
        for (int d = 0; d < 4; ++d)
#pragma unroll
            for (int r = 0; r < 16; ++r) exch[(d * 16 + r) * 64 + lane] = o[d][r] * rl[r];
    }
    __syncthreads();
    if (c == 0) {
        float ss[16];
#pragma unroll
        for (int r = 0; r < 16; ++r) { float sacc = 0.f;
#pragma unroll
            for (int d = 0; d < 4; ++d) { const float v = o[d][r] * rl[r] - exch[(d * 16 + r) * 64 + lane]; o[d][r] = v; sacc += v * v; }
            ss[r] = sacc; }
#pragma unroll
        for (int r = 0; r < 16; ++r) {
            ss[r] = xsum16(row_sum16(ss[r]));
        }
        bf16_t* Ob = (bf16_t*)(P.ws + WS_O) + (size_t)(b * SEQ + i0 + grp * 32) * 1024 + C_RW + h * 128;
        float sg[4];
#pragma unroll
        for (int d = 0; d < 4; ++d) sg[d] = P.da_subln_g[d * 32 + r32] * 0.8f;
#pragma unroll
        for (int r = 0; r < 16; ++r) { const float rn = __builtin_amdgcn_rsqf(ss[r] * (1.f / 128.f) + NORM_EPS); bf16_t* op = Ob + (size_t)crow(r, hi) * 1024 + r32;
#pragma unroll
            for (int d = 0; d < 4; ++d) op[d * 32] = f2bf(o[d][r] * rn * sg[d]); }
    }
}

constexpr int SL_SZ = 19712, SL_AT = 0, SL_RT = 2304, SL_BT = 4608, SL_KT = 6912, SL_BH = 9216, SL_KH = 11776, SL_VT = 14336, SL_PC = 16896,
              SL_AAK = 17152, SL_TT = 17792, SL_ARB = 18432, SL_ARK = 19072;
constexpr int RW_SLOT = 0, RW_EX = 78848, RW_FG = 79872, RW_MU = 96256, RW_WFW = 98560, RW_WFA = 106752, RW_WFG = 123136, RW_AAB = 139520;
DI bf16x8 lo_hi(u32x2 lo, u32x2 hi) { u32x4 w = {lo[0], lo[1], hi[0], hi[1]}; return __builtin_bit_cast(bf16x8, w); }
DI float tanh_fast(float x) { const float t = __builtin_amdgcn_exp2f(x * (2.0f * LOG2E)); return 1.0f - 2.0f * __builtin_amdgcn_rcpf(t + 1.0f); }
template <int CTRL> DI unsigned dpp_keep(unsigned old, unsigned v) { return (unsigned)__builtin_amdgcn_update_dpp((int)old, (int)v, CTRL, 0xF, 0xF, false); }
DI void shift8(const u32x4 cur, const u32x4 bnd, const float* mu, float (&f)[8]) {
    const f32x4 m0 = *(const f32x4*)mu, m1 = *(const f32x4*)(mu + 4);
#pragma unroll
    for (int q = 0; q < 4; ++q) {
        const unsigned na = dpp_keep<0x111>(bnd[q], cur[q]), nb = dpp_keep<0x101>(bnd[q], cur[q]);
        const float c0 = bf_lo(cur[q]), c1 = bf_hi(cur[q]);
        const float mm0 = q < 2 ? m0[2 * q] : m1[2 * q - 4], mm1 = q < 2 ? m0[2 * q + 1] : m1[2 * q - 3];
        f[2 * q] = c0 + (0.5f * (bf_lo(na) + bf_lo(nb)) - c0) * mm0; f[2 * q + 1] = c1 + (0.5f * (bf_hi(na) + bf_hi(nb)) - c1) * mm1;
    }
}

#define RW_BAR() do { asm volatile("s_waitcnt lgkmcnt(0)" ::: "memory"); __builtin_amdgcn_s_barrier(); asm volatile("" ::: "memory"); } while (0)
DI void rwkv_task(const Params& P, unsigned char* lds, int b, int h, int wd) {
    int tid_ = threadIdx.x; asm volatile("" : "+v"(tid_));
    const int tid = tid_, wid = __builtin_amdgcn_readfirstlane(tid >> 6), lane = tid & 63, n16 = lane & 15, q4 = lane >> 4, cp = wid >> 1, hf = (wid ^ (wid >> 2)) & 1, vt = wid & 3;
    const bf16_t* Zb = (const bf16_t*)(P.ws + WS_Z) + (size_t)b * SEQ * IN_COLS;
    float* Ysc = (float*)(P.ws + WS_U) + (size_t)b * SEQ * 512 + h * 64;
    bf16_t* Ob = (bf16_t*)(P.ws + WS_O) + (size_t)b * SEQ * 1024 + h * 64;
    const bf16_t* XLb = (const bf16_t*)(P.ws + WS_XL) + (size_t)b * SEQ * 384;
    unsigned* flags = (unsigned*)(P.ws + WS_CTL) + CW_RWFLAG;
    const int hc = h * 64, task = (b * 8 + h) * 2 + wd;
    __syncthreads();
    float* MU = (float*)(lds + RW_MU);
    for (int i = tid; i < 192; i += 512) { const int col = (i < 64 ? ZR : i < 128 ? ZK - 64 : ZV - 128) + hc + i; MU[i] = P.rw_mu[col]; }
    float* CST = (float*)(lds + RW_AAB + 4096);
    for (int i = tid; i < 512; i += 512) { const int a = i >> 6, ch = i & 63; const float* src = a == 0 ? P.rw_w0 + wd * 512 : a == 1 ? P.rw_a0 + wd * 512 : a == 2 ? P.rw_a0 + (1 - wd) * 512 : a == 3 ? P.rw_k_k : a == 4 ? P.rw_k_a : a == 5 ? P.rw_r_k : a == 6 ? P.rw_ln_g : P.rw_ln_b; CST[i] = src[hc + ch] * (a < 3 ? -LOG2E : 1.f); }
    bf16x8* wfw = (bf16x8*)(lds + RW_WFW) + (size_t)(hf * 4) * 64 + lane;
    bf16x8* wfa = (bf16x8*)(lds + RW_WFA) + (size_t)(hf * 4) * 64 + lane;
    bf16x8* wfo = (bf16x8*)(lds + RW_WFA) + (size_t)(8 + hf * 4) * 64 + lane;
    bf16x8* wfg = (bf16x8*)(lds + RW_WFG) + (size_t)(hf * 8) * 64 + lane;
#pragma unroll
    for (int u = 0; u < 2; ++u) {
        const int col = hc + hf * 32 + 2 * n16 + u;
        if (cp == 0) {
#pragma unroll
            for (int s = 0; s < 2; ++s) {
                float x[8], y[8], z[8];
#pragma unroll
                for (int j = 0; j < 8; ++j) { const int r = s * 32 + q4 * 8 + j; x[j] = -LOG2E * P.rw_w2[(size_t)(wd * 64 + r) * 512 + col]; y[j] = -LOG2E * P.rw_a2[(size_t)(wd * 64 + r) * 512 + col]; z[j] = -LOG2E * P.rw_a2[(size_t)((1 - wd) * 64 + r) * 512 + col]; }
                wfw[(u * 2 + s) * 64] = pack8(x[0], x[1], x[2], x[3], x[4], x[5], x[6], x[7]); wfa[(u * 2 + s) * 64] = pack8(y[0], y[1], y[2], y[3], y[4], y[5], y[6], y[7]);
                wfo[(u * 2 + s) * 64] = pack8(z[0], z[1], z[2], z[3], z[4], z[5], z[6], z[7]);
            }
#pragma unroll
            for (int s = 0; s < 4; ++s) { float x[8];
#pragma unroll
                for (int j = 0; j < 8; ++j) x[j] = P.rw_g2[(size_t)(s * 32 + q4 * 8 + j) * 512 + col];
                wfg[(u * 4 + s) * 64] = pack8(x[0], x[1], x[2], x[3], x[4], x[5], x[6], x[7]); }
        }
    }
    u32x4* selp = (u32x4*)(lds + RW_AAB + 6144) + lane;
    if (wid == 0) {
#pragma unroll
        for (int u = 0; u < 2; ++u) { const unsigned one = (q4 == (n16 >> 2)) ? (u ? 0x3F800000u : 0x00003F80u) : 0u; const int w = n16 & 3;
            selp[u * 64] = (u32x4){w == 0 ? one : 0u, w == 1 ? one : 0u, w == 2 ? one : 0u, w == 3 ? one : 0u}; }
    }
    f32x4 ST[4];
#pragma unroll
    for (int t = 0; t < 4; ++t) ST[t] = (f32x4){0.f, 0.f, 0.f, 0.f};
    unsigned char* slot = lds + RW_SLOT + cp * SL_SZ;
    float* ex = (float*)(lds + RW_EX);
    bf16_t* fgb = (bf16_t*)(lds + RW_FG) + cp * 2048;
    const int sgn = wd ? -1 : 1;
    bf16x8 xw0, xw1, xa0, xa1; u32x4 zc[3], zb[3]; bool bok = false;
    bf16x8 xo0 = {0, 0, 0, 0, 0, 0, 0, 0}, xo1 = xo0, xg0 = xo0, xg1 = xo0, xg2 = xo0, xg3 = xo0;
#define RW_OPQ() int lo_ = lane; asm volatile("" : "+v"(lo_)); const int n16 = lo_ & 15, q4 = lo_ >> 4
#define RW_LOADS(S_) do { RW_OPQ(); const int sc_ = wd ? (SEQ / 64 - 1 - (S_)) : (S_); const int T0_ = wd ? (sc_ * 64 + 63 - 16 * cp) : (sc_ * 64 + 16 * cp); \
        const int tb_ = (n16 == 0) ? (T0_ - sgn) : (T0_ + 16 * sgn); bok = (n16 == 0 || n16 == 15) && tb_ >= 0 && tb_ < SEQ; \
          \
        const unsigned zro_ = (unsigned)((T0_ + sgn * n16) * IN_COLS + q4 * 8 + hc + hf * 32) * 2u, zbo_ = (unsigned)((bok ? tb_ : 0) * IN_COLS + q4 * 8 + hc + hf * 32) * 2u; \
        const unsigned xlo_ = (unsigned)((T0_ + sgn * n16) * 384 + q4 * 8) * 2u; const char* xl_ = (const char*)XLb + xlo_; \
        xw0 = *(const bf16x8*)(xl_ + (wd * 64) * 2); xw1 = *(const bf16x8*)(xl_ + (wd * 64 + 32) * 2); xa0 = *(const bf16x8*)(xl_ + (128 + wd * 64) * 2); xa1 = *(const bf16x8*)(xl_ + (128 + wd * 64 + 32) * 2); \
        _Pragma("unroll") for (int arr = 0; arr < 3; ++arr) { const int col = (arr == 0 ? ZR : arr == 1 ? ZK : ZV); zc[arr] = *(const u32x4*)((const char*)Zb + zro_ + col * 2); zb[arr] = *(const u32x4*)((const char*)Zb + zbo_ + col * 2); } \
        if ((S_) >= SEQ / 128) { xo0 = *(const bf16x8*)(xl_ + (128 + (1 - wd) * 64) * 2); xo1 = *(const bf16x8*)(xl_ + (128 + (1 - wd) * 64 + 32) * 2); \
            xg0 = *(const bf16x8*)(xl_ + 256 * 2); xg1 = *(const bf16x8*)(xl_ + 288 * 2); xg2 = *(const bf16x8*)(xl_ + 320 * 2); xg3 = *(const bf16x8*)(xl_ + 352 * 2); } } while (0)
#define RW_LANDED() asm volatile("" :: "v"(xw0), "v"(xw1), "v"(xa0), "v"(xa1), "v"(zc[0]), "v"(zc[1]), "v"(zc[2]), "v"(zb[0]), "v"(zb[1]), "v"(zb[2]), "v"(xo0), "v"(xo1), "v"(xg0), "v"(xg1), "v"(xg2), "v"(xg3))
    RW_LOADS(0);
    RW_LANDED();
    for (int s = 0; s < SEQ / 64; ++s) {
        const bool fin = s >= SEQ / 128;
        const int sc = wd ? (SEQ / 64 - 1 - s) : s;
        const int T0 = wd ? (sc * 64 + 63 - 16 * cp) : (sc * 64 + 16 * cp);
        if (s == SEQ / 128) {
            if (tid < 64) {
                unsigned spins = 0;
                while (__builtin_amdgcn_readfirstlane(__hip_atomic_load(flags + (task ^ 1) * 16, __ATOMIC_RELAXED, __HIP_MEMORY_SCOPE_AGENT)) == 0u) { __builtin_amdgcn_s_sleep(8); if (++spins > (1u << 24)) break; }
                __builtin_amdgcn_fence(__ATOMIC_ACQUIRE, "agent");
                asm volatile("s_waitcnt vmcnt(0)" ::: "memory");
            }
        }
        RW_BAR();
        const u32x4 z4 = {0u, 0u, 0u, 0u};
        f32x4 lw[2], la[2], lo[2], lg[2];
#pragma unroll
        for (int u = 0; u < 2; ++u) { lw[u] = (f32x4){0.f, 0.f, 0.f, 0.f}; la[u] = lw[u]; lo[u] = lw[u]; lg[u] = lw[u]; }
#define RW_MM(acc, af, wf, nks, ks) acc[0] = __builtin_amdgcn_mfma_f32_16x16x32_bf16(af, wf[(ks) * 64], acc[0], 0, 0, 0); acc[1] = __builtin_amdgcn_mfma_f32_16x16x32_bf16(af, wf[((nks) + (ks)) * 64], acc[1], 0, 0, 0);
        RW_MM(lw, xw0, wfw, 2, 0) RW_MM(lw, xw1, wfw, 2, 1) RW_MM(la, xa0, wfa, 2, 0) RW_MM(la, xa1, wfa, 2, 1)
        if (fin) { RW_MM(lo, xo0, wfo, 2, 0) RW_MM(lo, xo1, wfo, 2, 1) RW_MM(lg, xg0, wfg, 4, 0) RW_MM(lg, xg1, wfg, 4, 1) RW_MM(lg, xg2, wfg, 4, 2) RW_MM(lg, xg3, wfg, 4, 3) }
#undef RW_MM
        float rr[2][4], kr[2][4], vv[2][4];
        {
            const bf16x8 sel0 = __builtin_bit_cast(bf16x8, selp[0]), sel1 = __builtin_bit_cast(bf16x8, selp[64]);
            const f32x4 zero4 = {0.f, 0.f, 0.f, 0.f};
            const bool edge = (T0 - sgn < 0) || (T0 - sgn >= SEQ) || (T0 + 16 * sgn < 0) || (T0 + 16 * sgn >= SEQ);
            if (edge) {
#pragma unroll
                for (int arr = 0; arr < 3; ++arr) zb[arr] = bok ? zb[arr] : z4;
            }
#pragma unroll
            for (int arr = 0; arr < 3; ++arr) {
                const u32x4 cur = zc[arr], bnd = zb[arr]; u32x4 na, nb;
#pragma unroll
                for (int q = 0; q < 4; ++q) { na[q] = dpp_keep<0x111>(bnd[q], cur[q]); nb[q] = dpp_keep<0x101>(bnd[q], cur[q]); }
                const f32x2 mu2 = *(const f32x2*)(MU + arr * 64 + hf * 32 + 2 * n16);
#pragma unroll
                for (int u = 0; u < 2; ++u) {
                    const bf16x8 sl = u ? sel1 : sel0;
                    const f32x4 d1 = __builtin_amdgcn_mfma_f32_16x16x32_bf16(__builtin_bit_cast(bf16x8, cur), sl, zero4, 0, 0, 0);
                    f32x4 d2 = __builtin_amdgcn_mfma_f32_16x16x32_bf16(__builtin_bit_cast(bf16x8, na), sl, zero4, 0, 0, 0);
                    d2 = __builtin_amdgcn_mfma_f32_16x16x32_bf16(__builtin_bit_cast(bf16x8, nb), sl, d2, 0, 0, 0);
                    const f32x4 val = d1 + (0.5f * d2 - d1) * mu2[u];
#pragma unroll
                    for (int j = 0; j < 4; ++j) { if (arr == 0) rr[u][j] = val[j]; else if (arr == 1) kr[u][j] = val[j]; else vv[u][j] = val[j]; }
                }
            }
        }
        float lgw[2][4], aa[2][4], kkr[2][4], gg[2][4], n2p[4], bnp[4];
#pragma unroll
        for (int j = 0; j < 4; ++j) { n2p[j] = 0.f; bnp[j] = 0.f; }
        {
            const int ch2 = hf * 32 + 2 * n16;
            const f32x2 w0c2 = *(const f32x2*)(CST + ch2), a0c2 = *(const f32x2*)(CST + 64 + ch2), a0oc2 = *(const f32x2*)(CST + 128 + ch2), kkc2 = *(const f32x2*)(CST + 192 + ch2), kac2 = *(const f32x2*)(CST + 256 + ch2), rkc2 = *(const f32x2*)(CST + 320 + ch2);
#define RW_SG2(x_) __builtin_amdgcn_rcpf(1.f + __builtin_amdgcn_exp2f(x_))
            if (!fin) {
#pragma unroll
                for (int u = 0; u < 2; ++u)
#pragma unroll
                    for (int j = 0; j < 4; ++j) {
                        lgw[u][j] = (-0.6065306597f * LOG2E) * RW_SG2(w0c2[u] + lw[u][j]);
                        aa[u][j] = RW_SG2(a0c2[u] + la[u][j]);
                        const float kk = kr[u][j] * kkc2[u]; kkr[u][j] = kk; n2p[j] += kk * kk; gg[u][j] = 0.f;
                    }
            } else {
#pragma unroll
                for (int u = 0; u < 2; ++u)
#pragma unroll
                    for (int j = 0; j < 4; ++j) {
                        lgw[u][j] = (-0.6065306597f * LOG2E) * RW_SG2(w0c2[u] + lw[u][j]);
                        const float a = RW_SG2(a0c2[u] + la[u][j]); aa[u][j] = a;
                        const float k = kr[u][j], kk = k * kkc2[u]; kkr[u][j] = kk; n2p[j] += kk * kk;
                        const float ao = RW_SG2(a0oc2[u] + lo[u][j]); const float kb = k * (1.f + (0.5f * (a + ao) - 1.f) * kac2[u]); bnp[j] += rr[u][j] * kb * rkc2[u]; gg[u][j] = lg[u][j];
                    }
            }
#undef RW_SG2
        }
#pragma unroll
        for (int j = 0; j < 4; ++j) n2p[j] = row_sum16(n2p[j]);
        if (fin) {
#pragma unroll
            for (int j = 0; j < 4; ++j) bnp[j] = row_sum16(bnp[j]);
        }
        if (n16 == 0) {
#pragma unroll
            for (int j = 0; j < 4; ++j) { float* e = ex + ((cp * 2 + hf) * 16 + q4 * 4 + j) * 2; e[0] = n2p[j]; e[1] = bnp[j]; }
        }
        RW_BAR();
        if (s + 1 < SEQ / 64) RW_LOADS(s + 1);
        {
            RW_OPQ();
            float bon[4], rsn[4];
#pragma unroll
            for (int j = 0; j < 4; ++j) { const float* e = ex + ((cp * 2 + (1 - hf)) * 16 + q4 * 4 + j) * 2; rsn[j] = __builtin_amdgcn_rsqf(n2p[j] + e[0] + 1e-12f); bon[j] = bnp[j] + e[1]; }
            const int ch2 = hf * 32 + 2 * n16; const f32x2 kac2 = *(const f32x2*)(CST + 256 + ch2);
            float excl[2], PCv[2], eprev[2], L[2][4];
#pragma unroll
            for (int u = 0; u < 2; ++u) {
                L[u][0] = lgw[u][0]; L[u][1] = L[u][0] + lgw[u][1]; L[u][2] = L[u][1] + lgw[u][2]; L[u][3] = L[u][2] + lgw[u][3];
                const unsigned tu = __builtin_bit_cast(unsigned, L[u][3]);
                auto s16 = __builtin_amdgcn_permlane16_swap(tu, tu, false, false);
                const float sa = __builtin_bit_cast(float, (unsigned)s16[0]), sb = __builtin_bit_cast(float, (unsigned)s16[1]), sp = sa + sb;
                const unsigned pu = __builtin_bit_cast(unsigned, sp);
                auto s32 = __builtin_amdgcn_permlane32_swap(pu, pu, false, false);
                const float s01 = __builtin_bit_cast(float, (unsigned)s32[0]), s23 = __builtin_bit_cast(float, (unsigned)s32[1]);
                const float LC = s01 + s23;
                const float incl = q4 == 0 ? sa : q4 == 1 ? sp : q4 == 2 ? s01 + sa : LC;
                excl[u] = incl - L[u][3];
                PCv[u] = __builtin_amdgcn_exp2f(LC); eprev[u] = __builtin_amdgcn_exp2f(excl[u]);
            }
            if (q4 == 0) *(f32x2*)((float*)(slot + SL_PC) + ch2) = (f32x2){PCv[0], PCv[1]};
            float bhv[2][4], khv[2][4];
#pragma unroll
            for (int j = 0; j < 4; ++j) { const int i = q4 * 4 + j;
                float atv[2], rtv[2], btv[2], ktv[2];
#pragma unroll
                for (int u = 0; u < 2; ++u) {
                    const float eL = __builtin_amdgcn_exp2f(excl[u] + L[u][j]), eLp = eprev[u], emL = __builtin_amdgcn_rcpf(eL); eprev[u] = eL;
                    const float kk = kkr[u][j] * rsn[j], a = aa[u][j], k = kr[u][j];
                    const float bt = kk * a * emL, kt = k * (1.f + (a - 1.f) * kac2[u]) * emL;
                    atv[u] = -kk * eLp; rtv[u] = rr[u][j] * eL; btv[u] = bt; ktv[u] = kt;
                    bhv[u][j] = bt * PCv[u]; khv[u][j] = kt * PCv[u];
                }
                *(unsigned*)((bf16_t*)(slot + SL_AT) + i * 72 + ch2) = cvt_pk(atv[0], atv[1]); *(unsigned*)((bf16_t*)(slot + SL_RT) + i * 72 + ch2) = cvt_pk(rtv[0], rtv[1]);
                *(unsigned*)((bf16_t*)(slot + SL_BT) + i * 72 + ch2) = cvt_pk(btv[0], btv[1]); *(unsigned*)((bf16_t*)(slot + SL_KT) + i * 72 + ch2) = cvt_pk(ktv[0], ktv[1]);
            }
            if (fin) {
#pragma unroll
                for (int j = 0; j < 4; ++j) { const int i = q4 * 4 + j; *(unsigned*)(fgb + i * 64 + ch2) = cvt_pk(gg[0][j], gg[1][j]); *(unsigned*)(fgb + 1024 + i * 64 + ch2) = cvt_pk(bon[j] * vv[0][j] * gg[0][j], bon[j] * vv[1][j] * gg[1][j]); }
            }
#pragma unroll
            for (int u = 0; u < 2; ++u) { const int ch = ch2 + u;
                *(u32x2*)(slot + SL_BH + (ch * 20 + q4 * 4) * 2) = (u32x2){cvt_pk(bhv[u][0], bhv[u][1]), cvt_pk(bhv[u][2], bhv[u][3])};
                *(u32x2*)(slot + SL_KH + (ch * 20 + q4 * 4) * 2) = (u32x2){cvt_pk(khv[u][0], khv[u][1]), cvt_pk(khv[u][2], khv[u][3])};
                *(u32x2*)(slot + SL_VT + (ch * 20 + q4 * 4) * 2) = (u32x2){cvt_pk(vv[u][0], vv[u][1]), cvt_pk(vv[u][2], vv[u][3])};
            }
        }
        RW_BAR();
        f32x4 ysp[2] = {(f32x4){0.f, 0.f, 0.f, 0.f}, (f32x4){0.f, 0.f, 0.f, 0.f}};
        if (fin) {
            RW_OPQ();
#pragma unroll
            for (int jt = 0; jt < 2; ++jt) ysp[jt] = *(const f32x4*)((const char*)Ysc + (unsigned)((T0 + sgn * (hf * 8 + q4 * 2 + jt)) * 512 + n16 * 4) * 4u);
        }
        {
            RW_OPQ();
            const bf16_t* X = (const bf16_t*)(slot + (hf ? SL_RT : SL_AT)) + n16 * 72 + q4 * 8;
            const bf16_t* YB = (const bf16_t*)(slot + SL_BT) + n16 * 72 + q4 * 8; const bf16_t* YK = (const bf16_t*)(slot + SL_KT) + n16 * 72 + q4 * 8;
            const bf16x8 x0 = *(const bf16x8*)X, x1 = *(const bf16x8*)(X + 32);
            f32x4 mb = {0.f, 0.f, 0.f, 0.f}, mk = mb;
            mb = __builtin_amdgcn_mfma_f32_16x16x32_bf16(x0, *(const bf16x8*)YB, mb, 0, 0, 0); mb = __builtin_amdgcn_mfma_f32_16x16x32_bf16(x1, *(const bf16x8*)(YB + 32), mb, 0, 0, 0);
            mk = __builtin_amdgcn_mfma_f32_16x16x32_bf16(x0, *(const bf16x8*)YK, mk, 0, 0, 0); mk = __builtin_amdgcn_mfma_f32_16x16x32_bf16(x1, *(const bf16x8*)(YK + 32), mk, 0, 0, 0);
#pragma unroll
            for (int jj = 0; jj < 4; ++jj) { const int i = q4 * 4 + jj; const bool keep = hf ? (n16 <= i) : (n16 < i); const float vb = keep ? mb[jj] : 0.f, vk = keep ? mk[jj] : 0.f;
                mb[jj] = vb;
                ((bf16_t*)(slot + (hf ? SL_ARK : SL_AAK)))[i * 20 + n16] = f2bf(vk);
                if (hf) ((bf16_t*)(slot + SL_ARB))[i * 20 + n16] = f2bf(vb); }
            if (hf == 0) {
#define RW_P4(M) __builtin_bit_cast(s16x4, (u32x2){cvt_pk(M[0], M[1]), cvt_pk(M[2], M[3])})
#define RW_MM16(A_, B_, C_) __builtin_amdgcn_mfma_f32_16x16x16bf16_1k(A_, B_, C_, 0, 0, 0)
                const f32x4 z4f = {0.f, 0.f, 0.f, 0.f};
                f32x4 nt = z4f;
                nt = __builtin_amdgcn_mfma_f32_16x16x32_bf16(*(const bf16x8*)YB, x0, nt, 0, 0, 0); nt = __builtin_amdgcn_mfma_f32_16x16x32_bf16(*(const bf16x8*)(YB + 32), x1, nt, 0, 0, 0);
                f32x4 R;
#pragma unroll
                for (int jj = 0; jj < 4; ++jj) { const int i = q4 * 4 + jj; nt[jj] = (i < n16) ? nt[jj] : 0.f; R[jj] = nt[jj] + (i == n16 ? 1.f : 0.f); }
                const s16x4 n1 = RW_P4(mb), n1t = RW_P4(nt);
                const f32x4 N2 = RW_MM16(n1t, n1, z4f), N2t = RW_MM16(n1, n1t, z4f);
                const s16x4 n2 = RW_P4(N2), n2t = RW_P4(N2t);
                R = RW_MM16(n2, RW_P4(R), R);
                const f32x4 N4 = RW_MM16(n2t, n2, z4f), N4t = RW_MM16(n2, n2t, z4f);
                const s16x4 n4 = RW_P4(N4), n4t = RW_P4(N4t);
                R = RW_MM16(n4, RW_P4(R), R);
                const f32x4 N8 = RW_MM16(n4t, n4, z4f);
                R = RW_MM16(RW_P4(N8), RW_P4(R), R);
                *(u32x2*)((bf16_t*)(slot + SL_TT) + n16 * 20 + q4 * 4) = (u32x2){cvt_pk(R[0], R[1]), cvt_pk(R[2], R[3])};
#undef RW_P4
#undef RW_MM16
            }
        }
        RW_BAR();
        if (wid < 4) {
            RW_OPQ();
#pragma unroll
            for (int c2 = 0; c2 < 4; ++c2) {
                const unsigned char* sl = lds + RW_SLOT + c2 * SL_SZ;
                const bf16x8 sf0 = pack8(ST[0][0], ST[0][1], ST[0][2], ST[0][3], ST[1][0], ST[1][1], ST[1][2], ST[1][3]);
                const bf16x8 sf1 = pack8(ST[2][0], ST[2][1], ST[2][2], ST[2][3], ST[3][0], ST[3][1], ST[3][2], ST[3][3]);
                const bf16_t* AT = (const bf16_t*)(sl + SL_AT) + n16 * 72 + q4 * 4; const bf16_t* RT = (const bf16_t*)(sl + SL_RT) + n16 * 72 + q4 * 4;
                const int mo = (n16 * 20 + q4 * 4) * 2;
                const u32x2 vmf = *(const u32x2*)(sl + SL_VT + ((vt * 16 + n16) * 20 + q4 * 4) * 2);
                const f32x4 z4f = {0.f, 0.f, 0.f, 0.f};
                f32x4 X = __builtin_amdgcn_mfma_f32_16x16x16bf16_1k(__builtin_bit_cast(s16x4, *(const u32x2*)(sl + SL_AAK + mo)), __builtin_bit_cast(s16x4, vmf), z4f, 0, 0, 0);
                X = __builtin_amdgcn_mfma_f32_16x16x32_bf16(lo_hi(*(const u32x2*)(AT), *(const u32x2*)(AT + 16)), sf0, X, 0, 0, 0);
                X = __builtin_amdgcn_mfma_f32_16x16x32_bf16(lo_hi(*(const u32x2*)(AT + 32), *(const u32x2*)(AT + 48)), sf1, X, 0, 0, 0);
                const f32x4 U = __builtin_amdgcn_mfma_f32_16x16x16bf16_1k(__builtin_bit_cast(s16x4, *(const u32x2*)(sl + SL_TT + mo)), __builtin_bit_cast(s16x4, (u32x2){cvt_pk(X[0], X[1]), cvt_pk(X[2], X[3])}), z4f, 0, 0, 0);
                const bf16x8 uv = lo_hi((u32x2){cvt_pk(U[0], U[1]), cvt_pk(U[2], U[3])}, vmf);
                f32x4 Y = {0.f, 0.f, 0.f, 0.f};
                Y = __builtin_amdgcn_mfma_f32_16x16x32_bf16(lo_hi(*(const u32x2*)(RT), *(const u32x2*)(RT + 16)), sf0, Y, 0, 0, 0);
                Y = __builtin_amdgcn_mfma_f32_16x16x32_bf16(lo_hi(*(const u32x2*)(RT + 32), *(const u32x2*)(RT + 48)), sf1, Y, 0, 0, 0);
                Y = __builtin_amdgcn_mfma_f32_16x16x32_bf16(lo_hi(*(const u32x2*)(sl + SL_ARB + mo), *(const u32x2*)(sl + SL_ARK + mo)), uv, Y, 0, 0, 0);
#pragma unroll
                for (int t = 0; t < 4; ++t) {
                    const f32x4 pc = *(const f32x4*)(sl + SL_PC + (t * 16 + q4 * 4) * 4);
                    const int kro = ((t * 16 + n16) * 20 + q4 * 4) * 2;
                    ST[t] = __builtin_amdgcn_mfma_f32_16x16x32_bf16(lo_hi(*(const u32x2*)(sl + SL_BH + kro), *(const u32x2*)(sl + SL_KH + kro)), uv, ST[t] * pc, 0, 0, 0);
                }
                float* yo = (float*)(lds + RW_SLOT + c2 * SL_SZ + SL_BT);
#pragma unroll
                for (int j = 0; j < 4; ++j) yo[(q4 * 4 + j) * 64 + vt * 16 + n16] = Y[j];
            }
        }
        RW_BAR();
        {
            RW_OPQ();
            const float* yo = (const float*)(slot + SL_BT);
            const int i0 = hf * 8 + q4 * 2, o0 = i0 * 64 + n16 * 4, t0 = T0 + sgn * i0, t1 = t0 + sgn;
            f32x4 y0 = *(const f32x4*)(yo + o0), y1 = *(const f32x4*)(yo + o0 + 64);
            u32x2 res[2] = {(u32x2){0u, 0u}, (u32x2){0u, 0u}};
            if (fin) {
                const f32x4 lng4 = *(const f32x4*)(CST + 384 + n16 * 4), lnb4 = *(const f32x4*)(CST + 448 + n16 * 4);
#pragma unroll
                for (int jt = 0; jt < 2; ++jt) { const int o = o0 + jt * 64;
                    const f32x4 y = (jt ? y1 : y0) + ysp[jt];
                    const float s1 = row_sum16(y[0] + y[1] + y[2] + y[3]), s2 = row_sum16(y[0] * y[0] + y[1] * y[1] + y[2] * y[2] + y[3] * y[3]);
                    const float mean = s1 * (1.f / 64.f), var = s2 * (1.f / 64.f) - mean * mean; const float rs = __builtin_amdgcn_rsqf(var + 64e-5f);
                    const u32x2 g2 = *(const u32x2*)(fgb + o), v2 = *(const u32x2*)(fgb + 1024 + o);
                    const float r0 = ((y[0] - mean) * rs * lng4[0] + lnb4[0]) * bf_lo(g2[0]) + bf_lo(v2[0]), r1 = ((y[1] - mean) * rs * lng4[1] + lnb4[1]) * bf_hi(g2[0]) + bf_hi(v2[0]);
                    const float r2 = ((y[2] - mean) * rs * lng4[2] + lnb4[2]) * bf_lo(g2[1]) + bf_lo(v2[1]), r3 = ((y[3] - mean) * rs * lng4[3] + lnb4[3]) * bf_hi(g2[1]) + bf_hi(v2[1]);
                    res[jt] = (u32x2){cvt_pk(r0, r1), cvt_pk(r2, r3)};
                }
            }
            RW_LANDED();
            if (!fin) { *(f32x4*)((char*)Ysc + (unsigned)(t0 * 512 + n16 * 4) * 4u) = y0; *(f32x4*)((char*)Ysc + (unsigned)(t1 * 512 + n16 * 4) * 4u) = y1; }
            else { *(u32x2*)((char*)Ob + (unsigned)(t0 * 1024 + n16 * 4) * 2u) = res[0]; *(u32x2*)((char*)Ob + (unsigned)(t1 * 1024 + n16 * 4) * 2u) = res[1]; }
        }
        if (s == SEQ / 128 - 1) {
            asm volatile("s_waitcnt vmcnt(0)" ::: "memory");
            __syncthreads();
            if (tid == 0) { __builtin_amdgcn_fence(__ATOMIC_RELEASE, "agent"); asm volatile("s_waitcnt vmcnt(0)" ::: "memory"); __hip_atomic_store(flags + task * 16, 1u, __ATOMIC_RELAXED, __HIP_MEMORY_SCOPE_AGENT); }
        }
    }
}

DI void phase_mixer(const Params& P, unsigned char* lds, int qsel, int mode = 0) {
    const int lane = threadIdx.x & 63;
    const float lam = __expf(wave_sum(P.da_lq1[lane] * P.da_lk1[lane])) - __expf(wave_sum(P.da_lq2[lane] * P.da_lk2[lane])) + 0.2f;
    float mq = fabsf(P.da_q_norm_g[lane]), mk = fabsf(P.da_k_norm_g[lane]);
    mq = wave_max(mq); mk = wave_max(mk);
    const float smax_ = 8.0f * mq * mk * 1.01f;
    unsigned* qhead = (unsigned*)(P.ws + WS_CTL) + CW_QUEUE + qsel;
    volatile unsigned* qw = (volatile unsigned*)(lds + LDS_QW);
    volatile float* pw = (volatile float*)(lds + LDS_QW + 4);
    if (threadIdx.x == 0) { pw[0] = lam; pw[1] = smax_; }
    for (;;) {
        __syncthreads();
        if (threadIdx.x == 0) *qw = atomicAdd(qhead, 1u) + (mode == 2 ? 128u : 0u);
        __syncthreads();
        const unsigned idx = __builtin_amdgcn_readfirstlane(*qw);
#ifndef AT_REP
#define AT_REP 1
#endif
#ifndef RW_DUP
#define RW_DUP 0
#endif
        if (idx >= 128u + 128u * RW_DUP + 2048u * AT_REP || (mode == 1 && idx >= 128u)) break;
#if !defined(MIX_ONLY) || MIX_ONLY == 1
        if (idx < 128u + 128u * RW_DUP) { const unsigned ti = idx & 127u; rwkv_task(P, lds, (int)(ti >> 4), (int)((ti >> 1) & 7), (int)(ti & 1)); }
#endif
#if !defined(MIX_ONLY) || MIX_ONLY == 2
        if (idx >= 128u + 128u * RW_DUP) { const unsigned u = (idx - 128u - 128u * RW_DUP) & 2047u; const int h = 3 - (int)(u >> 9), b = (int)((u >> 6) & 7), qb = (int)(u & 63);
            const float lam_ = __builtin_bit_cast(float, __builtin_amdgcn_readfirstlane(__builtin_bit_cast(int, (float)pw[0]))), smax = __builtin_bit_cast(float, __builtin_amdgcn_readfirstlane(__builtin_bit_cast(int, (float)pw[1])));
            const float slope = exp2f(-2.0f * (float)(h + 1)); int W = (int)ceilf((25.65f + 2.0f * smax) / slope); if (W > SEQ) W = SEQ;
            attn_unit(P, lds, b, h, qb, lam_, smax * LOG2E, W); }
#endif
    }
}

constexpr int N_PHASES = 13;
__global__ void __launch_bounds__(512, 2) mega(Params P) {
    extern __shared__ __attribute__((aligned(16))) unsigned char shm[];
    LAS unsigned char* lds = (LAS unsigned char*)shm;
    unsigned char* ws = P.ws;
    if (threadIdx.x == 0) *(LAS u32x4*)(lds + LDS_XB) = (u32x4){0u, 0u, 0u, 0u};
    __syncthreads();
    XcdBarrier bar = xcd_barrier_post(g_xbar, (volatile LAS unsigned*)(lds + LDS_XB));
#ifndef ONLY_PHASE
#define RUN(k) (P.ph_lo <= (k) && (k) < P.ph_hi)
#else
#define RUN(k) ((k) == ONLY_PHASE && P.ph_lo <= (k) && (k) < P.ph_hi)
#endif
#ifdef DIAG_PHASE
    unsigned long long dg_t0 = 0, dg_t1 = 0;
#define SYNC(k) do { if (P.ph_lo <= (k) && (k) + 1 < P.ph_hi) xcd_barrier(bar); if ((k) + 1 == DIAG_PHASE || ((k) == 8 && DIAG_PHASE == 12)) dg_t0 = wall_clock64(); if ((k) == DIAG_PHASE) dg_t1 = wall_clock64(); } while (0)
#else
#define SYNC(k) do { if (P.ph_lo <= (k) && (k) + 1 < P.ph_hi) xcd_barrier(bar); } while (0)
#endif
    if (RUN(0)) phase_prep(P, shm);
#if defined(REP_PHASE) && REP_PHASE == 0
    xcd_barrier(bar); phase_prep(P, shm);
#endif
    SYNC(0);
    if (RUN(1)) { DenseOrder S; S.init(ws + WS_U, ws + WS_WIN, MTOK, IN_PAD, 2048, 2048); EpiZ E{(bf16_t*)(ws + WS_Z), P.da_q_norm_g, P.da_k_norm_g}; gemm_phase<false, 2>(lds, 1024, 1024, S, E);
#if defined(REP_PHASE) && REP_PHASE == 1
        xcd_barrier(bar); gemm_phase<false, 2>(lds, 1024, 1024, S, E);
#endif
#if defined(REP_PHASE) && REP_PHASE == 101
        xcd_barrier(bar); { EpiNone E0{(float*)(ws + WS_ESS)}; gemm_phase<false, 2>(lds, 1024, 1024, S, E0); }
#endif
    }
    SYNC(1);
    if (RUN(2)) phase_qknorm(P);
    SYNC(2);
#if defined(REP_PHASE) && REP_PHASE == 3
    if (RUN(3)) for (int rep = 0; rep < 2; ++rep) { if (rep) xcd_barrier(bar); phase_mixer(P, shm, rep, rep ? REP_MODE : 0); }
#else
    if (RUN(3)) phase_mixer(P, shm, 0);
#endif
    SYNC(3);
    if (RUN(4)) { DenseOrder S; S.init(ws + WS_O, ws + WS_WOUT, MTOK, 1024, 2048, 2048); EpiH1 E{P.x, (bf16_t*)P.out}; gemm_phase<false, 2>(lds, 1024, 1024, S, E);
#if defined(REP_PHASE) && REP_PHASE == 4
        xcd_barrier(bar); gemm_phase<false, 2>(lds, 1024, 1024, S, E);
#endif
    }
    SYNC(4);
    if (RUN(5)) phase_route(P, lds);
    SYNC(5);
    if (RUN(6)) { moe_tables(lds, (const unsigned*)(ws + WS_CTL) + CW_CNT);
        MoeOrder<8, true, 1> S{(const char*)(ws + WS_U), (const char*)(ws + WS_W1), (size_t)2048 * 1024, 0, 128, (int)gridDim.x, (int)blockIdx.x, lds, (const int*)(ws + WS_LIST)};
        EpiMoe1 E{ws + WS_Z, P.b1}; gemm_phase<true, 1>(lds, 1024, 1024, S, E);
#if defined(REP_PHASE) && REP_PHASE == 6
        xcd_barrier(bar); gemm_phase<true, 1>(lds, 1024, 1024, S, E);
#endif
    }
    SYNC(6);
    if (RUN(7)) { moe_tables(lds, (const unsigned*)(ws + WS_CTL) + CW_CNT);
        MoeOrder<4, false, 1> S{(const char*)(ws + WS_Z), (const char*)(ws + WS_W2), (size_t)1024 * 1024, 0, 128, (int)gridDim.x, (int)blockIdx.x, lds, (const int*)(ws + WS_LIST)};
        EpiMoe2 E{ws + WS_Y8}; gemm_phase<true, 1>(lds, 1024, 1024, S, E);
        DenseOrder SP; SP.init(ws + WS_PB, ws + WS_WPLE, MTOK, 1024, 512, 512);
        { const LAS int* pre_ = (const LAS int*)(lds + LDS_GRP) + 128; const int n2 = (__builtin_amdgcn_readfirstlane(pre_[128]) - __builtin_amdgcn_readfirstlane(pre_[0])) * 4, G_ = (int)gridDim.x, c_ = (int)blockIdx.x;
          const int i1 = n2 > c_ ? (n2 - c_ + G_ - 1) / G_ : 0; SP.shift = i1 * G_ - n2; }
        EpiPle EP{(bf16_t*)(ws + WS_U), (float*)(ws + WS_ESS)}; gemm_phase<true, 2>(lds, 256, 256, SP, EP); }
    SYNC(7);
    if (RUN(8)) phase_combine(P, lds);
    SYNC(8);
    if (RUN(12)) { DenseOrder S; S.init(ws + WS_W2, ws + WS_WG, MTOK, 1024, 1024, 1024); EpiFinal E{P.out, (const bf16_t*)(ws + WS_HB), (const bf16_t*)(ws + WS_U), (const float*)(ws + WS_ESS), P.ple_norm_g}; gemm_phase<true, 1>(lds, 1024, 1024, S, E); }
#ifdef DIAG_PHASE
    xcd_barrier(bar); if (DIAG_PHASE == 12) dg_t1 = wall_clock64();
    __syncthreads();
    if (blockIdx.x == 0 && threadIdx.x == 0) { asm volatile("s_waitcnt vmcnt(0)" ::: "memory"); P.out[0] += (float)((((dg_t1 - dg_t0) / 100ull + DIAG_Q / 2) / DIAG_Q) * DIAG_Q); }
#endif
    __syncthreads();
    if (threadIdx.x == 0) { const unsigned old = xb_add(&g_xbar[XCD_BAR_WORDS], 1u); *(volatile LAS unsigned*)(lds + LDS_QW) = (old + 1u == gridDim.x) ? 1u : 0u; }
    __syncthreads();
    if (*(volatile LAS unsigned*)(lds + LDS_QW) != 0u) { for (int i = threadIdx.x; i < XCD_BAR_WORDS + 64; i += 512) __hip_atomic_store(&g_xbar[i], 0u, __ATOMIC_RELAXED, __HIP_MEMORY_SCOPE_AGENT); }
}

#ifndef MK_N_LAUNCHES
#define MK_N_LAUNCHES 1
#endif
extern "C" void kernel_launch(void* const* d_in, const int* in_sizes, int n_in, void* d_out, int out_size, void* d_ws, size_t ws_size, hipStream_t stream) {
    static int grid = 0;
    if (grid == 0) {
        if (n_in != 33 || in_sizes[0] != MTOK * D_MODEL || out_size != MTOK * D_MODEL || ws_size < WS_END) {
            fprintf(stderr, "kernel_launch: shape mismatch: n_in %d in0 %d out %d ws %zu (need %zu)\n", n_in, n_in > 0 ? in_sizes[0] : -1, out_size, ws_size, (size_t)WS_END); grid = -1; return; }
        int dev = 0, cus = 0, per_cu = 0;
        if (hipGetDevice(&dev) != hipSuccess || hipDeviceGetAttribute(&cus, hipDeviceAttributeMultiprocessorCount, dev) != hipSuccess) { grid = -1; return; }
        if (hipFuncSetAttribute((const void*)mega, hipFuncAttributeMaxDynamicSharedMemorySize, LDS_BYTES) != hipSuccess) { fprintf(stderr, "kernel_launch: hipFuncSetAttribute failed\n"); grid = -1; return; }
        if (hipOccupancyMaxActiveBlocksPerMultiprocessor(&per_cu, (const void*)mega, 512, LDS_BYTES) != hipSuccess || per_cu < 1) fprintf(stderr, "kernel_launch: occupancy query says %d\n", per_cu);
        (void)hipGetLastError();
        grid = cus;
    }
    if (grid < 0) return;
    Params p{};
    const float** f = (const float**)&p;
    for (int i = 0; i < 33; ++i) f[i] = (const float*)d_in[i];
    p.out = (float*)d_out; p.ws = (unsigned char*)d_ws;
    if (MK_N_LAUNCHES == 1) { p.ph_lo = 0; p.ph_hi = N_PHASES; hipLaunchKernelGGL(mega, dim3(grid), dim3(512), LDS_BYTES, stream, p); }
    else for (int k = 0; k < N_PHASES; ++k) { p.ph_lo = k; p.ph_hi = k + 1; hipLaunchKernelGGL(mega, dim3(grid), dim3(512), LDS_BYTES, stream, p); }
    const hipError_t le = hipPeekAtLastError();
    if (le != hipSuccess) fprintf(stderr, "kernel_launch: launch failed: %s\n", hipGetErrorName(le));
}
```

```cpp
#include <hip/hip_runtime.h>
#include <stdint.h>
#include <stdio.h>

#define LAS __attribute__((address_space(3)))
#define DI __device__ __forceinline__
typedef unsigned short bf16_t;
typedef short bf16x8 __attribute__((ext_vector_type(8)));
typedef short s16x4 __attribute__((ext_vector_type(4)));
typedef float f32x4 __attribute__((ext_vector_type(4)));
typedef float f32x2 __attribute__((ext_vector_type(2)));
typedef float f32x16 __attribute__((ext_vector_type(16)));
typedef unsigned u32x4 __attribute__((ext_vector_type(4)));
typedef unsigned u32x2 __attribute__((ext_vector_type(2)));
typedef __bf16 bf16x2_t __attribute__((ext_vector_type(2)));

constexpr int D_MODEL = 1024, BATCH = 8, SEQ = 8192, MTOK = BATCH * SEQ;
constexpr int PLE_DIM = 256;
constexpr int C_RW = 512, RW_HEAD = 64, RW_HEADS = 8, RW_COLS = 1920;
constexpr int C_DA = 512, DA_HEADS = 4, DA_V = 128, DA_QK = 64;
constexpr int IN_COLS = 3456, IN_PAD = 3584;
constexpr int N_EXP = 32, TOPK = 4, D_FF = 1024;
constexpr int ZR = 0, ZK = 512, ZV = 1024, ZWD = 1536, ZAD = 1664, ZGD = 1792, ZQ = 1920, ZKK = 2432, ZVV = 2944;
constexpr float NORM_EPS = 1e-6f;
constexpr float LOG2E = 1.4426950408889634f;

constexpr size_t MiB = 1024ull * 1024ull;
constexpr size_t WS_CTL = 0;
constexpr size_t CTL_BYTES = 64 * 1024;
constexpr size_t WS_WIN = WS_CTL + CTL_BYTES;
constexpr size_t WS_WOUT = WS_WIN + (size_t)IN_PAD * 1024 * 2;
constexpr size_t WS_W1 = WS_WOUT + 2 * MiB;
constexpr size_t WS_W2 = WS_W1 + 128 * MiB;
constexpr size_t WS_WPLE = WS_W2 + 64 * MiB;
constexpr size_t WS_WG = WS_WPLE + MiB / 2;
constexpr size_t WS_PB = WS_WG + 2 * MiB;
constexpr size_t WS_U = WS_PB + 32 * MiB;
constexpr size_t WS_Z = WS_U + 128 * MiB;
constexpr size_t WS_Y8 = WS_Z + 288 * MiB;
constexpr size_t WS_HB = WS_W1;
constexpr size_t WS_O = WS_Z + 432 * MiB;
constexpr size_t WS_LIST = WS_Z + 576 * MiB;
constexpr size_t WS_GATE = WS_LIST + 32 * MiB;
constexpr size_t WS_ESS = WS_GATE + MiB;
constexpr size_t WS_XL = WS_ESS + MiB / 4;
constexpr size_t WS_TOKPOS = WS_XL;
constexpr size_t WS_END = WS_XL + 48 * MiB;
constexpr int ACT_ROWS_MAX = 262144 + 128 * 256;

constexpr int CW_BAR = 0;
constexpr int CW_CNT = 4096;
constexpr int CW_QUEUE = 4352;
constexpr int CW_LAM = 4416;
constexpr int CW_RWFLAG = 4480;

struct Params {
    const float* x; const float* p; const float* norm_mix_g; const float* w_in; const float* rw_mu; const float* rw_w0; const float* rw_w2;
    const float* rw_a0; const float* rw_a2; const float* rw_g2; const float* rw_k_k; const float* rw_k_a; const float* rw_r_k; const float* rw_ln_g;
    const float* rw_ln_b; const float* da_q_norm_g; const float* da_k_norm_g; const float* da_lq1; const float* da_lk1; const float* da_lq2;
    const float* da_lk2; const float* da_subln_g; const float* w_out; const float* norm_ffn_g; const float* w_router; const float* b_router;
    const float* w1; const float* b1; const float* w2; const float* b2; const float* w_ple; const float* ple_norm_g; const float* w_ple_gate;
    float* out; unsigned char* ws; int ph_lo, ph_hi;
};

DI unsigned cvt_pk(float lo, float hi) { f32x2 v = {lo, hi}; bf16x2_t r = __builtin_convertvector(v, bf16x2_t); return __builtin_bit_cast(unsigned, r); }
DI unsigned pk4_fp8(float a, float b, float c, float d) { int v = __builtin_amdgcn_cvt_pk_fp8_f32(a, b, 0, false); v = __builtin_amdgcn_cvt_pk_fp8_f32(c, d, v, true); return (unsigned)v; }
DI bf16x8 pack8(float a0, float a1, float a2, float a3, float a4, float a5, float a6, float a7) { u32x4 w = {cvt_pk(a0, a1), cvt_pk(a2, a3), cvt_pk(a4, a5), cvt_pk(a6, a7)}; return __builtin_bit_cast(bf16x8, w); }
DI float bf_lo(unsigned u) { return __uint_as_float(u << 16); }
DI float bf_hi(unsigned u) { return __uint_as_float(u & 0xffff0000u); }
DI float bf2f(bf16_t b) { return __uint_as_float(((unsigned)b) << 16); }
DI bf16_t f2bf(float f) { return (bf16_t)(cvt_pk(f, f) & 0xffffu); }
template <int CTRL, int RM> DI float dpp_mov0(float v) { return __builtin_bit_cast(float, __builtin_amdgcn_update_dpp(0, __builtin_bit_cast(int, v), CTRL, RM, 0xF, false)); }
DI float row_sum16(float v) {
    v += dpp_mov0<0x121, 0xF>(v); v += dpp_mov0<0x122, 0xF>(v); v += dpp_mov0<0x124, 0xF>(v); v += dpp_mov0<0x128, 0xF>(v); return v;
}
DI float wave_sum(float v) {
    v = row_sum16(v);
    v += dpp_mov0<0x142, 0xA>(v);
    v += dpp_mov0<0x143, 0xC>(v);
    return __builtin_bit_cast(float, __builtin_amdgcn_readlane(__builtin_bit_cast(int, v), 63));
}
DI float xsum16(float v) { const unsigned u = __builtin_bit_cast(unsigned, v); auto r = __builtin_amdgcn_permlane16_swap(u, u, false, false); return __builtin_bit_cast(float, (unsigned)r[0]) + __builtin_bit_cast(float, (unsigned)r[1]); }
DI float xsum32(float v) { const unsigned u = __builtin_bit_cast(unsigned, v); auto r = __builtin_amdgcn_permlane32_swap(u, u, false, false); return __builtin_bit_cast(float, (unsigned)r[0]) + __builtin_bit_cast(float, (unsigned)r[1]); }
DI float wave_max(float v) {
    v = fmaxf(v, dpp_mov0<0x121, 0xF>(v)); v = fmaxf(v, dpp_mov0<0x122, 0xF>(v)); v = fmaxf(v, dpp_mov0<0x124, 0xF>(v)); v = fmaxf(v, dpp_mov0<0x128, 0xF>(v));
    const unsigned u = __builtin_bit_cast(unsigned, v); auto r = __builtin_amdgcn_permlane16_swap(u, u, false, false); v = fmaxf(__builtin_bit_cast(float, (unsigned)r[0]), __builtin_bit_cast(float, (unsigned)r[1]));
    const unsigned w = __builtin_bit_cast(unsigned, v); auto q = __builtin_amdgcn_permlane32_swap(w, w, false, false); return fmaxf(__builtin_bit_cast(float, (unsigned)q[0]), __builtin_bit_cast(float, (unsigned)q[1]));
}
DI float sigmoidf_(float x) { return __builtin_amdgcn_rcpf(1.f + __builtin_amdgcn_exp2f(-x * LOG2E)); }

#define XB_TMO      128
#define XB_XCNT(j)  (256  + 64 * (j))
#define XB_XSUB(j)  (1280 + 64 * (j))
#define XB_XGEN(j)  (2304 + 64 * (j))
#define XB_TOP      3328
#define XB_TOPGEN   3392
#define XCD_BAR_WORDS 3456
#define XB_SPIN_CAP (1u << 22)
DI unsigned xb_ld(unsigned* p)              { return __hip_atomic_load(p, __ATOMIC_RELAXED, __HIP_MEMORY_SCOPE_AGENT); }
DI unsigned xb_add(unsigned* p, unsigned v) { return __hip_atomic_fetch_add(p, v, __ATOMIC_RELAXED, __HIP_MEMORY_SCOPE_AGENT); }
DI unsigned xb_xcc_id() { return (unsigned)__builtin_amdgcn_s_getreg((3 << 11) | 20) & 0xFu; }
#define XB_SPIN(cond, bar) do { unsigned _sp = 0; while (cond) { __builtin_amdgcn_s_sleep(1); \
    if ((++_sp & 255u) == 0u) { if (xb_ld(&(bar)[XB_TMO])) break; if (_sp > XB_SPIN_CAP) { atomicAdd(&(bar)[XB_TMO], 1u); break; } } } } while (0)
__device__ unsigned g_xbar[XCD_BAR_WORDS + 64];
struct XcdBarrier { unsigned* bar; unsigned x; volatile LAS unsigned* st; };
DI XcdBarrier xcd_barrier_post(unsigned* bar, volatile LAS unsigned* st) {
    XcdBarrier b; b.bar = bar; b.x = xb_xcc_id(); b.st = st;
    if (threadIdx.x == 0) (void)xb_add(&bar[XB_XCNT(b.x)], 1u);
    return b;
}
DI void xcd_barrier_complete(unsigned* bar, unsigned x, unsigned& nloc, unsigned& nx) {
    const unsigned G = gridDim.x * gridDim.y * gridDim.z;
    unsigned sum, cnt, mine, sp = 0u;
    for (;;) {
        sum = 0u; cnt = 0u; mine = 0u;
#pragma unroll
        for (unsigned j = 0; j < 16; ++j) { const unsigned c = xb_ld(&bar[XB_XCNT(j)]); sum += c; cnt += (c > 0u) ? 1u : 0u; mine = (j == x) ? c : mine; }
        if (sum == G) break;
        __builtin_amdgcn_s_sleep(1);
        if ((++sp & 255u) == 0u) { if (xb_ld(&bar[XB_TMO])) break; if (sp > XB_SPIN_CAP) { atomicAdd(&bar[XB_TMO], 1u); break; } }
    }
    nloc = mine > 0u ? mine : 1u; nx = cnt > 0u ? cnt : 1u;
}
DI void xcd_barrier(const XcdBarrier& b) {
    asm volatile("s_waitcnt vmcnt(0)" ::: "memory");
    __syncthreads();
    if (threadIdx.x == 0) {
        unsigned* bar = b.bar;
        __builtin_amdgcn_s_waitcnt(0);
        unsigned nloc = b.st[0], nx = b.st[1];
        if (nloc == 0u) { xcd_barrier_complete(bar, b.x, nloc, nx); b.st[0] = nloc; b.st[1] = nx; }
        const unsigned old = xb_add(&bar[XB_XSUB(b.x)], 1u);
        const unsigned gen = old / nloc;
        if (old + 1u == (gen + 1u) * nloc) {
            __builtin_amdgcn_fence(__ATOMIC_RELEASE, "agent");
            asm volatile("s_waitcnt vmcnt(0)" ::: "memory");
            const unsigned og = xb_add(&bar[XB_TOP], 1u);
            const unsigned tg = og / nx;
            if (og + 1u == (tg + 1u) * nx) xb_add(&bar[XB_TOPGEN], 1u);
            else XB_SPIN(xb_ld(&bar[XB_TOPGEN]) == tg, bar);
            __builtin_amdgcn_fence(__ATOMIC_ACQUIRE, "agent");
            xb_add(&bar[XB_XGEN(b.x)], 1u);
            asm volatile("s_waitcnt vmcnt(0)" ::: "memory");
        } else {
            XB_SPIN(xb_ld(&bar[XB_XGEN(b.x)]) == gen, bar);
            __builtin_amdgcn_fence(__ATOMIC_ACQUIRE, "agent");
            asm volatile("s_waitcnt vmcnt(0)" ::: "memory");
        }
    }
    __syncthreads();
}

constexpr int BM = 256, BK = 64, HALF = 128, HTB = HALF * BK * 2, STAGE_BYTES = 8 * HTB, NXCD = 8, WGM = 8;
constexpr int LDS_TAB = STAGE_BYTES;
constexpr int LDS_GRP = STAGE_BYTES + 2048;
constexpr int LDS_BYTES = 156 * 1024;
constexpr int LDS_XB = LDS_BYTES - 16;
constexpr int LDS_QW = LDS_BYTES - 32;

DI void tconv_tile(const float* __restrict__ src, int ldn, int k0, int ncol0, bool zero, bf16_t* __restrict__ dst, int K, int nrow0, float* tile  ) {
    const int t = threadIdx.x;
    {
        const int kk = t >> 4, c4 = (t & 15) * 4;
#pragma unroll
        for (int i = 0; i < 2; ++i) {
            const int k = kk + 32 * i;
            f32x4 v = {0.f, 0.f, 0.f, 0.f};
            if (!zero) v = *(const f32x4*)(src + (size_t)(k0 + k) * ldn + ncol0 + c4);
            tile[(c4 + 0) * 65 + k] = v[0]; tile[(c4 + 1) * 65 + k] = v[1]; tile[(c4 + 2) * 65 + k] = v[2]; tile[(c4 + 3) * 65 + k] = v[3];
        }
    }
    __syncthreads();
    {
        const int n = t >> 3, kc = (t & 7) * 8;
        const float* r = tile + n * 65 + kc;
        u32x4 o = {cvt_pk(r[0], r[1]), cvt_pk(r[2], r[3]), cvt_pk(r[4], r[5]), cvt_pk(r[6], r[7])};
        *(u32x4*)(dst + (size_t)(nrow0 + n) * K + k0 + kc) = o;
    }
    __syncthreads();
}

DI void tconv_tile8(const float* __restrict__ src, int ldn, int k0, int ncol0, unsigned char* __restrict__ dst, int K, int nrow0, float sc, float* tile) {
    const int t = threadIdx.x;
    {
        const int kk = t >> 4, c4 = (t & 15) * 4;
#pragma unroll
        for (int i = 0; i < 2; ++i) {
            const int k = kk + 32 * i;
            const f32x4 v = *(const f32x4*)(src + (size_t)(k0 + k) * ldn + ncol0 + c4);
            tile[(c4 + 0) * 65 + k] = v[0]; tile[(c4 + 1) * 65 + k] = v[1]; tile[(c4 + 2) * 65 + k] = v[2]; tile[(c4 + 3) * 65 + k] = v[3];
        }
    }
    __syncthreads();
    {
        const int n = t >> 3, kc = (t & 7) * 8;
        const float* r = tile + n * 65 + kc;
        u32x2 o = {pk4_fp8(r[0] * sc, r[1] * sc, r[2] * sc, r[3] * sc), pk4_fp8(r[4] * sc, r[5] * sc, r[6] * sc, r[7] * sc)};
        *(u32x2*)(dst + (size_t)(nrow0 + n) * K + k0 + kc) = o;
    }
    __syncthreads();
}
constexpr float W8_SCALE = 64.0f, M8_SCALE = 16.0f, A8_SCALE = 4.0f, Y8_SCALE = 16.0f;

DI void phase_prep(const Params& P, unsigned char* lds_generic) {
    float* tile = (float*)lds_generic;
    const int wg = blockIdx.x, nwg = gridDim.x;
    unsigned char* ws = P.ws;
    constexpr int J0 = 16 * 56, J1 = J0 + 256, J2 = J1 + 32 * 16 * 32, J3 = J2 + 32 * 16 * 16, J4 = J3 + 64, J5 = J4 + 256;
    for (int j = wg; j < J5; j += nwg) {
        if (j < J0) { const int kt = j / 56, nt = j % 56; tconv_tile(P.w_in, IN_COLS, kt * 64, nt * 64, nt >= 54, (bf16_t*)(ws + WS_WIN), 1024, nt * 64, tile); }
        else if (j < J1) { const int q = j - J0, kt = q >> 4, nt = q & 15; tconv_tile(P.w_out, 1024, kt * 64, nt * 64, false, (bf16_t*)(ws + WS_WOUT), 1024, nt * 64, tile); }
        else if (j < J2) { const int q = j - J1, e = q >> 9, r = q & 511, kt = r >> 5, nt = r & 31; const int n0 = nt * 64;
            const int orig = ((n0 & 128) ? 1024 : 0) + (n0 >> 8) * 128 + (n0 & 127);
            tconv_tile8(P.w1 + (size_t)e * 1024 * 2048, 2048, kt * 64, orig, ws + WS_W1 + (size_t)e * 2048 * 1024, 1024, n0, W8_SCALE, tile); }
        else if (j < J3) { const int q = j - J2, e = q >> 8, r = q & 255, kt = r >> 4, nt = r & 15;
            tconv_tile8(P.w2 + (size_t)e * 1024 * 1024, 1024, kt * 64, nt * 64, ws + WS_W2 + (size_t)e * 1024 * 1024, 1024, nt * 64, W8_SCALE, tile); }
        else if (j < J4) { const int q = j - J3, kt = q >> 4, nt = q & 15; tconv_tile(P.w_ple, 1024, kt * 64, nt * 64, false, (bf16_t*)(ws + WS_WPLE), 256, nt * 64, tile); }
        else { const int q = j - J4, kt = q >> 4, nt = q & 15; tconv_tile8(P.w_ple_gate, 1024, kt * 64, nt * 64, ws + WS_WG, 1024, nt * 64, W8_SCALE, tile); }
    }
    {
        const int wid = __builtin_amdgcn_readfirstlane(threadIdx.x >> 6), lane = threadIdx.x & 63;
        f32x4 g[4];
#pragma unroll
        for (int i = 0; i < 4; ++i) g[i] = *(const f32x4*)(P.norm_mix_g + 4 * lane + 256 * i);
        bf16_t* U = (bf16_t*)(ws + WS_U);
        const int rstep = nwg * 8; int row = wg * 8 + wid;
        f32x4 vn[4];
#pragma unroll
        for (int i = 0; i < 4; ++i) vn[i] = (row < MTOK) ? *(const f32x4*)(P.x + (size_t)row * 1024 + 4 * lane + 256 * i) : (f32x4){0.f, 0.f, 0.f, 0.f};
        for (; row < MTOK; row += rstep) {
            f32x4 v[4]; float ss = 0.f;
#pragma unroll
            for (int i = 0; i < 4; ++i) { v[i] = vn[i]; ss += v[i][0] * v[i][0] + v[i][1] * v[i][1] + v[i][2] * v[i][2] + v[i][3] * v[i][3]; }
            const int rn = row + rstep;
            if (rn < MTOK) {
#pragma unroll
                for (int i = 0; i < 4; ++i) vn[i] = *(const f32x4*)(P.x + (size_t)rn * 1024 + 4 * lane + 256 * i);
            }
            ss = wave_sum(ss);
            const float rinv = __builtin_amdgcn_rsqf(ss * (1.f / 1024.f) + NORM_EPS);
#pragma unroll
            for (int i = 0; i < 4; ++i) {
                u32x2 o = {cvt_pk(v[i][0] * rinv * g[i][0], v[i][1] * rinv * g[i][1]), cvt_pk(v[i][2] * rinv * g[i][2], v[i][3] * rinv * g[i][3])};
                *(u32x2*)(U + (size_t)row * 1024 + 4 * lane + 256 * i) = o;
            }
        }
    }
    { unsigned* ctl = (unsigned*)(ws + WS_CTL); for (int i = wg * 512 + (int)threadIdx.x; i < (int)(CTL_BYTES / 4) - CW_CNT; i += nwg * 512) ctl[CW_CNT + i] = 0u; }
    { float* ESS = (float*)(ws + WS_ESS); for (int i = wg * 512 + (int)threadIdx.x; i < MTOK; i += nwg * 512) ESS[i] = 0.f; }
    {
        bf16_t* PB = (bf16_t*)(ws + WS_PB);
        const size_t n8 = (size_t)MTOK * PLE_DIM / 8;
        for (size_t i = (size_t)wg * 512 + threadIdx.x; i < n8; i += (size_t)nwg * 512) {
            const f32x4 a = *(const f32x4*)(P.p + i * 8), b = *(const f32x4*)(P.p + i * 8 + 4);
            u32x4 o = {cvt_pk(a[0], a[1]), cvt_pk(a[2], a[3]), cvt_pk(b[0], b[1]), cvt_pk(b[2], b[3])};
            *(u32x4*)(PB + i * 8) = o;
        }
    }
}

DI int lds_byte(int r, int c) { const int st = (r >> 4) * 2 + (c >> 5), rr = r & 15, cc = c & 31, ob = rr * 64 + cc * 2; return st * 1024 + (ob ^ (((ob >> 9) & 1) << 5)); }
DI void stage_rc(int b, int& R, int& C) { const int st = b / 1024, sb = b % 1024, swz = sb ^ (((sb >> 9) & 1) << 5); R = (st >> 1) * 16 + swz / 64; C = (st & 1) * 32 + (swz % 64) / 2; }
DI int perm32(int rho) { const int n = rho >> 4, i = rho & 15; return 8 * (i >> 2) + 4 * n + (i & 3); }

struct Unit { unsigned ao, bo; int pm, pn, g, cnt, arow; };
typedef f32x4 AccT[2][2][4][2];

struct DenseOrder {
    const char* A; const char* B; int nM, nN, nwg, G, c; size_t astep, bstep; int shift = 0;
    DI void init(const void* A_, const void* B_, int M, int N, int lda_bytes, int ldb_bytes) { A = (const char*)A_; B = (const char*)B_; nM = M / BM; nN = N / BM; nwg = nM * nN; G = gridDim.x; c = blockIdx.x; astep = (size_t)BM * lda_bytes; bstep = (size_t)BM * ldb_bytes; }
    static constexpr bool GATHER = false;
    DI bool next(int i, Unit& u) const {
        const long L = (long)i * G + c + shift; if (L >= nwg) return false;
        int wgid = (int)L; { const int q = nwg / NXCD, r = nwg % NXCD, xcd = wgid % NXCD, off = wgid / NXCD; wgid = (xcd < r ? xcd * (q + 1) : r * (q + 1) + (xcd - r) * q) + off; }
        const int nig = WGM * nN, gid = wgid / nig, fm = gid * WGM, gsz = (nM - fm) < WGM ? (nM - fm) : WGM;
        u.pm = fm + ((wgid % nig) % gsz); u.pn = (wgid % nig) / gsz; u.ao = (unsigned)((size_t)u.pm * astep); u.bo = (unsigned)((size_t)u.pn * bstep); u.g = 0; u.cnt = 256; u.arow = u.pm * 256; return true;
    }
    DI void issue_table(const Unit&, LAS unsigned char*) const {}
    DI unsigned row_off(const Unit&, LAS unsigned char*, int) const { return 0u; }
};

struct PleTailOrder {
    const char* A; const char* B; int u0, u1, u2;
    static constexpr bool GATHER = false;
    DI void init(const void* A_, const void* B_, int sl, int moe_units) {
        A = (const char*)A_; B = (const char*)B_; const int G = gridDim.x, c = blockIdx.x, r = moe_units % G, nidle = G - r, k = c - r;
        u0 = u1 = u2 = -1;
        if (k >= 0) { if (k < 256) u0 = 256 * sl + k; if (k + nidle < 256) u1 = 256 * sl + k + nidle; }
        const int rest0 = 2 * nidle;
        if (rest0 + c < 256) u2 = 256 * sl + rest0 + c;
        if (u0 < 0) { u0 = u1; u1 = -1; } if (u0 < 0) { u0 = u2; u2 = -1; } if (u1 < 0) { u1 = u2; u2 = -1; }
    }
    DI bool next(int i, Unit& u) const {
        const int L = i == 0 ? u0 : i == 1 ? u1 : i == 2 ? u2 : -1; if (L < 0) return false;
        u.pm = L >> 2; u.pn = L & 3; u.ao = (unsigned)u.pm * (256u * 512u); u.bo = (unsigned)u.pn * (256u * 512u); u.g = 0; u.cnt = 256; u.arow = u.pm * 256; return true;
    }
    DI void issue_table(const Unit&, LAS unsigned char*) const {}
    DI unsigned row_off(const Unit&, LAS unsigned char*, int) const { return 0u; }
};

#define G_WAIT_V(n) asm volatile("s_waitcnt vmcnt(" #n ")" ::: "memory")
#define G_WAIT_L(n) asm volatile("s_waitcnt lgkmcnt(" #n ")" ::: "memory")
#define G_BAR __builtin_amdgcn_s_barrier()
#define G_SCHED __builtin_amdgcn_sched_barrier(0)

typedef int i32x8 __attribute__((ext_vector_type(8)));
typedef unsigned u32x8 __attribute__((ext_vector_type(8)));
template <bool OPQ, int EB, class Sched, class Epi>
DI void gemm_phase(LAS unsigned char* lds, const int K_  , const int lda_  , const Sched& S, const Epi& E) {
    int K = K_, lda = lda_; if constexpr (OPQ) asm volatile("" : "+s"(K), "+s"(lda));
    const int tid = threadIdx.x, wid = __builtin_amdgcn_readfirstlane(tid >> 6), lane = tid & 63, wr = wid >> 2, wc = wid & 3, fr = lane & 15, fq = lane >> 4;
    const int nt = K * EB / (BK * 2);
    unsigned vA[2][2], voffB[2]; int R0 = 0, C0 = 0;
#pragma unroll
    for (int i = 0; i < 2; ++i) { int R, C; stage_rc(tid * 16 + i * 8192, R, C); const int Rb = Epi::REMAP ? (64 * (R >> 5) + perm32(R & 31)) : Epi::PERM ? ((R & ~31) + perm32(R & 31)) : R;
        if (i == 0) { R0 = R; C0 = C; } voffB[i] = (unsigned)(Rb * K * EB + C * 2);
        vA[0][i] = (unsigned)(R * lda * EB + C * 2); vA[1][i] = (unsigned)((R + HALF) * lda * EB + C * 2); }
    const unsigned kstep = BK * 2;
    const unsigned hstepB = (unsigned)((Epi::REMAP ? 32 : HALF) * K * EB);
    const __amdgpu_buffer_rsrc_t rsA = __builtin_amdgcn_make_buffer_rsrc((void*)S.A, 0, 0x7ffffff0, 0x00020000), rsB = __builtin_amdgcn_make_buffer_rsrc((void*)S.B, 0, 0x7ffffff0, 0x00020000);
    const unsigned ldsw = (unsigned)wid * 1024u;
    const int aoff = lds_byte(wr * 64 + fr, fq * 8), boff = lds_byte(wc * 32 + fr, fq * 8);
#define G_SA(b, h) (((b) * 2 + (h)) * HTB)
#define G_SB(b, h) ((4 + (b) * 2 + (h)) * HTB)
#define G_STAGE(bufoff, rs, so, v0, v1) do { \
        __builtin_amdgcn_raw_ptr_buffer_load_lds(rs, (LAS void*)(lds + (bufoff) + ldsw), 16, (int)(v0), (int)(so), 0, 0); \
        __builtin_amdgcn_raw_ptr_buffer_load_lds(rs, (LAS void*)(lds + (bufoff) + ldsw + 8192), 16, (int)(v1), (int)(so), 0, 0); } while (0)
#define G_LD16(off) (*(const LAS u32x4*)(lds + (off)))
#define G_LDA(dst, b, h) do { _Pragma("unroll") for (int m = 0; m < 4; ++m) { if constexpr (EB == 2) { dst[m].pq[0] = G_LD16(G_SA(b, h) + aoff + m * 2048); dst[m].pq[1] = G_LD16(G_SA(b, h) + aoff + m * 2048 + 1024); } \
        else dst[m].w8 = __builtin_shufflevector(G_LD16(G_SA(b, h) + aoff + m * 2048), G_LD16(G_SA(b, h) + aoff + m * 2048 + 1024), 0, 1, 2, 3, 4, 5, 6, 7); } } while (0)
#define G_LDB(dst, b, h) do { _Pragma("unroll") for (int n = 0; n < 2; ++n) { if constexpr (EB == 2) { dst[n].pq[0] = G_LD16(G_SB(b, h) + boff + n * 2048); dst[n].pq[1] = G_LD16(G_SB(b, h) + boff + n * 2048 + 1024); } \
        else dst[n].w8 = __builtin_shufflevector(G_LD16(G_SB(b, h) + boff + n * 2048), G_LD16(G_SB(b, h) + boff + n * 2048 + 1024), 0, 1, 2, 3, 4, 5, 6, 7); } } while (0)
#define G_MMA(ai, bj, At, Bt) do { __builtin_amdgcn_s_setprio(1); _Pragma("unroll") for (int m = 0; m < 4; ++m) _Pragma("unroll") for (int n = 0; n < 2; ++n) { \
        if constexpr (EB == 2) { _Pragma("unroll") for (int k = 0; k < 2; ++k) acc[ai][bj][m][n] = __builtin_amdgcn_mfma_f32_16x16x32_bf16(__builtin_bit_cast(bf16x8, Bt[n].pq[k]), __builtin_bit_cast(bf16x8, At[m].pq[k]), acc[ai][bj][m][n], 0, 0, 0); } \
        else acc[ai][bj][m][n] = __builtin_amdgcn_mfma_scale_f32_16x16x128_f8f6f4(__builtin_bit_cast(i32x8, Bt[n].w8), __builtin_bit_cast(i32x8, At[m].w8), acc[ai][bj][m][n], 0, 0, 0, 0, 0, 0); } \
        __builtin_amdgcn_s_setprio(0); } while (0)
    Unit cur, nxt; int ui = 0;
    if (!S.next(0, cur)) return;
#ifndef GEMM_STAGGER_TICKS
#define GEMM_STAGGER_TICKS 0
#endif
    if (GEMM_STAGGER_TICKS > 0) {
        const unsigned long long t0 = __builtin_amdgcn_s_memrealtime(), wait = (unsigned long long)((blockIdx.x >> 3) & 3) * GEMM_STAGGER_TICKS;
        while (__builtin_amdgcn_s_memrealtime() - t0 < wait) __builtin_amdgcn_s_sleep(16);
    }
    AccT acc;
#pragma unroll
    for (int a = 0; a < 2; ++a)
#pragma unroll
        for (int b = 0; b < 2; ++b)
#pragma unroll
            for (int m = 0; m < 4; ++m)
#pragma unroll
                for (int n = 0; n < 2; ++n) { acc[a][b][m][n] = (f32x4){0.f, 0.f, 0.f, 0.f}; if constexpr (EB == 1) asm volatile("" : "+v"(acc[a][b][m][n])); }
    union Frag { u32x4 pq[2]; u32x8 w8; };
    Frag At[4], B0[2], B1[2];
    unsigned cA = cur.ao, cB = cur.bo;
    if constexpr (Sched::GATHER) {
        S.issue_table(cur, lds + LDS_TAB);
        G_WAIT_V(0); __syncthreads();
#pragma unroll
        for (int h = 0; h < 2; ++h)
#pragma unroll
            for (int i = 0; i < 2; ++i) { vA[h][i] = S.row_off(cur, lds + LDS_TAB, R0 + 64 * i + HALF * h) + (unsigned)C0 * 2u; }
    }
    G_STAGE(G_SB(0, 0), rsB, cB, voffB[0], voffB[1]); G_STAGE(G_SA(0, 0), rsA, cA, vA[0][0], vA[0][1]); G_STAGE(G_SB(0, 1), rsB, cB + hstepB, voffB[0], voffB[1]); G_STAGE(G_SA(0, 1), rsA, cA, vA[1][0], vA[1][1]);
    if (wr == 1) G_BAR;
    G_WAIT_V(4); G_BAR;
    G_STAGE(G_SB(1, 0), rsB, cB + kstep, voffB[0], voffB[1]); G_STAGE(G_SA(1, 0), rsA, cA + kstep, vA[0][0], vA[0][1]); G_STAGE(G_SB(1, 1), rsB, cB + hstepB + kstep, voffB[0], voffB[1]);
    G_WAIT_V(6); G_BAR;
    for (;;) {
        const bool has_next = S.next(ui + 1, nxt);
        const unsigned nA = has_next ? nxt.ao : cA, nB = has_next ? nxt.bo : cB;
        for (int t = 0; t < nt; t += 2) {
            const bool last = (t == nt - 2);
            const unsigned a1 = cA + (unsigned)(t + 1) * kstep;
            const unsigned a2 = last ? nA : cA + (unsigned)(t + 2) * kstep, b2 = last ? nB : cB + (unsigned)(t + 2) * kstep;
            const unsigned a3 = a2 + kstep, b3 = b2 + kstep;
            if constexpr (Sched::GATHER) {
                if (t == 0 && has_next) S.issue_table(nxt, lds + LDS_TAB + ((ui + 1) & 1) * 1024);
            }
            G_LDB(B0, 0, 0); G_SCHED; G_LDA(At, 0, 0); G_STAGE(G_SA(1, 1), rsA, a1, vA[1][0], vA[1][1]);
            if (last && has_next) {
                int tz = threadIdx.x; asm volatile("" : "+v"(tz)); int Rz, Cz; stage_rc(tz * 16, Rz, Cz);
#pragma unroll
                for (int h = 0; h < 2; ++h)
#pragma unroll
                    for (int i = 0; i < 2; ++i) {
                        if constexpr (Sched::GATHER) vA[h][i] = S.row_off(nxt, lds + LDS_TAB + ((ui + 1) & 1) * 1024, Rz + 64 * i + HALF * h) + (unsigned)Cz * 2u;
                        else vA[h][i] = (unsigned)((Rz + 64 * i + HALF * h) * lda * EB + Cz * 2);
                    }
            }
            G_WAIT_L(8); G_BAR; G_WAIT_L(0); G_MMA(0, 0, At, B0); G_BAR; G_SCHED;
            G_LDB(B1, 0, 1); G_STAGE(G_SB(0, 0), rsB, b2, voffB[0], voffB[1]);
            G_BAR; G_WAIT_L(0); G_MMA(0, 1, At, B1); G_BAR;
            G_LDA(At, 0, 1); G_STAGE(G_SA(0, 0), rsA, a2, vA[0][0], vA[0][1]);
            G_BAR; G_WAIT_L(0); G_MMA(1, 0, At, B0); G_BAR; G_SCHED;
            G_STAGE(G_SB(0, 1), rsB, b2 + hstepB, voffB[0], voffB[1]);
            G_WAIT_V(6); G_BAR; G_MMA(1, 1, At, B1); G_BAR;
            G_LDB(B0, 1, 0); G_SCHED; G_LDA(At, 1, 0); G_STAGE(G_SA(0, 1), rsA, a2, vA[1][0], vA[1][1]);
            G_WAIT_L(8); G_BAR; G_WAIT_L(0); G_MMA(0, 0, At, B0); G_BAR; G_SCHED;
            G_LDB(B1, 1, 1); G_STAGE(G_SB(1, 0), rsB, b3, voffB[0], voffB[1]);
            G_BAR; G_WAIT_L(0); G_MMA(0, 1, At, B1); G_BAR;
            G_LDA(At, 1, 1); G_STAGE(G_SA(1, 0), rsA, a3, vA[0][0], vA[0][1]);
            G_BAR; G_WAIT_L(0); G_MMA(1, 0, At, B0); G_BAR; G_SCHED;
            G_STAGE(G_SB(1, 1), rsB, b3 + hstepB, voffB[0], voffB[1]);
            G_WAIT_V(6); G_BAR; G_MMA(1, 1, At, B1); G_BAR;
        }
        { int tz = threadIdx.x; asm volatile("" : "+v"(tz)); const int wz = tz >> 6, lz = tz & 63; E(acc, cur, wz >> 2, wz & 3, lz & 15, lz >> 4); }
        if (!has_next) break;
#pragma unroll
        for (int a = 0; a < 2; ++a)
#pragma unroll
            for (int b = 0; b < 2; ++b)
#pragma unroll
                for (int m = 0; m < 4; ++m)
#pragma unroll
                    for (int n = 0; n < 2; ++n) { acc[a][b][m][n] = (f32x4){0.f, 0.f, 0.f, 0.f}; if constexpr (EB == 1) asm volatile("" : "+v"(acc[a][b][m][n])); }
        cur = nxt; cA = nA; cB = nB; ++ui;
    }
    G_WAIT_V(0);
    if (wr == 0) G_BAR;
    G_BAR;
}

struct EpiZ {
    static constexpr bool PERM = true, REMAP = true;
    bf16_t* Z; const float* gq; const float* gk;
    DI void operator()(const AccT& acc, const Unit& u, int wr, int wc, int fr, int fq) const {
        const int row0 = u.pm * BM + wr * 64 + fr, colw = u.pn * BM + wc * 64;
        if (colw >= IN_COLS) return;
        const bool isq = colw >= ZQ && colw < ZKK, isk = colw >= ZKK && colw < ZVV;
        float g[2][8];
        if (isq || isk) { const float* gp = (isq ? gq : gk) + 8 * fq; const float sc = isq ? 0.125f * LOG2E : 1.0f;
#pragma unroll
            for (int bj = 0; bj < 2; ++bj)
#pragma unroll
                for (int j = 0; j < 8; ++j) g[bj][j] = gp[32 * bj + j] * sc; }
#pragma unroll
        for (int ai = 0; ai < 2; ++ai)
#pragma unroll
            for (int m = 0; m < 4; ++m) { bf16_t* rowp = Z + (size_t)(row0 + ai * HALF + m * 16) * IN_COLS + colw + 8 * fq;
                float v[2][8];
#pragma unroll
                for (int bj = 0; bj < 2; ++bj)
#pragma unroll
                    for (int j = 0; j < 8; ++j) v[bj][j] = acc[ai][bj][m][j >> 2][j & 3];
                if (isq || isk) { float ss = 0.f;
#pragma unroll
                    for (int bj = 0; bj < 2; ++bj)
#pragma unroll
                        for (int j = 0; j < 8; ++j) ss += v[bj][j] * v[bj][j];
                    ss = xsum32(xsum16(ss));
                    const float rinv = __builtin_amdgcn_rsqf(ss * (1.f / 64.f) + NORM_EPS);
#pragma unroll
                    for (int bj = 0; bj < 2; ++bj)
#pragma unroll
                        for (int j = 0; j < 8; ++j) v[bj][j] *= rinv * g[bj][j]; }
#pragma unroll
                for (int bj = 0; bj < 2; ++bj) *(u32x4*)(rowp + 32 * bj) = (u32x4){cvt_pk(v[bj][0], v[bj][1]), cvt_pk(v[bj][2], v[bj][3]), cvt_pk(v[bj][4], v[bj][5]), cvt_pk(v[bj][6], v[bj][7])};
            }
    }
};
struct EpiNone {
    static constexpr bool PERM = true, REMAP = false;
    float* sink;
    DI void operator()(const AccT& acc, const Unit& u, int wr, int wc, int fr, int fq) const {
        float t = 0.f;
#pragma unroll
        for (int ai = 0; ai < 2; ++ai)
#pragma unroll
            for (int bj = 0; bj < 2; ++bj)
#pragma unroll
                for (int m = 0; m < 4; ++m)
#pragma unroll
                    for (int n = 0; n < 2; ++n) t += acc[ai][bj][m][n][0] + acc[ai][bj][m][n][1] + acc[ai][bj][m][n][2] + acc[ai][bj][m][n][3];
        if (t == 123456.789f) sink[0] = t;
    }
};
struct EpiH1 {
    static constexpr bool PERM = true, REMAP = true;
    const float* X; bf16_t* H;
    DI void operator()(const AccT& acc, const Unit& u, int wr, int wc, int fr, int fq) const {
        const int row0 = u.pm * BM + wr * 64 + fr, col0 = u.pn * BM + wc * 64 + 8 * fq;
#pragma unroll
        for (int ai = 0; ai < 2; ++ai)
#pragma unroll
            for (int m = 0; m < 4; ++m) { const size_t ro = (size_t)(row0 + ai * HALF + m * 16) * 1024 + col0;
#pragma unroll
                for (int bj = 0; bj < 2; ++bj) { const f32x4 x0 = *(const f32x4*)(X + ro + bj * 32), x1 = *(const f32x4*)(X + ro + bj * 32 + 4);
                    const f32x4 h0 = x0 + acc[ai][bj][m][0], h1 = x1 + acc[ai][bj][m][1];
                    *(u32x4*)(H + ro + bj * 32) = (u32x4){cvt_pk(h0[0], h0[1]), cvt_pk(h0[2], h0[3]), cvt_pk(h1[0], h1[1]), cvt_pk(h1[2], h1[3])}; } }
    }
};
struct EpiMoe1 {
    static constexpr bool PERM = true, REMAP = false;
    unsigned char* ACT; const float* b1;
    DI void operator()(const AccT& acc, const Unit& u, int wr, int wc, int fr, int fq) const {
        const int e = u.g & 31, cb = u.pn * 128 + wc * 32 + 8 * fq;
        const float* bg = b1 + (size_t)e * 2048 + cb; const float* bl = bg + 1024;
        const f32x4 bg0 = *(const f32x4*)bg, bg1 = *(const f32x4*)(bg + 4), bl0 = *(const f32x4*)bl, bl1 = *(const f32x4*)(bl + 4);
        constexpr float sc = 1.0f / (W8_SCALE * M8_SCALE);
#pragma unroll
        for (int ai = 0; ai < 2; ++ai) {
            unsigned pw_[4][2];
#pragma unroll
            for (int m = 0; m < 4; ++m) {
                float o[8];
#pragma unroll
                for (int n = 0; n < 2; ++n)
#pragma unroll
                    for (int pj = 0; pj < 2; ++pj) {
                        const f32x4 ag = acc[ai][0][m][n], al = acc[ai][1][m][n], bgv = n ? bg1 : bg0, blv = n ? bl1 : bl0;
                        f32x2 glu = (f32x2){ag[2 * pj], ag[2 * pj + 1]} * sc + (f32x2){bgv[2 * pj], bgv[2 * pj + 1]};
                        f32x2 lin = (f32x2){al[2 * pj], al[2 * pj + 1]} * sc + (f32x2){blv[2 * pj], blv[2 * pj + 1]};
                        glu = (f32x2){fminf(glu[0], 7.0f), fminf(glu[1], 7.0f)}; lin = (f32x2){fminf(fmaxf(lin[0], -7.0f), 7.0f), fminf(fmaxf(lin[1], -7.0f), 7.0f)};
                        const f32x2 ex = glu * (-1.702f * LOG2E);
                        const f32x2 den = (f32x2){__builtin_amdgcn_exp2f(ex[0]), __builtin_amdgcn_exp2f(ex[1])} + 1.0f;
                        const f32x2 sg = {__builtin_amdgcn_rcpf(den[0]), __builtin_amdgcn_rcpf(den[1])};
                        const f32x2 r = (glu * sg) * (lin * A8_SCALE + A8_SCALE);
                        o[n * 4 + 2 * pj] = r[0]; o[n * 4 + 2 * pj + 1] = r[1];
                    }
                pw_[m][0] = pk4_fp8(o[0], o[1], o[2], o[3]); pw_[m][1] = pk4_fp8(o[4], o[5], o[6], o[7]);
            }
#pragma unroll
            for (int mp = 0; mp < 4; mp += 2) {
                auto s0 = __builtin_amdgcn_permlane16_swap(pw_[mp][0], pw_[mp + 1][0], false, false);
                auto s1 = __builtin_amdgcn_permlane16_swap(pw_[mp][1], pw_[mp + 1][1], false, false);
                const int rl = ai * HALF + wr * 64 + (mp + (fq & 1)) * 16 + fr;
                *(u32x4*)(ACT + (size_t)(u.arow + rl) * 1024 + u.pn * 128 + wc * 32 + (fq >> 1) * 16) = (u32x4){(unsigned)s0[0], (unsigned)s1[0], (unsigned)s0[1], (unsigned)s1[1]};
            }
        }
    }
};
struct EpiMoe2 {
    static constexpr bool PERM = true, REMAP = true;
    unsigned char* Y8;
    DI void operator()(const AccT& acc, const Unit& u, int wr, int wc, int fr, int fq) const {
        const int col0 = u.pn * BM + wc * 64 + (fq & 1) * 32 + (fq >> 1) * 16;
        constexpr float sc = Y8_SCALE / (W8_SCALE * A8_SCALE);
#pragma unroll
        for (int ai = 0; ai < 2; ++ai)
#pragma unroll
            for (int m = 0; m < 4; ++m) {
                unsigned char* yp = Y8 + (size_t)(u.arow + ai * HALF + wr * 64 + m * 16 + fr) * 1024 + col0;
                unsigned w[2][2];
#pragma unroll
                for (int bj = 0; bj < 2; ++bj) { const f32x4 a0 = acc[ai][bj][m][0] * sc, a1 = acc[ai][bj][m][1] * sc; w[bj][0] = pk4_fp8(a0[0], a0[1], a0[2], a0[3]); w[bj][1] = pk4_fp8(a1[0], a1[1], a1[2], a1[3]); }
                auto s0 = __builtin_amdgcn_permlane16_swap(w[0][0], w[1][0], false, false);
                auto s1 = __builtin_amdgcn_permlane16_swap(w[0][1], w[1][1], false, false);
                *(u32x4*)yp = (u32x4){(unsigned)s0[0], (unsigned)s1[0], (unsigned)s0[1], (unsigned)s1[1]};
            }
    }
};
struct EpiPle {
    static constexpr bool PERM = true, REMAP = true;
    bf16_t* EB; float* ESS;
    DI void operator()(const AccT& acc, const Unit& u, int wr, int wc, int fr, int fq) const {
        const int row0 = u.pm * BM + wr * 64 + fr, col0 = u.pn * BM + wc * 64 + 8 * fq;
#pragma unroll
        for (int ai = 0; ai < 2; ++ai)
#pragma unroll
            for (int m = 0; m < 4; ++m) { const int row = row0 + ai * HALF + m * 16; bf16_t* rowp = EB + (size_t)row * 1024 + col0; float ss = 0.f;
#pragma unroll
                for (int bj = 0; bj < 2; ++bj) { const f32x4 v0 = acc[ai][bj][m][0], v1 = acc[ai][bj][m][1];
                    ss += v0[0] * v0[0] + v0[1] * v0[1] + v0[2] * v0[2] + v0[3] * v0[3] + v1[0] * v1[0] + v1[1] * v1[1] + v1[2] * v1[2] + v1[3] * v1[3];
                    u32x4 o = {cvt_pk(v0[0], v0[1]), cvt_pk(v0[2], v0[3]), cvt_pk(v1[0], v1[1]), cvt_pk(v1[2], v1[3])}; *(u32x4*)(rowp + bj * 32) = o; }
                ss = xsum32(xsum16(ss));
                if (fq == 0) atomicAdd(ESS + row, ss);
            }
    }
};
struct EpiFinal {
    static constexpr bool PERM = true, REMAP = true;
    float* OUT; const bf16_t* HB; const bf16_t* EB; const float* ESS; const float* g;
    DI void operator()(const AccT& acc, const Unit& u, int wr, int wc, int fr, int fq) const {
        const int row0 = u.pm * BM + wr * 64 + fr, col0 = u.pn * BM + wc * 64 + 8 * fq;
        constexpr float gsc = 1.0f / (W8_SCALE * M8_SCALE);
        f32x4 gv[2][2];
#pragma unroll
        for (int bj = 0; bj < 2; ++bj)
#pragma unroll
            for (int n = 0; n < 2; ++n) gv[bj][n] = *(const f32x4*)(g + col0 + bj * 32 + n * 4);
#pragma unroll
        for (int ai = 0; ai < 2; ++ai)
#pragma unroll
            for (int m = 0; m < 4; ++m) { const int row = row0 + ai * HALF + m * 16; const size_t ro = (size_t)row * 1024 + col0;
                const float rinv = __builtin_amdgcn_rsqf(ESS[row] * (1.f / 1024.f) + NORM_EPS);
#pragma unroll
                for (int bj = 0; bj < 2; ++bj) {
                    const size_t o = ro + bj * 32;
                    const u32x4 eb = *(const u32x4*)(EB + o), hb = *(const u32x4*)(HB + o);
#pragma unroll
                    for (int n = 0; n < 2; ++n) { const f32x4 a = acc[ai][bj][m][n], rg = gv[bj][n] * rinv; f32x4 r;
#pragma unroll
                        for (int pj = 0; pj < 2; ++pj) {
                            const unsigned ew = eb[2 * n + pj], hw = hb[2 * n + pj];
                            const f32x2 ex = (f32x2){a[2 * pj], a[2 * pj + 1]} * (-gsc * LOG2E);
                            const f32x2 den = (f32x2){__builtin_amdgcn_exp2f(ex[0]), __builtin_amdgcn_exp2f(ex[1])} + 1.0f;
                            const f32x2 sg = {__builtin_amdgcn_rcpf(den[0]), __builtin_amdgcn_rcpf(den[1])};
                            const f32x2 v = ((f32x2){bf_lo(ew), bf_hi(ew)} * (f32x2){rg[2 * pj], rg[2 * pj + 1]}) * sg + (f32x2){bf_lo(hw), bf_hi(hw)};
                            r[2 * pj] = v[0]; r[2 * pj + 1] = v[1];
                        }
                        *(f32x4*)(OUT + o + n * 4) = r; }
                }
            }
    }
};

DI void moe_tables(LAS unsigned char* lds, const unsigned* cnt_g) {
    LAS int* cntL = (LAS int*)(lds + LDS_GRP); LAS int* pre = cntL + 128;
    __syncthreads();
    if (threadIdx.x < 128) cntL[threadIdx.x] = (int)cnt_g[threadIdx.x];
    __syncthreads();
    if (threadIdx.x == 0) { int s = 0; for (int g = 0; g < 128; ++g) { pre[g] = s; s += (cntL[g] + 255) >> 8; } pre[128] = s; }
    __syncthreads();
}
template <int NT, bool GATHER_, int EB>
struct MoeOrder {
    static constexpr bool GATHER = GATHER_;
    const char* A; const char* B; size_t bexp; int g0, ng, G, c; LAS unsigned char* lds; const int* list;
    DI bool next(int i, Unit& u) const {
        LAS int* cntL = (LAS int*)(lds + LDS_GRP); LAS int* pre = cntL + 128;
        const int base = __builtin_amdgcn_readfirstlane(pre[g0]), tot = __builtin_amdgcn_readfirstlane(pre[g0 + ng]) - base;
        int rbg, pn_;
        if (G == 256) { const int x = c & 7, q = c >> 3;
            if (NT == 8) { rbg = i * 32 + (x >> 1) * 8 + (q >> 2); pn_ = (x & 1) * 4 + (q & 3); }
            else { rbg = i * 64 + x * 8 + (q >> 2); pn_ = q & 3; } }
        else { const int L = i * G + c; rbg = L / NT; pn_ = L % NT; }
        if (rbg >= tot) return false;
        const int ra = rbg + base; int lo = g0, hi = g0 + ng;
        while (hi - lo > 1) { const int mid = (lo + hi) >> 1; const int pm_ = __builtin_amdgcn_readfirstlane(pre[mid]); if (pm_ <= ra) lo = mid; else hi = mid; }
        const int g = lo, pg = __builtin_amdgcn_readfirstlane(pre[g]), rb = ra - pg, cg = __builtin_amdgcn_readfirstlane(cntL[g]);
        u.g = g; u.pm = rb; u.pn = pn_; u.cnt = (cg - rb * 256) < 256 ? (cg - rb * 256) : 256; u.arow = ra * 256;
        u.ao = GATHER ? 0u : (unsigned)u.arow * (1024u * EB); u.bo = (unsigned)((size_t)(g & 31) * bexp) + (unsigned)u.pn * (256u * 1024u * EB);
        return true;
    }
    DI void issue_table(const Unit& u, LAS unsigned char* tab) const {
        if (threadIdx.x < 256) { const int wid = __builtin_amdgcn_readfirstlane(threadIdx.x >> 6);
            __builtin_amdgcn_global_load_lds((const unsigned*)(list + (size_t)u.g * 262144 + (size_t)u.pm * 256 + threadIdx.x), (LAS unsigned*)(tab + wid * 256), 4, 0, 0); }
    }
    DI unsigned row_off(const Unit& u, LAS unsigned char* tab, int r) const { const unsigned t = *(const LAS unsigned*)(tab + r * 4); return (r < u.cnt) ? t * (1024u * EB) : 0u; }
};

DI void phase_qknorm(const Params& P) {
    bf16_t* Z = (bf16_t*)(P.ws + WS_Z);
    {
        bf16_t* XL = (bf16_t*)(P.ws + WS_XL);
        for (int it = blockIdx.x * 512 + threadIdx.x; it < (MTOK / 16) * 48; it += gridDim.x * 512) {
            const int chunk = it / 48, cg = it - chunk * 48, tok0 = chunk * 16, t0 = tok0 & (SEQ - 1), col = ZWD + cg * 8;
            const bf16_t* zp = Z + (size_t)tok0 * IN_COLS + col;
            const f32x4 mu0 = *(const f32x4*)(P.rw_mu + col), mu1 = *(const f32x4*)(P.rw_mu + col + 4);
            u32x4 vp = {0u, 0u, 0u, 0u}; if (t0 > 0) vp = *(const u32x4*)(zp - IN_COLS);
            u32x4 vc = *(const u32x4*)zp;
#pragma unroll 4
            for (int i = 0; i < 16; ++i) {
                u32x4 vn = {0u, 0u, 0u, 0u}; if (t0 + i < SEQ - 1) vn = *(const u32x4*)(zp + (size_t)(i + 1) * IN_COLS);
                float f[8];
#pragma unroll
                for (int q = 0; q < 4; ++q) {
                    const float c0 = bf_lo(vc[q]), c1 = bf_hi(vc[q]);
                    const float m0 = q < 2 ? mu0[2 * q] : mu1[2 * q - 4], m1 = q < 2 ? mu0[2 * q + 1] : mu1[2 * q - 3];
                    f[2 * q] = c0 + (0.5f * (bf_lo(vp[q]) + bf_lo(vn[q])) - c0) * m0; f[2 * q + 1] = c1 + (0.5f * (bf_hi(vp[q]) + bf_hi(vn[q])) - c1) * m1;
                }
                if (cg < 16) {
#pragma unroll
                    for (int q = 0; q < 8; ++q) { const float e = __builtin_amdgcn_exp2f(f[q] * (2.0f * LOG2E)); f[q] = 1.0f - 2.0f * __builtin_amdgcn_rcpf(e + 1.0f); }
                } else if (cg >= 32) {
#pragma unroll
                    for (int q = 0; q < 8; ++q) f[q] = sigmoidf_(f[q]);
                }
                u32x4 ov = {cvt_pk(f[0], f[1]), cvt_pk(f[2], f[3]), cvt_pk(f[4], f[5]), cvt_pk(f[6], f[7])};
                *(u32x4*)(XL + (size_t)(tok0 + i) * 384 + cg * 8) = ov;
                vp = vc; vc = vn;
            }
        }
    }
}

constexpr int LDS_RT_SEL = STAGE_BYTES;
DI float row_max16(float v) { v = fmaxf(v, dpp_mov0<0x121, 0xF>(v)); v = fmaxf(v, dpp_mov0<0x122, 0xF>(v)); v = fmaxf(v, dpp_mov0<0x124, 0xF>(v)); v = fmaxf(v, dpp_mov0<0x128, 0xF>(v)); return v; }
template <int CTRL> DI int dpp_movi(int v) { return __builtin_amdgcn_update_dpp(0, v, CTRL, 0xF, 0xF, false); }
DI int row_min16(int v) { v = min(v, dpp_movi<0x121>(v)); v = min(v, dpp_movi<0x122>(v)); v = min(v, dpp_movi<0x124>(v)); v = min(v, dpp_movi<0x128>(v)); return v; }
DI void phase_route(const Params& P, LAS unsigned char* lds) {
    LAS int* sel_e = (LAS int*)(lds + LDS_RT_SEL); LAS float* sel_g = (LAS float*)(sel_e + 1024); LAS int* lpos = (LAS int*)(sel_g + 1024);
    LAS int* lcnt = lpos + 1024; LAS int* lbase = lcnt + 128;
    const int tid = threadIdx.x, wid = tid >> 6, lane = tid & 63, n16 = lane & 15, q4 = lane >> 4;
    const bf16_t* H = (const bf16_t*)P.out; unsigned char* Mb = P.ws + WS_U;
    int* tokpos = (int*)(P.ws + WS_TOKPOS);
    unsigned* cnt_g = (unsigned*)(P.ws + WS_CTL) + CW_CNT; int* list = (int*)(P.ws + WS_LIST); float* gate = (float*)(P.ws + WS_GATE);
    __syncthreads();
    for (int it = tid; it < 64 * 64; it += 512) { const int ln = it & 63, f2 = it >> 6, ks = f2 >> 1, nt = f2 & 1, n = ln & 15, kq = ln >> 4; const int k0 = ks * 32 + kq * 8, e = nt * 16 + n;
        float hi[8], lo[8];
#pragma unroll
        for (int i = 0; i < 8; ++i) { const float v = P.norm_ffn_g[k0 + i] * P.w_router[(size_t)(k0 + i) * 32 + e]; const float h = bf2f(f2bf(v)); hi[i] = h; lo[i] = v - h; }
        *(LAS bf16x8*)(lds + (size_t)(f2 * 2) * 1024 + ln * 16) = pack8(hi[0], hi[1], hi[2], hi[3], hi[4], hi[5], hi[6], hi[7]);
        *(LAS bf16x8*)(lds + (size_t)(f2 * 2 + 1) * 1024 + ln * 16) = pack8(lo[0], lo[1], lo[2], lo[3], lo[4], lo[5], lo[6], lo[7]);
    }
    __syncthreads();
    f32x4 g[4];
#pragma unroll
    for (int i = 0; i < 4; ++i) g[i] = *(const f32x4*)(P.norm_ffn_g + 4 * lane + 256 * i);
    const float br0 = P.b_router[n16], br1 = P.b_router[16 + n16];
    for (int blk = blockIdx.x; blk < MTOK / 256; blk += gridDim.x) {
        if (tid < 128) lcnt[tid] = 0;
        {
            const bf16_t* hr0 = H + (size_t)(blk * 256 + wid * 32) * 1024 + 4 * lane;
            u32x2 hn[4];
#pragma unroll
            for (int i = 0; i < 4; ++i) hn[i] = *(const u32x2*)(hr0 + 256 * i);
            for (int rp = 0; rp < 32; ++rp) {
                const int row = blk * 256 + wid * 32 + rp; float ss = 0.f; f32x4 v[4];
#pragma unroll
                for (int i = 0; i < 4; ++i) { const u32x2 hb_ = hn[i]; v[i] = (f32x4){bf_lo(hb_[0]), bf_hi(hb_[0]), bf_lo(hb_[1]), bf_hi(hb_[1])}; ss += v[i][0] * v[i][0] + v[i][1] * v[i][1] + v[i][2] * v[i][2] + v[i][3] * v[i][3]; }
                if (rp + 1 < 32) {
#pragma unroll
                    for (int i = 0; i < 4; ++i) hn[i] = *(const u32x2*)(hr0 + (size_t)(rp + 1) * 1024 + 256 * i);
                }
                ss = wave_sum(ss);
                const float rinv = __builtin_amdgcn_rsqf(ss * (1.f / 1024.f) + NORM_EPS);
#pragma unroll
                for (int i = 0; i < 4; ++i) { const f32x4 mv = v[i] * rinv * g[i];
                    *(unsigned*)(Mb + (size_t)row * 1024 + 4 * lane + 256 * i) = pk4_fp8(mv[0] * M8_SCALE, mv[1] * M8_SCALE, mv[2] * M8_SCALE, mv[3] * M8_SCALE); }
            }
        }
#pragma unroll 1
        for (int rg = 0; rg < 2; ++rg) {
            const int rb = wid * 32 + rg * 16;
            const bf16_t* hp = H + (size_t)(blk * 256 + rb + n16) * 1024 + q4 * 8;
            const LAS bf16x8* wf = (const LAS bf16x8*)lds + lane;
            f32x4 a0h = {0.f, 0.f, 0.f, 0.f}, a0l = a0h, a1h = a0h, a1l = a0h;
            float ssq = 0.f;
#pragma unroll 8
            for (int ks = 0; ks < 32; ++ks) { const bf16x8 a = *(const bf16x8*)(hp + ks * 32);
                { const u32x4 aw = __builtin_bit_cast(u32x4, a);
#pragma unroll
                  for (int i = 0; i < 4; ++i) { const float x0 = bf_lo(aw[i]), x1 = bf_hi(aw[i]); ssq += x0 * x0 + x1 * x1; } }
                a0h = __builtin_amdgcn_mfma_f32_16x16x32_bf16(a, wf[(ks * 4 + 0) * 64], a0h, 0, 0, 0); a0l = __builtin_amdgcn_mfma_f32_16x16x32_bf16(a, wf[(ks * 4 + 1) * 64], a0l, 0, 0, 0);
                a1h = __builtin_amdgcn_mfma_f32_16x16x32_bf16(a, wf[(ks * 4 + 2) * 64], a1h, 0, 0, 0); a1l = __builtin_amdgcn_mfma_f32_16x16x32_bf16(a, wf[(ks * 4 + 3) * 64], a1l, 0, 0, 0); }
            ssq = xsum32(xsum16(ssq));
            const float rmine = __builtin_amdgcn_rsqf(ssq * (1.f / 1024.f) + NORM_EPS);
            f32x4 ri;
#pragma unroll
            for (int j = 0; j < 4; ++j) ri[j] = __shfl(rmine, q4 * 4 + j);
#pragma unroll
            for (int j = 0; j < 4; ++j) {
                float v0 = (a0h[j] + a0l[j]) * ri[j] + br0, v1 = (a1h[j] + a1l[j]) * ri[j] + br1;
                float tv[4]; int te[4];
#pragma unroll
                for (int k = 0; k < 4; ++k) {
                    const float mx = row_max16(fmaxf(v0, v1));
                    int ce = (v0 == mx) ? n16 : (v1 == mx) ? 16 + n16 : 99;
                    ce = row_min16(ce) & 31;
                    tv[k] = mx; te[k] = ce; if (ce == n16) v0 = -3.0e38f; if (ce == 16 + n16) v1 = -3.0e38f;
                }
                const float e1 = __expf(tv[1] - tv[0]), e2 = __expf(tv[2] - tv[0]), e3 = __expf(tv[3] - tv[0]); const float inv = 1.f / (1.f + e1 + e2 + e3);
                if (n16 == 0) { const int r = rb + q4 * 4 + j; sel_e[r * 4 + 0] = te[0]; sel_e[r * 4 + 1] = te[1]; sel_e[r * 4 + 2] = te[2]; sel_e[r * 4 + 3] = te[3];
                    sel_g[r * 4 + 0] = inv; sel_g[r * 4 + 1] = e1 * inv; sel_g[r * 4 + 2] = e2 * inv; sel_g[r * 4 + 3] = e3 * inv; }
            }
        }
        __syncthreads();
        if (tid < 256) {
#pragma unroll
            for (int s = 0; s < 4; ++s) lpos[tid * 4 + s] = atomicAdd((int*)&lcnt[sel_e[tid * 4 + s]], 1);
        }
        __syncthreads();
        if (tid < 128) lbase[tid] = (int)atomicAdd(cnt_g + tid, (unsigned)lcnt[tid]);
        __syncthreads();
        if (tid < 256) { const int tok = blk * 256 + tid;
#pragma unroll
            for (int s = 0; s < 4; ++s) { const int gi = sel_e[tid * 4 + s]; const int pos = lbase[gi] + lpos[tid * 4 + s]; list[(size_t)gi * 262144 + pos] = tok; gate[(size_t)tok * 4 + s] = sel_g[tid * 4 + s]; tokpos[(size_t)tok * 4 + s] = (gi << 20) | pos; }
        }
        __syncthreads();
    }
}

DI void phase_combine(const Params& P, LAS unsigned char* lds) {
    moe_tables(lds, (const unsigned*)(P.ws + WS_CTL) + CW_CNT);
    const LAS int* pre = (const LAS int*)(lds + LDS_GRP) + 128;
    const int wid = __builtin_amdgcn_readfirstlane(threadIdx.x >> 6), lane = threadIdx.x & 63;
    const bf16_t* H = (const bf16_t*)P.out; bf16_t* HB = (bf16_t*)(P.ws + WS_HB); const unsigned char* Y8 = P.ws + WS_Y8; unsigned char* H8 = P.ws + WS_W2;
    const int* tokpos = (const int*)(P.ws + WS_TOKPOS); const float* gate = (const float*)(P.ws + WS_GATE);
    for (int i = threadIdx.x; i < N_EXP * 1024 / 4; i += 512) ((LAS f32x4*)lds)[i] = ((const f32x4*)P.b2)[i];
    __syncthreads();
    const int tstep = gridDim.x * 8; int tok = blockIdx.x * 8 + wid;
    u32x4 hb0 = {0u, 0u, 0u, 0u}, hb1 = hb0; int4 tp = {0, 0, 0, 0}; f32x4 gt = {0.f, 0.f, 0.f, 0.f};
    if (tok < MTOK) { hb0 = *(const u32x4*)(H + (size_t)tok * 1024 + 16 * lane); hb1 = *(const u32x4*)(H + (size_t)tok * 1024 + 16 * lane + 8); tp = *(const int4*)(tokpos + (size_t)tok * 4); gt = *(const f32x4*)(gate + (size_t)tok * 4); }
    for (; tok < MTOK; tok += tstep) {
        float h[16];
#pragma unroll
        for (int q = 0; q < 4; ++q) { h[2 * q] = bf_lo(hb0[q]); h[2 * q + 1] = bf_hi(hb0[q]); h[8 + 2 * q] = bf_lo(hb1[q]); h[8 + 2 * q + 1] = bf_hi(hb1[q]); }
        const int tpv[4] = {tp.x, tp.y, tp.z, tp.w}; const f32x4 gc = gt;
        u32x4 yv[4];
#pragma unroll
        for (int s = 0; s < 4; ++s) { const int g = tpv[s] >> 20, pos = tpv[s] & 0xfffff; const size_t prow = (size_t)pre[g] * 256 + pos; yv[s] = *(const u32x4*)(Y8 + prow * 1024 + 16 * lane); }
        const int tn = tok + tstep;
        if (tn < MTOK) { hb0 = *(const u32x4*)(H + (size_t)tn * 1024 + 16 * lane); hb1 = *(const u32x4*)(H + (size_t)tn * 1024 + 16 * lane + 8); tp = *(const int4*)(tokpos + (size_t)tn * 4); gt = *(const f32x4*)(gate + (size_t)tn * 4); }
#pragma unroll
        for (int s = 0; s < 4; ++s) {
            const int e = (tpv[s] >> 20) & 31; const float gs = gc[s], ys = gs * (1.0f / Y8_SCALE);
            const LAS f32x4* bl = (const LAS f32x4*)(lds + (size_t)e * 4096 + lane * 64);
#pragma unroll
            for (int q = 0; q < 4; ++q) { const f32x4 bv = bl[q]; const f32x2 lo = __builtin_amdgcn_cvt_pk_f32_fp8((int)yv[s][q], false), hi = __builtin_amdgcn_cvt_pk_f32_fp8((int)yv[s][q], true);
                h[4 * q + 0] += ys * lo[0] + gs * bv[0]; h[4 * q + 1] += ys * lo[1] + gs * bv[1]; h[4 * q + 2] += ys * hi[0] + gs * bv[2]; h[4 * q + 3] += ys * hi[1] + gs * bv[3]; }
        }
        *(u32x4*)(HB + (size_t)tok * 1024 + 16 * lane) = (u32x4){cvt_pk(h[0], h[1]), cvt_pk(h[2], h[3]), cvt_pk(h[4], h[5]), cvt_pk(h[6], h[7])};
        *(u32x4*)(HB + (size_t)tok * 1024 + 16 * lane + 8) = (u32x4){cvt_pk(h[8], h[9]), cvt_pk(h[10], h[11]), cvt_pk(h[12], h[13]), cvt_pk(h[14], h[15])};
        *(u32x4*)(H8 + (size_t)tok * 1024 + 16 * lane) = (u32x4){pk4_fp8(h[0] * M8_SCALE, h[1] * M8_SCALE, h[2] * M8_SCALE, h[3] * M8_SCALE), pk4_fp8(h[4] * M8_SCALE, h[5] * M8_SCALE, h[6] * M8_SCALE, h[7] * M8_SCALE),
                                                                pk4_fp8(h[8] * M8_SCALE, h[9] * M8_SCALE, h[10] * M8_SCALE, h[11] * M8_SCALE), pk4_fp8(h[12] * M8_SCALE, h[13] * M8_SCALE, h[14] * M8_SCALE, h[15] * M8_SCALE)};
    }
    __syncthreads();
}

constexpr int AT_V = 0, AT_WS = 98304;
#define KSWZ(row, colB) ((row) * 256 + ((colB) ^ (((row) & 7) << 4)))
DI int crow(int r, int hi) { return (r & 3) + 8 * (r >> 2) + 4 * hi; }
DI int v_st(int k, int c) { const int kk = (k & ~0xC) | ((k & 4) << 1) | ((k & 8) >> 1); return ((kk >> 3) * 4 + (c >> 5)) * 512 + ((kk & 7) * 32 + (c & 31)) * 2; }
DI int v_rd_base(int lane) { return ((lane & 3) << 3) | (((lane >> 2) & 3) << 6) | (((lane >> 4) & 1) << 5) | (((lane >> 5) & 1) << 8); }
constexpr int v_rd_off(int d0, int ks, int half) { return d0 * 512 + ks * 4096 + half * 2048; }
template <int OFF> DI s16x4 tr_read(int vb) { s16x4 r; asm volatile("ds_read_b64_tr_b16 %0, %1 offset:%2" : "=&v"(r) : "v"(vb), "i"(OFF) : "memory"); return r; }
#define AT_PK(L, H) (bf16x8){L[0], L[1], L[2], L[3], H[0], H[1], H[2], H[3]}
template <int D0> DI void pv_one(f32x16& od, int vb, bf16x8 pa0, bf16x8 pa1, bf16x8 pa2, bf16x8 pa3) {
    const s16x4 l0 = tr_read<v_rd_off(D0, 0, 0)>(vb), h0 = tr_read<v_rd_off(D0, 0, 1)>(vb), l1 = tr_read<v_rd_off(D0, 1, 0)>(vb), h1 = tr_read<v_rd_off(D0, 1, 1)>(vb);
    const s16x4 l2 = tr_read<v_rd_off(D0, 2, 0)>(vb), h2 = tr_read<v_rd_off(D0, 2, 1)>(vb), l3 = tr_read<v_rd_off(D0, 3, 0)>(vb), h3 = tr_read<v_rd_off(D0, 3, 1)>(vb);
    asm volatile("s_waitcnt lgkmcnt(0)" ::: "memory"); __builtin_amdgcn_sched_barrier(0);
    od = __builtin_amdgcn_mfma_f32_32x32x16_bf16(pa0, AT_PK(l0, h0), od, 0, 0, 0);
    od = __builtin_amdgcn_mfma_f32_32x32x16_bf16(pa1, AT_PK(l1, h1), od, 0, 0, 0);
    od = __builtin_amdgcn_mfma_f32_32x32x16_bf16(pa2, AT_PK(l2, h2), od, 0, 0, 0);
    od = __builtin_amdgcn_mfma_f32_32x32x16_bf16(pa3, AT_PK(l3, h3), od, 0, 0, 0);
}
DI void at_softmax(f32x16& p0, f32x16& p1, f32x2& la, f32x2& lb, bf16x8& pa0, bf16x8& pa1, bf16x8& pa2, bf16x8& pa3) {
#pragma unroll
    for (int r = 0; r < 16; ++r) { p0[r] = __builtin_amdgcn_exp2f(p0[r]); p1[r] = __builtin_amdgcn_exp2f(p1[r]); }
#pragma unroll
    for (int r = 0; r < 8; ++r) { la += (f32x2){p0[2 * r], p0[2 * r + 1]}; lb += (f32x2){p1[2 * r], p1[2 * r + 1]}; }
#define AT_PK4(Pv, BASE, OUT) do { unsigned a0 = cvt_pk(Pv[BASE + 0], Pv[BASE + 1]), a1 = cvt_pk(Pv[BASE + 2], Pv[BASE + 3]); \
    unsigned b0 = cvt_pk(Pv[BASE + 4], Pv[BASE + 5]), b1 = cvt_pk(Pv[BASE + 6], Pv[BASE + 7]); \
    auto r0 = __builtin_amdgcn_permlane32_swap(a0, b0, false, false); auto r1 = __builtin_amdgcn_permlane32_swap(a1, b1, false, false); \
    u32x4 w = {r0[0], r1[0], r0[1], r1[1]}; OUT = __builtin_bit_cast(bf16x8, w); } while (0)
    AT_PK4(p0, 0, pa0); AT_PK4(p0, 8, pa1); AT_PK4(p1, 0, pa2); AT_PK4(p1, 8, pa3);
#undef AT_PK4
}

DI void at_bias(f32x16& p0, f32x16& p1, float x, float slope2, float smax2, int side  ) {
    if (side != 0) {
        const float ss = (float)side * slope2, base = fmaf(-ss, x, -smax2);
#pragma unroll
        for (int r = 0; r < 16; ++r) { const float c0 = (float)((r & 3) + 8 * (r >> 2)); p0[r] = fmaf(ss, c0, base); p1[r] = fmaf(ss, c0 + 32.f, base); }
    } else {
#pragma unroll
        for (int r = 0; r < 16; ++r) { const float c0 = (float)((r & 3) + 8 * (r >> 2)); p0[r] = fmaf(fabsf(x - c0), -slope2, -smax2); p1[r] = fmaf(fabsf(x - (c0 + 32.f)), -slope2, -smax2); }
    }
}
DI void attn_unit(const Params& P, unsigned char* lds, int b, int h, int qb, float lam, float smax2, int W) {
    int tid_ = threadIdx.x; asm volatile("" : "+v"(tid_));
    const int tid = tid_, wid = __builtin_amdgcn_readfirstlane(tid >> 6), lane = tid & 63, r32 = lane & 31, hi = lane >> 5, grp = wid >> 1, c = wid & 1;
    const bf16_t* Zb = (const bf16_t*)(P.ws + WS_Z) + (size_t)b * SEQ * IN_COLS;
    LAS unsigned char* L3 = (LAS unsigned char*)lds;
    const int i0 = qb * 128, qbase = i0 + grp * 32, qi = qbase + r32;
    const float slope2 = exp2f(-2.0f * (float)(h + 1)) * LOG2E;
    bf16x8 qr[4];
    { const bf16_t* qp = Zb + (size_t)qi * IN_COLS + ZQ + h * 128 + c * 64 + hi * 8;
#pragma unroll
      for (int d0 = 0; d0 < 4; ++d0) qr[d0] = *(const bf16x8*)(qp + d0 * 16); }
    const __amdgpu_buffer_rsrc_t rsZ = __builtin_amdgcn_make_buffer_rsrc((void*)Zb, 0, 0x7ffffff0, 0x00020000);
    unsigned voK[2], voV[2];
#pragma unroll
    for (int i = 0; i < 2; ++i) {
        const int u = tid + 512 * i;
        const int krow = u >> 4, kch = (u & 15) ^ (krow & 7);
        voK[i] = (unsigned)((krow * IN_COLS + ZKK + h * 128 + kch * 8) * 2);
        const int sub = u >> 5, kkl = (u >> 2) & 7, cq = u & 3, kk = (sub >> 2) * 8 + kkl, vkey = (kk & ~0xC) | ((kk & 4) << 1) | ((kk & 8) >> 1), vc = (sub & 3) * 32 + cq * 8;
        voV[i] = (unsigned)((vkey * IN_COLS + ZVV + h * 128 + vc) * 2);
    }
    const int vb0 = (int)(uintptr_t)(lds + AT_V) + v_rd_base(lane);
    f32x16 o[4];
#pragma unroll
    for (int d = 0; d < 4; ++d)
#pragma unroll
        for (int r = 0; r < 16; ++r) o[d][r] = 0.f;
    f32x2 la2 = {0.f, 0.f}, lb2 = {0.f, 0.f};
#define AT_TI(t) ((t) < n1 ? a1 + (t) : a2 + ((t) - n1))
#define AT_DMA(t, bf) do { const int so_ = AT_TI(t) * 64 * IN_COLS * 2; LAS unsigned char* d_ = L3 + (bf) * 32768 + wid * 1024; \
    __builtin_amdgcn_raw_ptr_buffer_load_lds(rsZ, (LAS void*)(d_), 16, (int)voK[0], so_, 0, 0); __builtin_amdgcn_raw_ptr_buffer_load_lds(rsZ, (LAS void*)(d_ + 8192), 16, (int)voK[1], so_, 0, 0); \
    __builtin_amdgcn_raw_ptr_buffer_load_lds(rsZ, (LAS void*)(d_ + 16384), 16, (int)voV[0], so_, 0, 0); __builtin_amdgcn_raw_ptr_buffer_load_lds(rsZ, (LAS void*)(d_ + 24576), 16, (int)voV[1], so_, 0, 0); } while (0)
#define AT_QK(p0, p1, bf, t) do { const int j0_ = AT_TI(t) * 64; const int side_ = (j0_ + 63 < qbase) ? 1 : (j0_ > qbase + 31 ? -1 : 0); \
    at_bias(p0, p1, (float)(qi - j0_ - 4 * hi), slope2, smax2, side_); const LAS unsigned char* Ks_ = L3 + (bf) * 32768; \
    _Pragma("unroll") for (int d0 = 0; d0 < 4; ++d0) { const int cb = (c * 64 + d0 * 16 + hi * 8) * 2; \
        const bf16x8 k0 = *(const LAS bf16x8*)(Ks_ + KSWZ(r32, cb)), k1 = *(const LAS bf16x8*)(Ks_ + KSWZ(32 + r32, cb)); \
        p0 = __builtin_amdgcn_mfma_f32_32x32x16_bf16(k0, qr[d0], p0, 0, 0, 0); p1 = __builtin_amdgcn_mfma_f32_32x32x16_bf16(k1, qr[d0], p1, 0, 0, 0); } } while (0)
#define AT_PV(bf) do { const int vb = vb0 + (bf) * 32768 + 16384; pv_one<0>(o[0], vb, pa0, pa1, pa2, pa3); pv_one<1>(o[1], vb, pa0, pa1, pa2, pa3); pv_one<2>(o[2], vb, pa0, pa1, pa2, pa3); pv_one<3>(o[3], vb, pa0, pa1, pa2, pa3); } while (0)
#define AT_SB() do {} while (0)
#define AT_SYNC() do { asm volatile("s_waitcnt vmcnt(0) lgkmcnt(0)" ::: "memory"); __builtin_amdgcn_s_barrier(); asm volatile("" ::: "memory"); } while (0)
    f32x16 pA0, pA1, pB0, pB1; bf16x8 pa0, pa1, pa2, pa3;
    int a1 = 2 * qb, n1 = 2, a2 = 0, NT = 2;
#define AT_RUN() do { \
        AT_DMA(0, 0); AT_DMA(1, 1); \
        asm volatile("s_waitcnt vmcnt(4)" ::: "memory"); __builtin_amdgcn_s_barrier(); asm volatile("" ::: "memory"); \
        AT_QK(pA0, pA1, 0, 0); \
        int b0 = 0, b1 = 1, b2 = 2;                          \
        for (int t = 0; t + 1 < NT; t += 2) { \
            AT_SYNC(); if (t + 2 < NT) AT_DMA(t + 2, b2); \
            __builtin_amdgcn_s_setprio(1); AT_QK(pB0, pB1, b1, t + 1); \
            at_softmax(pA0, pA1, la2, lb2, pa0, pa1, pa2, pa3); __builtin_amdgcn_s_setprio(0); \
            AT_PV(b0); \
            AT_SYNC(); if (t + 3 < NT) AT_DMA(t + 3, b0); \
            __builtin_amdgcn_s_setprio(1); if (t + 2 < NT) AT_QK(pA0, pA1, b2, t + 2); \
            at_softmax(pB0, pB1, la2, lb2, pa0, pa1, pa2, pa3); __builtin_amdgcn_s_setprio(0); \
            AT_PV(b1); \
            { const int nb0 = b2, nb1 = b0, nb2 = b1; b0 = nb0; b1 = nb1; b2 = nb2; } \
        } } while (0)
    __syncthreads();
    AT_RUN();
    {
        const float lc = xsum32((la2[0] + la2[1]) + (lb2[0] + lb2[1])), lmn = -wave_max(-lc);
        LAS float* sml = (LAS float*)(lds + AT_WS + 1024);
        if (lane == 0) sml[wid] = lmn;
        __syncthreads();
        const f32x4 m0 = *(const LAS f32x4*)sml, m1 = *(const LAS f32x4*)(sml + 4);
        float tmin = fminf(fminf(fminf(m0[0], m0[1]), fminf(m0[2], m0[3])), fminf(fminf(m1[0], m1[1]), fminf(m1[2], m1[3])));
        tmin = __builtin_bit_cast(float, __builtin_amdgcn_readfirstlane(__builtin_bit_cast(int, fmaxf(tmin, 1e-36f))));
        const float lcnt2 = fminf(13.0f, 1.0f - __builtin_amdgcn_logf(1.0f - __builtin_amdgcn_exp2f(-slope2)));
        const int Wt = (int)ceilf((lcnt2 + 24.02f - __builtin_amdgcn_logf(tmin)) / slope2);
        if (Wt < W) W = Wt;
        if (W < 0) W = 0;
        int jlo = i0 - W; if (jlo < 0) jlo = 0; jlo >>= 6;
        int jhi = i0 + 127 + W; if (jhi > SEQ - 1) jhi = SEQ - 1; jhi >>= 6;
        if (((jhi - jlo) & 1) == 0) { if (jhi < SEQ / 64 - 1) ++jhi; else --jlo; }
        a1 = jlo; n1 = 2 * qb - jlo; a2 = 2 * qb + 2; NT = n1 + (jhi - 2 * qb - 1);
    }
    if (NT > 0) AT_RUN();
#undef AT_RUN
    __syncthreads();
#undef AT_DMA
#undef AT_TI
#undef AT_QK
#undef AT_PV
#undef AT_SB
#undef AT_SYNC
    const float l = xsum32((la2[0] + la2[1]) + (lb2[0] + lb2[1]));
    float* wsf = (float*)(lds + AT_WS) + wid * 32;
    float* exch = (float*)lds + grp * 4096;
    if (hi == 0) wsf[r32] = l;
    asm volatile("s_waitcnt lgkmcnt(0)" ::: "memory");
    float rl[16];
#pragma unroll
    for (int r = 0; r < 16; ++r) rl[r] = __builtin_amdgcn_rcpf(wsf[crow(r, hi)]) * (c ? lam : 1.0f);
    if (c == 1) {
#pragma unroll
        for (int d = 0; d < 4; ++d)
#pragma unroll
            for (int r = 0; r < 16; ++r) exch[(d * 16 + r) * 64 + lane] = o[d][r] * rl[r];
    }
    __syncthreads();
    if (c == 0) {
        float ss[16];
#pragma unroll
        for (int r = 0; r < 16; ++r) { float sacc = 0.f;
#pragma unroll
            for (int d = 0; d < 4; ++d) { const float v = o[d][r] * rl[r] - exch[(d * 16 + r) * 64 + lane]; o[d][r] = v; sacc += v * v; }
            ss[r] = sacc; }
#pragma unroll
        for (int r = 0; r < 16; ++r) {
            ss[r] = xsum16(row_sum16(ss[r]));
        }
        bf16_t* Ob = (bf16_t*)(P.ws + WS_O) + (size_t)(b * SEQ + i0 + grp * 32) * 1024 + C_RW + h * 128;
        float sg[4];
#pragma unroll
        for (int d = 0; d < 4; ++d) sg[d] = P.da_subln_g[d * 32 + r32] * 0.8f;
#pragma unroll
        for (int r = 0; r < 16; ++r) { const float rn = __builtin_amdgcn_rsqf(ss[r] * (1.f / 128.f) + NORM_EPS); bf16_t* op = Ob + (size_t)crow(r, hi) * 1024 + r32;
#pragma unroll
            for (int d = 0; d < 4; ++d) op[d * 32] = f2bf(o[d][r] * rn * sg[d]); }
    }
}

constexpr int SL_SZ = 19712, SL_AT = 0, SL_RT = 2304, SL_BT = 4608, SL_KT = 6912, SL_BH = 9216, SL_KH = 11776, SL_VT = 14336, SL_PC = 16896,
              SL_AAK = 17152, SL_TT = 17792, SL_ARB = 18432, SL_ARK = 19072;
constexpr int RW_SLOT = 0, RW_EX = 78848, RW_FG = 79872, RW_MU = 96256, RW_WFW = 98560, RW_WFA = 106752, RW_WFG = 123136, RW_AAB = 139520;
DI bf16x8 lo_hi(u32x2 lo, u32x2 hi) { u32x4 w = {lo[0], lo[1], hi[0], hi[1]}; return __builtin_bit_cast(bf16x8, w); }
DI float tanh_fast(float x) { const float t = __builtin_amdgcn_exp2f(x * (2.0f * LOG2E)); return 1.0f - 2.0f * __builtin_amdgcn_rcpf(t + 1.0f); }
template <int CTRL> DI unsigned dpp_keep(unsigned old, unsigned v) { return (unsigned)__builtin_amdgcn_update_dpp((int)old, (int)v, CTRL, 0xF, 0xF, false); }
DI void shift8(const u32x4 cur, const u32x4 bnd, const float* mu, float (&f)[8]) {
    const f32x4 m0 = *(const f32x4*)mu, m1 = *(const f32x4*)(mu + 4);
#pragma unroll
    for (int q = 0; q < 4; ++q) {
        const unsigned na = dpp_keep<0x111>(bnd[q], cur[q]), nb = dpp_keep<0x101>(bnd[q], cur[q]);
        const float c0 = bf_lo(cur[q]), c1 = bf_hi(cur[q]);
        const float mm0 = q < 2 ? m0[2 * q] : m1[2 * q - 4], mm1 = q < 2 ? m0[2 * q + 1] : m1[2 * q - 3];
        f[2 * q] = c0 + (0.5f * (bf_lo(na) + bf_lo(nb)) - c0) * mm0; f[2 * q + 1] = c1 + (0.5f * (bf_hi(na) + bf_hi(nb)) - c1) * mm1;
    }
}

#define RW_BAR() do { asm volatile("s_waitcnt lgkmcnt(0)" ::: "memory"); __builtin_amdgcn_s_barrier(); asm volatile("" ::: "memory"); } while (0)
DI void rwkv_task(const Params& P, unsigned char* lds, int b, int h, int wd) {
    int tid_ = threadIdx.x; asm volatile("" : "+v"(tid_));
    const int tid = tid_, wid = __builtin_amdgcn_readfirstlane(tid >> 6), lane = tid & 63, n16 = lane & 15, q4 = lane >> 4, cp = wid >> 1, hf = (wid ^ (wid >> 2)) & 1, vt = wid & 3;
    const bf16_t* Zb = (const bf16_t*)(P.ws + WS_Z) + (size_t)b * SEQ * IN_COLS;
    float* Ysc = (float*)(P.ws + WS_U) + (size_t)b * SEQ * 512 + h * 64;
    bf16_t* Ob = (bf16_t*)(P.ws + WS_O) + (size_t)b * SEQ * 1024 + h * 64;
    const bf16_t* XLb = (const bf16_t*)(P.ws + WS_XL) + (size_t)b * SEQ * 384;
    unsigned* flags = (unsigned*)(P.ws + WS_CTL) + CW_RWFLAG;
    const int hc = h * 64, task = (b * 8 + h) * 2 + wd;
    __syncthreads();
    float* MU = (float*)(lds + RW_MU);
    for (int i = tid; i < 192; i += 512) { const int col = (i < 64 ? ZR : i < 128 ? ZK - 64 : ZV - 128) + hc + i; MU[i] = P.rw_mu[col]; }
    float* CST = (float*)(lds + RW_AAB + 4096);
    for (int i = tid; i < 512; i += 512) { const int a = i >> 6, ch = i & 63; const float* src = a == 0 ? P.rw_w0 + wd * 512 : a == 1 ? P.rw_a0 + wd * 512 : a == 2 ? P.rw_a0 + (1 - wd) * 512 : a == 3 ? P.rw_k_k : a == 4 ? P.rw_k_a : a == 5 ? P.rw_r_k : a == 6 ? P.rw_ln_g : P.rw_ln_b; CST[i] = src[hc + ch] * (a < 3 ? -LOG2E : 1.f); }
    bf16x8* wfw = (bf16x8*)(lds + RW_WFW) + (size_t)(hf * 4) * 64 + lane;
    bf16x8* wfa = (bf16x8*)(lds + RW_WFA) + (size_t)(hf * 4) * 64 + lane;
    bf16x8* wfo = (bf16x8*)(lds + RW_WFA) + (size_t)(8 + hf * 4) * 64 + lane;
    bf16x8* wfg = (bf16x8*)(lds + RW_WFG) + (size_t)(hf * 8) * 64 + lane;
#pragma unroll
    for (int u = 0; u < 2; ++u) {
        const int col = hc + hf * 32 + 2 * n16 + u;
        if (cp == 0) {
#pragma unroll
            for (int s = 0; s < 2; ++s) {
                float x[8], y[8], z[8];
#pragma unroll
                for (int j = 0; j < 8; ++j) { const int r = s * 32 + q4 * 8 + j; x[j] = -LOG2E * P.rw_w2[(size_t)(wd * 64 + r) * 512 + col]; y[j] = -LOG2E * P.rw_a2[(size_t)(wd * 64 + r) * 512 + col]; z[j] = -LOG2E * P.rw_a2[(size_t)((1 - wd) * 64 + r) * 512 + col]; }
                wfw[(u * 2 + s) * 64] = pack8(x[0], x[1], x[2], x[3], x[4], x[5], x[6], x[7]); wfa[(u * 2 + s) * 64] = pack8(y[0], y[1], y[2], y[3], y[4], y[5], y[6], y[7]);
                wfo[(u * 2 + s) * 64] = pack8(z[0], z[1], z[2], z[3], z[4], z[5], z[6], z[7]);
            }
#pragma unroll
            for (int s = 0; s < 4; ++s) { float x[8];
#pragma unroll
                for (int j = 0; j < 8; ++j) x[j] = P.rw_g2[(size_t)(s * 32 + q4 * 8 + j) * 512 + col];
                wfg[(u * 4 + s) * 64] = pack8(x[0], x[1], x[2], x[3], x[4], x[5], x[6], x[7]); }
        }
    }
    u32x4* selp = (u32x4*)(lds + RW_AAB + 6144) + lane;
    if (wid == 0) {
#pragma unroll
        for (int u = 0; u < 2; ++u) { const unsigned one = (q4 == (n16 >> 2)) ? (u ? 0x3F800000u : 0x00003F80u) : 0u; const int w = n16 & 3;
            selp[u * 64] = (u32x4){w == 0 ? one : 0u, w == 1 ? one : 0u, w == 2 ? one : 0u, w == 3 ? one : 0u}; }
    }
    f32x4 ST[4];
#pragma unroll
    for (int t = 0; t < 4; ++t) ST[t] = (f32x4){0.f, 0.f, 0.f, 0.f};
    unsigned char* slot = lds + RW_SLOT + cp * SL_SZ;
    float* ex = (float*)(lds + RW_EX);
    bf16_t* fgb = (bf16_t*)(lds + RW_FG) + cp * 2048;
    const int sgn = wd ? -1 : 1;
    bf16x8 xw0, xw1, xa0, xa1; u32x4 zc[3], zb[3]; bool bok = false;
    bf16x8 xo0 = {0, 0, 0, 0, 0, 0, 0, 0}, xo1 = xo0, xg0 = xo0, xg1 = xo0, xg2 = xo0, xg3 = xo0;
#define RW_OPQ() int lo_ = lane; asm volatile("" : "+v"(lo_)); const int n16 = lo_ & 15, q4 = lo_ >> 4
#define RW_LOADS(S_) do { RW_OPQ(); const int sc_ = wd ? (SEQ / 64 - 1 - (S_)) : (S_); const int T0_ = wd ? (sc_ * 64 + 63 - 16 * cp) : (sc_ * 64 + 16 * cp); \
        const int tb_ = (n16 == 0) ? (T0_ - sgn) : (T0_ + 16 * sgn); bok = (n16 == 0 || n16 == 15) && tb_ >= 0 && tb_ < SEQ; \
          \
        const unsigned zro_ = (unsigned)((T0_ + sgn * n16) * IN_COLS + q4 * 8 + hc + hf * 32) * 2u, zbo_ = (unsigned)((bok ? tb_ : 0) * IN_COLS + q4 * 8 + hc + hf * 32) * 2u; \
        const unsigned xlo_ = (unsigned)((T0_ + sgn * n16) * 384 + q4 * 8) * 2u; const char* xl_ = (const char*)XLb + xlo_; \
        xw0 = *(const bf16x8*)(xl_ + (wd * 64) * 2); xw1 = *(const bf16x8*)(xl_ + (wd * 64 + 32) * 2); xa0 = *(const bf16x8*)(xl_ + (128 + wd * 64) * 2); xa1 = *(const bf16x8*)(xl_ + (128 + wd * 64 + 32) * 2); \
        _Pragma("unroll") for (int arr = 0; arr < 3; ++arr) { const int col = (arr == 0 ? ZR : arr == 1 ? ZK : ZV); zc[arr] = *(const u32x4*)((const char*)Zb + zro_ + col * 2); zb[arr] = *(const u32x4*)((const char*)Zb + zbo_ + col * 2); } \
        if ((S_) >= SEQ / 128) { xo0 = *(const bf16x8*)(xl_ + (128 + (1 - wd) * 64) * 2); xo1 = *(const bf16x8*)(xl_ + (128 + (1 - wd) * 64 + 32) * 2); \
            xg0 = *(const bf16x8*)(xl_ + 256 * 2); xg1 = *(const bf16x8*)(xl_ + 288 * 2); xg2 = *(const bf16x8*)(xl_ + 320 * 2); xg3 = *(const bf16x8*)(xl_ + 352 * 2); } } while (0)
#define RW_LANDED() asm volatile("" :: "v"(xw0), "v"(xw1), "v"(xa0), "v"(xa1), "v"(zc[0]), "v"(zc[1]), "v"(zc[2]), "v"(zb[0]), "v"(zb[1]), "v"(zb[2]), "v"(xo0), "v"(xo1), "v"(xg0), "v"(xg1), "v"(xg2), "v"(xg3))
    RW_LOADS(0);
    RW_LANDED();
    for (int s = 0; s < SEQ / 64; ++s) {
        const bool fin = s >= SEQ / 128;
        const int sc = wd ? (SEQ / 64 - 1 - s) : s;
        const int T0 = wd ? (sc * 64 + 63 - 16 * cp) : (sc * 64 + 16 * cp);
        if (s == SEQ / 128) {
            if (tid < 64) {
                unsigned spins = 0;
                while (__builtin_amdgcn_readfirstlane(__hip_atomic_load(flags + (task ^ 1) * 16, __ATOMIC_RELAXED, __HIP_MEMORY_SCOPE_AGENT)) == 0u) { __builtin_amdgcn_s_sleep(8); if (++spins > (1u << 24)) break; }
                __builtin_amdgcn_fence(__ATOMIC_ACQUIRE, "agent");
                asm volatile("s_waitcnt vmcnt(0)" ::: "memory");
            }
        }
        RW_BAR();
        const u32x4 z4 = {0u, 0u, 0u, 0u};
        f32x4 lw[2], la[2], lo[2], lg[2];
#pragma unroll
        for (int u = 0; u < 2; ++u) { lw[u] = (f32x4){0.f, 0.f, 0.f, 0.f}; la[u] = lw[u]; lo[u] = lw[u]; lg[u] = lw[u]; }
#define RW_MM(acc, af, wf, nks, ks) acc[0] = __builtin_amdgcn_mfma_f32_16x16x32_bf16(af, wf[(ks) * 64], acc[0], 0, 0, 0); acc[1] = __builtin_amdgcn_mfma_f32_16x16x32_bf16(af, wf[((nks) + (ks)) * 64], acc[1], 0, 0, 0);
        RW_MM(lw, xw0, wfw, 2, 0) RW_MM(lw, xw1, wfw, 2, 1) RW_MM(la, xa0, wfa, 2, 0) RW_MM(la, xa1, wfa, 2, 1)
        if (fin) { RW_MM(lo, xo0, wfo, 2, 0) RW_MM(lo, xo1, wfo, 2, 1) RW_MM(lg, xg0, wfg, 4, 0) RW_MM(lg, xg1, wfg, 4, 1) RW_MM(lg, xg2, wfg, 4, 2) RW_MM(lg, xg3, wfg, 4, 3) }
#undef RW_MM
        float rr[2][4], kr[2][4], vv[2][4];
        {
            const bf16x8 sel0 = __builtin_bit_cast(bf16x8, selp[0]), sel1 = __builtin_bit_cast(bf16x8, selp[64]);
            const f32x4 zero4 = {0.f, 0.f, 0.f, 0.f};
            const bool edge = (T0 - sgn < 0) || (T0 - sgn >= SEQ) || (T0 + 16 * sgn < 0) || (T0 + 16 * sgn >= SEQ);
            if (edge) {
#pragma unroll
                for (int arr = 0; arr < 3; ++arr) zb[arr] = bok ? zb[arr] : z4;
            }
#pragma unroll
            for (int arr = 0; arr < 3; ++arr) {
                const u32x4 cur = zc[arr], bnd = zb[arr]; u32x4 na, nb;
#pragma unroll
                for (int q = 0; q < 4; ++q) { na[q] = dpp_keep<0x111>(bnd[q], cur[q]); nb[q] = dpp_keep<0x101>(bnd[q], cur[q]); }
                const f32x2 mu2 = *(const f32x2*)(MU + arr * 64 + hf * 32 + 2 * n16);
#pragma unroll
                for (int u = 0; u < 2; ++u) {
                    const bf16x8 sl = u ? sel1 : sel0;
                    const f32x4 d1 = __builtin_amdgcn_mfma_f32_16x16x32_bf16(__builtin_bit_cast(bf16x8, cur), sl, zero4, 0, 0, 0);
                    f32x4 d2 = __builtin_amdgcn_mfma_f32_16x16x32_bf16(__builtin_bit_cast(bf16x8, na), sl, zero4, 0, 0, 0);
                    d2 = __builtin_amdgcn_mfma_f32_16x16x32_bf16(__builtin_bit_cast(bf16x8, nb), sl, d2, 0, 0, 0);
                    const f32x4 val = d1 + (0.5f * d2 - d1) * mu2[u];
#pragma unroll
                    for (int j = 0; j < 4; ++j) { if (arr == 0) rr[u][j] = val[j]; else if (arr == 1) kr[u][j] = val[j]; else vv[u][j] = val[j]; }
                }
            }
        }
        float lgw[2][4], aa[2][4], kkr[2][4], gg[2][4], n2p[4], bnp[4];
#pragma unroll
        for (int j = 0; j < 4; ++j) { n2p[j] = 0.f; bnp[j] = 0.f; }
        {
            const int ch2 = hf * 32 + 2 * n16;
            const f32x2 w0c2 = *(const f32x2*)(CST + ch2), a0c2 = *(const f32x2*)(CST + 64 + ch2), a0oc2 = *(const f32x2*)(CST + 128 + ch2), kkc2 = *(const f32x2*)(CST + 192 + ch2), kac2 = *(const f32x2*)(CST + 256 + ch2), rkc2 = *(const f32x2*)(CST + 320 + ch2);
#define RW_SG2(x_) __builtin_amdgcn_rcpf(1.f + __builtin_amdgcn_exp2f(x_))
            if (!fin) {
#pragma unroll
                for (int u = 0; u < 2; ++u)
#pragma unroll
                    for (int j = 0; j < 4; ++j) {
                        lgw[u][j] = (-0.6065306597f * LOG2E) * RW_SG2(w0c2[u] + lw[u][j]);
                        aa[u][j] = RW_SG2(a0c2[u] + la[u][j]);
                        const float kk = kr[u][j] * kkc2[u]; kkr[u][j] = kk; n2p[j] += kk * kk; gg[u][j] = 0.f;
                    }
            } else {
#pragma unroll
                for (int u = 0; u < 2; ++u)
#pragma unroll
                    for (int j = 0; j < 4; ++j) {
                        lgw[u][j] = (-0.6065306597f * LOG2E) * RW_SG2(w0c2[u] + lw[u][j]);
                        const float a = RW_SG2(a0c2[u] + la[u][j]); aa[u][j] = a;
                        const float k = kr[u][j], kk = k * kkc2[u]; kkr[u][j] = kk; n2p[j] += kk * kk;
                        const float ao = RW_SG2(a0oc2[u] + lo[u][j]); const float kb = k * (1.f + (0.5f * (a + ao) - 1.f) * kac2[u]); bnp[j] += rr[u][j] * kb * rkc2[u]; gg[u][j] = lg[u][j];
                    }
            }
#undef RW_SG2
        }
#pragma unroll
        for (int j = 0; j < 4; ++j) n2p[j] = row_sum16(n2p[j]);
        if (fin) {
#pragma unroll
            for (int j = 0; j < 4; ++j) bnp[j] = row_sum16(bnp[j]);
        }
        if (n16 == 0) {
#pragma unroll
            for (int j = 0; j < 4; ++j) { float* e = ex + ((cp * 2 + hf) * 16 + q4 * 4 + j) * 2; e[0] = n2p[j]; e[1] = bnp[j]; }
        }
        RW_BAR();
        if (s + 1 < SEQ / 64) RW_LOADS(s + 1);
        {
            RW_OPQ();
            float bon[4], rsn[4];
#pragma unroll
            for (int j = 0; j < 4; ++j) { const float* e = ex + ((cp * 2 + (1 - hf)) * 16 + q4 * 4 + j) * 2; rsn[j] = __builtin_amdgcn_rsqf(n2p[j] + e[0] + 1e-12f); bon[j] = bnp[j] + e[1]; }
            const int ch2 = hf * 32 + 2 * n16; const f32x2 kac2 = *(const f32x2*)(CST + 256 + ch2);
            float excl[2], PCv[2], eprev[2], L[2][4];
#pragma unroll
            for (int u = 0; u < 2; ++u) {
                L[u][0] = lgw[u][0]; L[u][1] = L[u][0] + lgw[u][1]; L[u][2] = L[u][1] + lgw[u][2]; L[u][3] = L[u][2] + lgw[u][3];
                const unsigned tu = __builtin_bit_cast(unsigned, L[u][3]);
                auto s16 = __builtin_amdgcn_permlane16_swap(tu, tu, false, false);
                const float sa = __builtin_bit_cast(float, (unsigned)s16[0]), sb = __builtin_bit_cast(float, (unsigned)s16[1]), sp = sa + sb;
                const unsigned pu = __builtin_bit_cast(unsigned, sp);
                auto s32 = __builtin_amdgcn_permlane32_swap(pu, pu, false, false);
                const float s01 = __builtin_bit_cast(float, (unsigned)s32[0]), s23 = __builtin_bit_cast(float, (unsigned)s32[1]);
                const float LC = s01 + s23;
                const float incl = q4 == 0 ? sa : q4 == 1 ? sp : q4 == 2 ? s01 + sa : LC;
                excl[u] = incl - L[u][3];
                PCv[u] = __builtin_amdgcn_exp2f(LC); eprev[u] = __builtin_amdgcn_exp2f(excl[u]);
            }
            if (q4 == 0) *(f32x2*)((float*)(slot + SL_PC) + ch2) = (f32x2){PCv[0], PCv[1]};
            float bhv[2][4], khv[2][4];
#pragma unroll
            for (int j = 0; j < 4; ++j) { const int i = q4 * 4 + j;
                float atv[2], rtv[2], btv[2], ktv[2];
#pragma unroll
                for (int u = 0; u < 2; ++u) {
                    const float eL = __builtin_amdgcn_exp2f(excl[u] + L[u][j]), eLp = eprev[u], emL = __builtin_amdgcn_rcpf(eL); eprev[u] = eL;
                    const float kk = kkr[u][j] * rsn[j], a = aa[u][j], k = kr[u][j];
                    const float bt = kk * a * emL, kt = k * (1.f + (a - 1.f) * kac2[u]) * emL;
                    atv[u] = -kk * eLp; rtv[u] = rr[u][j] * eL; btv[u] = bt; ktv[u] = kt;
                    bhv[u][j] = bt * PCv[u]; khv[u][j] = kt * PCv[u];
                }
                *(unsigned*)((bf16_t*)(slot + SL_AT) + i * 72 + ch2) = cvt_pk(atv[0], atv[1]); *(unsigned*)((bf16_t*)(slot + SL_RT) + i * 72 + ch2) = cvt_pk(rtv[0], rtv[1]);
                *(unsigned*)((bf16_t*)(slot + SL_BT) + i * 72 + ch2) = cvt_pk(btv[0], btv[1]); *(unsigned*)((bf16_t*)(slot + SL_KT) + i * 72 + ch2) = cvt_pk(ktv[0], ktv[1]);
            }
            if (fin) {
#pragma unroll
                for (int j = 0; j < 4; ++j) { const int i = q4 * 4 + j; *(unsigned*)(fgb + i * 64 + ch2) = cvt_pk(gg[0][j], gg[1][j]); *(unsigned*)(fgb + 1024 + i * 64 + ch2) = cvt_pk(bon[j] * vv[0][j] * gg[0][j], bon[j] * vv[1][j] * gg[1][j]); }
            }
#pragma unroll
            for (int u = 0; u < 2; ++u) { const int ch = ch2 + u;
                *(u32x2*)(slot + SL_BH + (ch * 20 + q4 * 4) * 2) = (u32x2){cvt_pk(bhv[u][0], bhv[u][1]), cvt_pk(bhv[u][2], bhv[u][3])};
                *(u32x2*)(slot + SL_KH + (ch * 20 + q4 * 4) * 2) = (u32x2){cvt_pk(khv[u][0], khv[u][1]), cvt_pk(khv[u][2], khv[u][3])};
                *(u32x2*)(slot + SL_VT + (ch * 20 + q4 * 4) * 2) = (u32x2){cvt_pk(vv[u][0], vv[u][1]), cvt_pk(vv[u][2], vv[u][3])};
            }
        }
        RW_BAR();
        f32x4 ysp[2] = {(f32x4){0.f, 0.f, 0.f, 0.f}, (f32x4){0.f, 0.f, 0.f, 0.f}};
        if (fin) {
            RW_OPQ();
#pragma unroll
            for (int jt = 0; jt < 2; ++jt) ysp[jt] = *(const f32x4*)((const char*)Ysc + (unsigned)((T0 + sgn * (hf * 8 + q4 * 2 + jt)) * 512 + n16 * 4) * 4u);
        }
        {
            RW_OPQ();
            const bf16_t* X = (const bf16_t*)(slot + (hf ? SL_RT : SL_AT)) + n16 * 72 + q4 * 8;
            const bf16_t* YB = (const bf16_t*)(slot + SL_BT) + n16 * 72 + q4 * 8; const bf16_t* YK = (const bf16_t*)(slot + SL_KT) + n16 * 72 + q4 * 8;
            const bf16x8 x0 = *(const bf16x8*)X, x1 = *(const bf16x8*)(X + 32);
            f32x4 mb = {0.f, 0.f, 0.f, 0.f}, mk = mb;
            mb = __builtin_amdgcn_mfma_f32_16x16x32_bf16(x0, *(const bf16x8*)YB, mb, 0, 0, 0); mb = __builtin_amdgcn_mfma_f32_16x16x32_bf16(x1, *(const bf16x8*)(YB + 32), mb, 0, 0, 0);
            mk = __builtin_amdgcn_mfma_f32_16x16x32_bf16(x0, *(const bf16x8*)YK, mk, 0, 0, 0); mk = __builtin_amdgcn_mfma_f32_16x16x32_bf16(x1, *(const bf16x8*)(YK + 32), mk, 0, 0, 0);
#pragma unroll
            for (int jj = 0; jj < 4; ++jj) { const int i = q4 * 4 + jj; const bool keep = hf ? (n16 <= i) : (n16 < i); const float vb = keep ? mb[jj] : 0.f, vk = keep ? mk[jj] : 0.f;
                mb[jj] = vb;
                ((bf16_t*)(slot + (hf ? SL_ARK : SL_AAK)))[i * 20 + n16] = f2bf(vk);
                if (hf) ((bf16_t*)(slot + SL_ARB))[i * 20 + n16] = f2bf(vb); }
            if (hf == 0) {
#define RW_P4(M) __builtin_bit_cast(s16x4, (u32x2){cvt_pk(M[0], M[1]), cvt_pk(M[2], M[3])})
#define RW_MM16(A_, B_, C_) __builtin_amdgcn_mfma_f32_16x16x16bf16_1k(A_, B_, C_, 0, 0, 0)
                const f32x4 z4f = {0.f, 0.f, 0.f, 0.f};
                f32x4 nt = z4f;
                nt = __builtin_amdgcn_mfma_f32_16x16x32_bf16(*(const bf16x8*)YB, x0, nt, 0, 0, 0); nt = __builtin_amdgcn_mfma_f32_16x16x32_bf16(*(const bf16x8*)(YB + 32), x1, nt, 0, 0, 0);
                f32x4 R;
#pragma unroll
                for (int jj = 0; jj < 4; ++jj) { const int i = q4 * 4 + jj; nt[jj] = (i < n16) ? nt[jj] : 0.f; R[jj] = nt[jj] + (i == n16 ? 1.f : 0.f); }
                const s16x4 n1 = RW_P4(mb), n1t = RW_P4(nt);
                const f32x4 N2 = RW_MM16(n1t, n1, z4f), N2t = RW_MM16(n1, n1t, z4f);
                const s16x4 n2 = RW_P4(N2), n2t = RW_P4(N2t);
                R = RW_MM16(n2, RW_P4(R), R);
                const f32x4 N4 = RW_MM16(n2t, n2, z4f), N4t = RW_MM16(n2, n2t, z4f);
                const s16x4 n4 = RW_P4(N4), n4t = RW_P4(N4t);
                R = RW_MM16(n4, RW_P4(R), R);
                const f32x4 N8 = RW_MM16(n4t, n4, z4f);
                R = RW_MM16(RW_P4(N8), RW_P4(R), R);
                *(u32x2*)((bf16_t*)(slot + SL_TT) + n16 * 20 + q4 * 4) = (u32x2){cvt_pk(R[0], R[1]), cvt_pk(R[2], R[3])};
#undef RW_P4
#undef RW_MM16
            }
        }
        RW_BAR();
        if (wid < 4) {
            RW_OPQ();
#pragma unroll
            for (int c2 = 0; c2 < 4; ++c2) {
                const unsigned char* sl = lds + RW_SLOT + c2 * SL_SZ;
                const bf16x8 sf0 = pack8(ST[0][0], ST[0][1], ST[0][2], ST[0][3], ST[1][0], ST[1][1], ST[1][2], ST[1][3]);
                const bf16x8 sf1 = pack8(ST[2][0], ST[2][1], ST[2][2], ST[2][3], ST[3][0], ST[3][1], ST[3][2], ST[3][3]);
                const bf16_t* AT = (const bf16_t*)(sl + SL_AT) + n16 * 72 + q4 * 4; const bf16_t* RT = (const bf16_t*)(sl + SL_RT) + n16 * 72 + q4 * 4;
                const int mo = (n16 * 20 + q4 * 4) * 2;
                const u32x2 vmf = *(const u32x2*)(sl + SL_VT + ((vt * 16 + n16) * 20 + q4 * 4) * 2);
                const f32x4 z4f = {0.f, 0.f, 0.f, 0.f};
                f32x4 X = __builtin_amdgcn_mfma_f32_16x16x16bf16_1k(__builtin_bit_cast(s16x4, *(const u32x2*)(sl + SL_AAK + mo)), __builtin_bit_cast(s16x4, vmf), z4f, 0, 0, 0);
                X = __builtin_amdgcn_mfma_f32_16x16x32_bf16(lo_hi(*(const u32x2*)(AT), *(const u32x2*)(AT + 16)), sf0, X, 0, 0, 0);
                X = __builtin_amdgcn_mfma_f32_16x16x32_bf16(lo_hi(*(const u32x2*)(AT + 32), *(const u32x2*)(AT + 48)), sf1, X, 0, 0, 0);
                const f32x4 U = __builtin_amdgcn_mfma_f32_16x16x16bf16_1k(__builtin_bit_cast(s16x4, *(const u32x2*)(sl + SL_TT + mo)), __builtin_bit_cast(s16x4, (u32x2){cvt_pk(X[0], X[1]), cvt_pk(X[2], X[3])}), z4f, 0, 0, 0);
                const bf16x8 uv = lo_hi((u32x2){cvt_pk(U[0], U[1]), cvt_pk(U[2], U[3])}, vmf);
                f32x4 Y = {0.f, 0.f, 0.f, 0.f};
                Y = __builtin_amdgcn_mfma_f32_16x16x32_bf16(lo_hi(*(const u32x2*)(RT), *(const u32x2*)(RT + 16)), sf0, Y, 0, 0, 0);
                Y = __builtin_amdgcn_mfma_f32_16x16x32_bf16(lo_hi(*(const u32x2*)(RT + 32), *(const u32x2*)(RT + 48)), sf1, Y, 0, 0, 0);
                Y = __builtin_amdgcn_mfma_f32_16x16x32_bf16(lo_hi(*(const u32x2*)(sl + SL_ARB + mo), *(const u32x2*)(sl + SL_ARK + mo)), uv, Y, 0, 0, 0);
#pragma unroll
                for (int t = 0; t < 4; ++t) {
                    const f32x4 pc = *(const f32x4*)(sl + SL_PC + (t * 16 + q4 * 4) * 4);
                    const int kro = ((t * 16 + n16) * 20 + q4 * 4) * 2;
                    ST[t] = __builtin_amdgcn_mfma_f32_16x16x32_bf16(lo_hi(*(const u32x2*)(sl + SL_BH + kro), *(const u32x2*)(sl + SL_KH + kro)), uv, ST[t] * pc, 0, 0, 0);
                }
                float* yo = (float*)(lds + RW_SLOT + c2 * SL_SZ + SL_BT);
#pragma unroll
                for (int j = 0; j < 4; ++j) yo[(q4 * 4 + j) * 64 + vt * 16 + n16] = Y[j];
            }
        }
        RW_BAR();
        {
            RW_OPQ();
            const float* yo = (const float*)(slot + SL_BT);
            const int i0 = hf * 8 + q4 * 2, o0 = i0 * 64 + n16 * 4, t0 = T0 + sgn * i0, t1 = t0 + sgn;
            f32x4 y0 = *(const f32x4*)(yo + o0), y1 = *(const f32x4*)(yo + o0 + 64);
            u32x2 res[2] = {(u32x2){0u, 0u}, (u32x2){0u, 0u}};
            if (fin) {
                const f32x4 lng4 = *(const f32x4*)(CST + 384 + n16 * 4), lnb4 = *(const f32x4*)(CST + 448 + n16 * 4);
#pragma unroll
                for (int jt = 0; jt < 2; ++jt) { const int o = o0 + jt * 64;
                    const f32x4 y = (jt ? y1 : y0) + ysp[jt];
                    const float s1 = row_sum16(y[0] + y[1] + y[2] + y[3]), s2 = row_sum16(y[0] * y[0] + y[1] * y[1] + y[2] * y[2] + y[3] * y[3]);
                    const float mean = s1 * (1.f / 64.f), var = s2 * (1.f / 64.f) - mean * mean; const float rs = __builtin_amdgcn_rsqf(var + 64e-5f);
                    const u32x2 g2 = *(const u32x2*)(fgb + o), v2 = *(const u32x2*)(fgb + 1024 + o);
                    const float r0 = ((y[0] - mean) * rs * lng4[0] + lnb4[0]) * bf_lo(g2[0]) + bf_lo(v2[0]), r1 = ((y[1] - mean) * rs * lng4[1] + lnb4[1]) * bf_hi(g2[0]) + bf_hi(v2[0]);
                    const float r2 = ((y[2] - mean) * rs * lng4[2] + lnb4[2]) * bf_lo(g2[1]) + bf_lo(v2[1]), r3 = ((y[3] - mean) * rs * lng4[3] + lnb4[3]) * bf_hi(g2[1]) + bf_hi(v2[1]);
                    res[jt] = (u32x2){cvt_pk(r0, r1), cvt_pk(r2, r3)};
                }
            }
            RW_LANDED();
            if (!fin) { *(f32x4*)((char*)Ysc + (unsigned)(t0 * 512 + n16 * 4) * 4u) = y0; *(f32x4*)((char*)Ysc + (unsigned)(t1 * 512 + n16 * 4) * 4u) = y1; }
            else { *(u32x2*)((char*)Ob + (unsigned)(t0 * 1024 + n16 * 4) * 2u) = res[0]; *(u32x2*)((char*)Ob + (unsigned)(t1 * 1024 + n16 * 4) * 2u) = res[1]; }
        }
        if (s == SEQ / 128 - 1) {
            asm volatile("s_waitcnt vmcnt(0)" ::: "memory");
            __syncthreads();
            if (tid == 0) { __builtin_amdgcn_fence(__ATOMIC_RELEASE, "agent"); asm volatile("s_waitcnt vmcnt(0)" ::: "memory"); __hip_atomic_store(flags + task * 16, 1u, __ATOMIC_RELAXED, __HIP_MEMORY_SCOPE_AGENT); }
        }
    }
}

DI void phase_mixer(const Params& P, unsigned char* lds, int qsel, int mode = 0) {
    const int lane = threadIdx.x & 63;
    const float lam = __expf(wave_sum(P.da_lq1[lane] * P.da_lk1[lane])) - __expf(wave_sum(P.da_lq2[lane] * P.da_lk2[lane])) + 0.2f;
    float mq = fabsf(P.da_q_norm_g[lane]), mk = fabsf(P.da_k_norm_g[lane]);
    mq = wave_max(mq); mk = wave_max(mk);
    const float smax_ = 8.0f * mq * mk * 1.01f;
    unsigned* qhead = (unsigned*)(P.ws + WS_CTL) + CW_QUEUE + qsel;
    volatile unsigned* qw = (volatile unsigned*)(lds + LDS_QW);
    volatile float* pw = (volatile float*)(lds + LDS_QW + 4);
    if (threadIdx.x == 0) { pw[0] = lam; pw[1] = smax_; }
    for (;;) {
        __syncthreads();
        if (threadIdx.x == 0) *qw = atomicAdd(qhead, 1u) + (mode == 2 ? 128u : 0u);
        __syncthreads();
        const unsigned idx = __builtin_amdgcn_readfirstlane(*qw);
#ifndef AT_REP
#define AT_REP 1
#endif
#ifndef RW_DUP
#define RW_DUP 0
#endif
        if (idx >= 128u + 128u * RW_DUP + 2048u * AT_REP || (mode == 1 && idx >= 128u)) break;
#if !defined(MIX_ONLY) || MIX_ONLY == 1
        if (idx < 128u + 128u * RW_DUP) { const unsigned ti = idx & 127u; rwkv_task(P, lds, (int)(ti >> 4), (int)((ti >> 1) & 7), (int)(ti & 1)); }
#endif
#if !defined(MIX_ONLY) || MIX_ONLY == 2
        if (idx >= 128u + 128u * RW_DUP) { const unsigned u = (idx - 128u - 128u * RW_DUP) & 2047u; const int h = 3 - (int)(u >> 9), b = (int)((u >> 6) & 7), qb = (int)(u & 63);
            const float lam_ = __builtin_bit_cast(float, __builtin_amdgcn_readfirstlane(__builtin_bit_cast(int, (float)pw[0]))), smax = __builtin_bit_cast(float, __builtin_amdgcn_readfirstlane(__builtin_bit_cast(int, (float)pw[1])));
            const float slope = exp2f(-2.0f * (float)(h + 1)); int W = (int)ceilf((25.65f + 2.0f * smax) / slope); if (W > SEQ) W = SEQ;
            attn_unit(P, lds, b, h, qb, lam_, smax * LOG2E, W); }
#endif
    }
}

constexpr int N_PHASES = 13;
__global__ void __launch_bounds__(512, 2) mega(Params P) {
    extern __shared__ __attribute__((aligned(16))) unsigned char shm[];
    LAS unsigned char* lds = (LAS unsigned char*)shm;
    unsigned char* ws = P.ws;
    if (threadIdx.x == 0) *(LAS u32x4*)(lds + LDS_XB) = (u32x4){0u, 0u, 0u, 0u};
    __syncthreads();
    XcdBarrier bar = xcd_barrier_post(g_xbar, (volatile LAS unsigned*)(lds + LDS_XB));
#ifndef ONLY_PHASE
#define RUN(k) (P.ph_lo <= (k) && (k) < P.ph_hi)
#else
#define RUN(k) ((k) == ONLY_PHASE && P.ph_lo <= (k) && (k) < P.ph_hi)
#endif
#ifdef DIAG_PHASE
    unsigned long long dg_t0 = 0, dg_t1 = 0;
#define SYNC(k) do { if (P.ph_lo <= (k) && (k) + 1 < P.ph_hi) xcd_barrier(bar); if ((k) + 1 == DIAG_PHASE || ((k) == 8 && DIAG_PHASE == 12)) dg_t0 = wall_clock64(); if ((k) == DIAG_PHASE) dg_t1 = wall_clock64(); } while (0)
#else
#define SYNC(k) do { if (P.ph_lo <= (k) && (k) + 1 < P.ph_hi) xcd_barrier(bar); } while (0)
#endif
    if (RUN(0)) phase_prep(P, shm);
#if defined(REP_PHASE) && REP_PHASE == 0
    xcd_barrier(bar); phase_prep(P, shm);
#endif
    SYNC(0);
    if (RUN(1)) { DenseOrder S; S.init(ws + WS_U, ws + WS_WIN, MTOK, IN_PAD, 2048, 2048); EpiZ E{(bf16_t*)(ws + WS_Z), P.da_q_norm_g, P.da_k_norm_g}; gemm_phase<false, 2>(lds, 1024, 1024, S, E);
#if defined(REP_PHASE) && REP_PHASE == 1
        xcd_barrier(bar); gemm_phase<false, 2>(lds, 1024, 1024, S, E);
#endif
#if defined(REP_PHASE) && REP_PHASE == 101
        xcd_barrier(bar); { EpiNone E0{(float*)(ws + WS_ESS)}; gemm_phase<false, 2>(lds, 1024, 1024, S, E0); }
#endif
    }
    SYNC(1);
    if (RUN(2)) phase_qknorm(P);
    SYNC(2);
#if defined(REP_PHASE) && REP_PHASE == 3
    if (RUN(3)) for (int rep = 0; rep < 2; ++rep) { if (rep) xcd_barrier(bar); phase_mixer(P, shm, rep, rep ? REP_MODE : 0); }
#else
    if (RUN(3)) phase_mixer(P, shm, 0);
#endif
    SYNC(3);
    if (RUN(4)) { DenseOrder S; S.init(ws + WS_O, ws + WS_WOUT, MTOK, 1024, 2048, 2048); EpiH1 E{P.x, (bf16_t*)P.out}; gemm_phase<false, 2>(lds, 1024, 1024, S, E);
#if defined(REP_PHASE) && REP_PHASE == 4
        xcd_barrier(bar); gemm_phase<false, 2>(lds, 1024, 1024, S, E);
#endif
    }
    SYNC(4);
    if (RUN(5)) phase_route(P, lds);
    SYNC(5);
    if (RUN(6)) { moe_tables(lds, (const unsigned*)(ws + WS_CTL) + CW_CNT);
        MoeOrder<8, true, 1> S{(const char*)(ws + WS_U), (const char*)(ws + WS_W1), (size_t)2048 * 1024, 0, 128, (int)gridDim.x, (int)blockIdx.x, lds, (const int*)(ws + WS_LIST)};
        EpiMoe1 E{ws + WS_Z, P.b1}; gemm_phase<true, 1>(lds, 1024, 1024, S, E);
#if defined(REP_PHASE) && REP_PHASE == 6
        xcd_barrier(bar); gemm_phase<true, 1>(lds, 1024, 1024, S, E);
#endif
    }
    SYNC(6);
    if (RUN(7)) { moe_tables(lds, (const unsigned*)(ws + WS_CTL) + CW_CNT);
        MoeOrder<4, false, 1> S{(const char*)(ws + WS_Z), (const char*)(ws + WS_W2), (size_t)1024 * 1024, 0, 128, (int)gridDim.x, (int)blockIdx.x, lds, (const int*)(ws + WS_LIST)};
        EpiMoe2 E{ws + WS_Y8}; gemm_phase<true, 1>(lds, 1024, 1024, S, E);
        DenseOrder SP; SP.init(ws + WS_PB, ws + WS_WPLE, MTOK, 1024, 512, 512);
        { const LAS int* pre_ = (const LAS int*)(lds + LDS_GRP) + 128; const int n2 = (__builtin_amdgcn_readfirstlane(pre_[128]) - __builtin_amdgcn_readfirstlane(pre_[0])) * 4, G_ = (int)gridDim.x, c_ = (int)blockIdx.x;
          const int i1 = n2 > c_ ? (n2 - c_ + G_ - 1) / G_ : 0; SP.shift = i1 * G_ - n2; }
        EpiPle EP{(bf16_t*)(ws + WS_U), (float*)(ws + WS_ESS)}; gemm_phase<true, 2>(lds, 256, 256, SP, EP); }
    SYNC(7);
    if (RUN(8)) phase_combine(P, lds);
    SYNC(8);
    if (RUN(12)) { DenseOrder S; S.init(ws + WS_W2, ws + WS_WG, MTOK, 1024, 1024, 1024); EpiFinal E{P.out, (const bf16_t*)(ws + WS_HB), (const bf16_t*)(ws + WS_U), (const float*)(ws + WS_ESS), P.ple_norm_g}; gemm_phase<true, 1>(lds, 1024, 1024, S, E); }
#ifdef DIAG_PHASE
    xcd_barrier(bar); if (DIAG_PHASE == 12) dg_t1 = wall_clock64();
    __syncthreads();
    if (blockIdx.x == 0 && threadIdx.x == 0) { asm volatile("s_waitcnt vmcnt(0)" ::: "memory"); P.out[0] += (float)((((dg_t1 - dg_t0) / 100ull + DIAG_Q / 2) / DIAG_Q) * DIAG_Q); }
#endif
    __syncthreads();
    if (threadIdx.x == 0) { const unsigned old = xb_add(&g_xbar[XCD_BAR_WORDS], 1u); *(volatile LAS unsigned*)(lds + LDS_QW) = (old + 1u == gridDim.x) ? 1u : 0u; }
    __syncthreads();
    if (*(volatile LAS unsigned*)(lds + LDS_QW) != 0u) { for (int i = threadIdx.x; i < XCD_BAR_WORDS + 64; i += 512) __hip_atomic_store(&g_xbar[i], 0u, __ATOMIC_RELAXED, __HIP_MEMORY_SCOPE_AGENT); }
}

#ifndef MK_N_LAUNCHES
#define MK_N_LAUNCHES 1
#endif
extern "C" void kernel_launch(void* const* d_in, const int* in_sizes, int n_in, void* d_out, int out_size, void* d_ws, size_t ws_size, hipStream_t stream) {
    static int grid = 0;
    if (grid == 0) {
        if (n_in != 33 || in_sizes[0] != MTOK * D_MODEL || out_size != MTOK * D_MODEL || ws_size < WS_END) {
            fprintf(stderr, "kernel_launch: shape mismatch: n_in %d in0 %d out %d ws %zu (need %zu)\n", n_in, n_in > 0 ? in_sizes[0] : -1, out_size, ws_size, (size_t)WS_END); grid = -1; return; }
        int dev = 0, cus = 0, per_cu = 0;
        if (hipGetDevice(&dev) != hipSuccess || hipDeviceGetAttribute(&cus, hipDeviceAttributeMultiprocessorCount, dev) != hipSuccess) { grid = -1; return; }
        if (hipFuncSetAttribute((const void*)mega, hipFuncAttributeMaxDynamicSharedMemorySize, LDS_BYTES) != hipSuccess) { fprintf(stderr, "kernel_launch: hipFuncSetAttribute failed\n"); grid = -1; return; }
        if (hipOccupancyMaxActiveBlocksPerMultiprocessor(&per_cu, (const void*)mega, 512, LDS_BYTES) != hipSuccess || per_cu < 1) fprintf(stderr, "kernel_launch: occupancy query says %d\n", per_cu);
        (void)hipGetLastError();
        grid = cus;
    }
    if (grid < 0) return;
    Params p{};
    const float** f = (const float**)&p;
    for (int i = 0; i < 33; ++i) f[i] = (const float*)d_in[i];
    p.out = (float*)d_out; p.ws = (unsigned char*)d_ws;
    if (MK_N_LAUNCHES == 1) { p.ph_lo = 0; p.ph_hi = N_PHASES; hipLaunchKernelGGL(mega, dim3(grid), dim3(512), LDS_BYTES, stream, p); }
    else for (int k = 0; k < N_PHASES; ++k) { p.ph_lo = k; p.ph_hi = k + 1; hipLaunchKernelGGL(mega, dim3(grid), dim3(512), LDS_BYTES, stream, p); }
    const hipError_t le = hipPeekAtLastError();
    if (le != hipSuccess) fprintf(stderr, "kernel_launch: launch failed: %s\n", hipGetErrorName(le));
}
```

```cpp
#include <hip/hip_runtime.h>
#include <stdint.h>
#include <stdio.h>

#define LAS __attribute__((address_space(3)))
#define DI __device__ __forceinline__
typedef unsigned short bf16_t;
typedef short bf16x8 __attribute__((ext_vector_type(8)));
typedef short s16x4 __attribute__((ext_vector_type(4)));
typedef float f32x4 __attribute__((ext_vector_type(4)));
typedef float f32x2 __attribute__((ext_vector_type(2)));
typedef float f32x16 __attribute__((ext_vector_type(16)));
typedef unsigned u32x4 __attribute__((ext_vector_type(4)));
typedef unsigned u32x2 __attribute__((ext_vector_type(2)));
typedef __bf16 bf16x2_t __attribute__((ext_vector_type(2)));

constexpr int D_MODEL = 1024, BATCH = 8, SEQ = 8192, MTOK = BATCH * SEQ;
constexpr int PLE_DIM = 256;
constexpr int C_RW = 512, RW_HEAD = 64, RW_HEADS = 8, RW_COLS = 1920;
constexpr int C_DA = 512, DA_HEADS = 4, DA_V = 128, DA_QK = 64;
constexpr int IN_COLS = 3456, IN_PAD = 3584;
constexpr int N_EXP = 32, TOPK = 4, D_FF = 1024;
constexpr int ZR = 0, ZK = 512, ZV = 1024, ZWD = 1536, ZAD = 1664, ZGD = 1792, ZQ = 1920, ZKK = 2432, ZVV = 2944;
constexpr float NORM_EPS = 1e-6f;
constexpr float LOG2E = 1.4426950408889634f;

constexpr size_t MiB = 1024ull * 1024ull;
constexpr size_t WS_CTL = 0;
constexpr size_t CTL_BYTES = 64 * 1024;
constexpr size_t WS_WIN = WS_CTL + CTL_BYTES;
constexpr size_t WS_WOUT = WS_WIN + (size_t)IN_PAD * 1024 * 2;
constexpr size_t WS_W1 = WS_WOUT + 2 * MiB;
constexpr size_t WS_W2 = WS_W1 + 128 * MiB;
constexpr size_t WS_WPLE = WS_W2 + 64 * MiB;
constexpr size_t WS_WG = WS_WPLE + MiB / 2;
constexpr size_t WS_PB = WS_WG + 2 * MiB;
constexpr size_t WS_U = WS_PB + 32 * MiB;
constexpr size_t WS_Z = WS_U + 128 * MiB;
constexpr size_t WS_Y8 = WS_Z + 288 * MiB;
constexpr size_t WS_HB = WS_W1;
constexpr size_t WS_O = WS_Z + 432 * MiB;
constexpr size_t WS_LIST = WS_Z + 576 * MiB;
constexpr size_t WS_GATE = WS_LIST + 32 * MiB;
constexpr size_t WS_ESS = WS_GATE + MiB;
constexpr size_t WS_XL = WS_ESS + MiB / 4;
constexpr size_t WS_TOKPOS = WS_XL;
constexpr size_t WS_END = WS_XL + 48 * MiB;
constexpr int ACT_ROWS_MAX = 262144 + 128 * 256;

constexpr int CW_BAR = 0;
constexpr int CW_CNT = 4096;
constexpr int CW_QUEUE = 4352;
constexpr int CW_LAM = 4416;
constexpr int CW_RWFLAG = 4480;

struct Params {
    const float* x; const float* p; const float* norm_mix_g; const float* w_in; const float* rw_mu; const float* rw_w0; const float* rw_w2;
    const float* rw_a0; const float* rw_a2; const float* rw_g2; const float* rw_k_k; const float* rw_k_a; const float* rw_r_k; const float* rw_ln_g;
    const float* rw_ln_b; const float* da_q_norm_g; const float* da_k_norm_g; const float* da_lq1; const float* da_lk1; const float* da_lq2;
    const float* da_lk2; const float* da_subln_g; const float* w_out; const float* norm_ffn_g; const float* w_router; const float* b_router;
    const float* w1; const float* b1; const float* w2; const float* b2; const float* w_ple; const float* ple_norm_g; const float* w_ple_gate;
    float* out; unsigned char* ws; int ph_lo, ph_hi;
};

DI unsigned cvt_pk(float lo, float hi) { f32x2 v = {lo, hi}; bf16x2_t r = __builtin_convertvector(v, bf16x2_t); return __builtin_bit_cast(unsigned, r); }
DI unsigned pk4_fp8(float a, float b, float c, float d) { int v = __builtin_amdgcn_cvt_pk_fp8_f32(a, b, 0, false); v = __builtin_amdgcn_cvt_pk_fp8_f32(c, d, v, true); return (unsigned)v; }
DI bf16x8 pack8(float a0, float a1, float a2, float a3, float a4, float a5, float a6, float a7) { u32x4 w = {cvt_pk(a0, a1), cvt_pk(a2, a3), cvt_pk(a4, a5), cvt_pk(a6, a7)}; return __builtin_bit_cast(bf16x8, w); }
DI float bf_lo(unsigned u) { return __uint_as_float(u << 16); }
DI float bf_hi(unsigned u) { return __uint_as_float(u & 0xffff0000u); }
DI float bf2f(bf16_t b) { return __uint_as_float(((unsigned)b) << 16); }
DI bf16_t f2bf(float f) { return (bf16_t)(cvt_pk(f, f) & 0xffffu); }
template <int CTRL, int RM> DI float dpp_mov0(float v) { return __builtin_bit_cast(float, __builtin_amdgcn_update_dpp(0, __builtin_bit_cast(int, v), CTRL, RM, 0xF, false)); }
DI float row_sum16(float v) {
    v += dpp_mov0<0x121, 0xF>(v); v += dpp_mov0<0x122, 0xF>(v); v += dpp_mov0<0x124, 0xF>(v); v += dpp_mov0<0x128, 0xF>(v); return v;
}
DI float wave_sum(float v) {
    v = row_sum16(v);
    v += dpp_mov0<0x142, 0xA>(v);
    v += dpp_mov0<0x143, 0xC>(v);
    return __builtin_bit_cast(float, __builtin_amdgcn_readlane(__builtin_bit_cast(int, v), 63));
}
DI float xsum16(float v) { const unsigned u = __builtin_bit_cast(unsigned, v); auto r = __builtin_amdgcn_permlane16_swap(u, u, false, false); return __builtin_bit_cast(float, (unsigned)r[0]) + __builtin_bit_cast(float, (unsigned)r[1]); }
DI float xsum32(float v) { const unsigned u = __builtin_bit_cast(unsigned, v); auto r = __builtin_amdgcn_permlane32_swap(u, u, false, false); return __builtin_bit_cast(float, (unsigned)r[0]) + __builtin_bit_cast(float, (unsigned)r[1]); }
DI float wave_max(float v) {
    v = fmaxf(v, dpp_mov0<0x121, 0xF>(v)); v = fmaxf(v, dpp_mov0<0x122, 0xF>(v)); v = fmaxf(v, dpp_mov0<0x124, 0xF>(v)); v = fmaxf(v, dpp_mov0<0x128, 0xF>(v));
    const unsigned u = __builtin_bit_cast(unsigned, v); auto r = __builtin_amdgcn_permlane16_swap(u, u, false, false); v = fmaxf(__builtin_bit_cast(float, (unsigned)r[0]), __builtin_bit_cast(float, (unsigned)r[1]));
    const unsigned w = __builtin_bit_cast(unsigned, v); auto q = __builtin_amdgcn_permlane32_swap(w, w, false, false); return fmaxf(__builtin_bit_cast(float, (unsigned)q[0]), __builtin_bit_cast(float, (unsigned)q[1]));
}
DI float sigmoidf_(float x) { return __builtin_amdgcn_rcpf(1.f + __builtin_amdgcn_exp2f(-x * LOG2E)); }

#define XB_TMO      128
#define XB_XCNT(j)  (256  + 64 * (j))
#define XB_XSUB(j)  (1280 + 64 * (j))
#define XB_XGEN(j)  (2304 + 64 * (j))
#define XB_TOP      3328
#define XB_TOPGEN   3392
#define XCD_BAR_WORDS 3456
#define XB_SPIN_CAP (1u << 22)
DI unsigned xb_ld(unsigned* p)              { return __hip_atomic_load(p, __ATOMIC_RELAXED, __HIP_MEMORY_SCOPE_AGENT); }
DI unsigned xb_add(unsigned* p, unsigned v) { return __hip_atomic_fetch_add(p, v, __ATOMIC_RELAXED, __HIP_MEMORY_SCOPE_AGENT); }
DI unsigned xb_xcc_id() { return (unsigned)__builtin_amdgcn_s_getreg((3 << 11) | 20) & 0xFu; }
#define XB_SPIN(cond, bar) do { unsigned _sp = 0; while (cond) { __builtin_amdgcn_s_sleep(1); \
    if ((++_sp & 255u) == 0u) { if (xb_ld(&(bar)[XB_TMO])) break; if (_sp > XB_SPIN_CAP) { atomicAdd(&(bar)[XB_TMO], 1u); break; } } } } while (0)
__device__ unsigned g_xbar[XCD_BAR_WORDS + 64];
struct XcdBarrier { unsigned* bar; unsigned x; volatile LAS unsigned* st; };
DI XcdBarrier xcd_barrier_post(unsigned* bar, volatile LAS unsigned* st) {
    XcdBarrier b; b.bar = bar; b.x = xb_xcc_id(); b.st = st;
    if (threadIdx.x == 0) (void)xb_add(&bar[XB_XCNT(b.x)], 1u);
    return b;
}
DI void xcd_barrier_complete(unsigned* bar, unsigned x, unsigned& nloc, unsigned& nx) {
    const unsigned G = gridDim.x * gridDim.y * gridDim.z;
    unsigned sum, cnt, mine, sp = 0u;
    for (;;) {
        sum = 0u; cnt = 0u; mine = 0u;
#pragma unroll
        for (unsigned j = 0; j < 16; ++j) { const unsigned c = xb_ld(&bar[XB_XCNT(j)]); sum += c; cnt += (c > 0u) ? 1u : 0u; mine = (j == x) ? c : mine; }
        if (sum == G) break;
        __builtin_amdgcn_s_sleep(1);
        if ((++sp & 255u) == 0u) { if (xb_ld(&bar[XB_TMO])) break; if (sp > XB_SPIN_CAP) { atomicAdd(&bar[XB_TMO], 1u); break; } }
    }
    nloc = mine > 0u ? mine : 1u; nx = cnt > 0u ? cnt : 1u;
}
DI void xcd_barrier(const XcdBarrier& b) {
    asm volatile("s_waitcnt vmcnt(0)" ::: "memory");
    __syncthreads();
    if (threadIdx.x == 0) {
        unsigned* bar = b.bar;
        __builtin_amdgcn_s_waitcnt(0);
        unsigned nloc = b.st[0], nx = b.st[1];
        if (nloc == 0u) { xcd_barrier_complete(bar, b.x, nloc, nx); b.st[0] = nloc; b.st[1] = nx; }
        const unsigned old = xb_add(&bar[XB_XSUB(b.x)], 1u);
        const unsigned gen = old / nloc;
        if (old + 1u == (gen + 1u) * nloc) {
            __builtin_amdgcn_fence(__ATOMIC_RELEASE, "agent");
            asm volatile("s_waitcnt vmcnt(0)" ::: "memory");
            const unsigned og = xb_add(&bar[XB_TOP], 1u);
            const unsigned tg = og / nx;
            if (og + 1u == (tg + 1u) * nx) xb_add(&bar[XB_TOPGEN], 1u);
            else XB_SPIN(xb_ld(&bar[XB_TOPGEN]) == tg, bar);
            __builtin_amdgcn_fence(__ATOMIC_ACQUIRE, "agent");
            xb_add(&bar[XB_XGEN(b.x)], 1u);
            asm volatile("s_waitcnt vmcnt(0)" ::: "memory");
        } else {
            XB_SPIN(xb_ld(&bar[XB_XGEN(b.x)]) == gen, bar);
            __builtin_amdgcn_fence(__ATOMIC_ACQUIRE, "agent");
            asm volatile("s_waitcnt vmcnt(0)" ::: "memory");
        }
    }
    __syncthreads();
}

constexpr int BM = 256, BK = 64, HALF = 128, HTB = HALF * BK * 2, STAGE_BYTES = 8 * HTB, NXCD = 8, WGM = 8;
constexpr int LDS_TAB = STAGE_BYTES;
constexpr int LDS_GRP = STAGE_BYTES + 2048;
constexpr int LDS_BYTES = 156 * 1024;
constexpr int LDS_XB = LDS_BYTES - 16;
constexpr int LDS_QW = LDS_BYTES - 32;

DI void tconv_tile(const float* __restrict__ src, int ldn, int k0, int ncol0, bool zero, bf16_t* __restrict__ dst, int K, int nrow0, float* tile  ) {
    const int t = threadIdx.x;
    {
        const int kk = t >> 4, c4 = (t & 15) * 4;
#pragma unroll
        for (int i = 0; i < 2; ++i) {
            const int k = kk + 32 * i;
            f32x4 v = {0.f, 0.f, 0.f, 0.f};
            if (!zero) v = *(const f32x4*)(src + (size_t)(k0 + k) * ldn + ncol0 + c4);
            tile[(c4 + 0) * 65 + k] = v[0]; tile[(c4 + 1) * 65 + k] = v[1]; tile[(c4 + 2) * 65 + k] = v[2]; tile[(c4 + 3) * 65 + k] = v[3];
        }
    }
    __syncthreads();
    {
        const int n = t >> 3, kc = (t & 7) * 8;
        const float* r = tile + n * 65 + kc;
        u32x4 o = {cvt_pk(r[0], r[1]), cvt_pk(r[2], r[3]), cvt_pk(r[4], r[5]), cvt_pk(r[6], r[7])};
        *(u32x4*)(dst + (size_t)(nrow0 + n) * K + k0 + kc) = o;
    }
    __syncthreads();
}

DI void tconv_tile8(const float* __restrict__ src, int ldn, int k0, int ncol0, unsigned char* __restrict__ dst, int K, int nrow0, float sc, float* tile) {
    const int t = threadIdx.x;
    {
        const int kk = t >> 4, c4 = (t & 15) * 4;
#pragma unroll
        for (int i = 0; i < 2; ++i) {
            const int k = kk + 32 * i;
            const f32x4 v = *(const f32x4*)(src + (size_t)(k0 + k) * ldn + ncol0 + c4);
            tile[(c4 + 0) * 65 + k] = v[0]; tile[(c4 + 1) * 65 + k] = v[1]; tile[(c4 + 2) * 65 + k] = v[2]; tile[(c4 + 3) * 65 + k] = v[3];
        }
    }
    __syncthreads();
    {
        const int n = t >> 3, kc = (t & 7) * 8;
        const float* r = tile + n * 65 + kc;
        u32x2 o = {pk4_fp8(r[0] * sc, r[1] * sc, r[2] * sc, r[3] * sc), pk4_fp8(r[4] * sc, r[5] * sc, r[6] * sc, r[7] * sc)};
        *(u32x2*)(dst + (size_t)(nrow0 + n) * K + k0 + kc) = o;
    }
    __syncthreads();
}
constexpr float W8_SCALE = 64.0f, M8_SCALE = 16.0f, A8_SCALE = 4.0f, Y8_SCALE = 16.0f, E8_SCALE = 16.0f;

DI void phase_prep(const Params& P, unsigned char* lds_generic) {
    float* tile = (float*)lds_generic;
    const int wg = blockIdx.x, nwg = gridDim.x;
    unsigned char* ws = P.ws;
    constexpr int J0 = 16 * 56, J1 = J0 + 256, J2 = J1 + 32 * 16 * 32, J3 = J2 + 32 * 16 * 16, J4 = J3 + 64, J5 = J4 + 256;
    for (int j = wg; j < J5; j += nwg) {
        if (j < J0) { const int kt = j / 56, nt = j % 56; tconv_tile(P.w_in, IN_COLS, kt * 64, nt * 64, nt >= 54, (bf16_t*)(ws + WS_WIN), 1024, nt * 64, tile); }
        else if (j < J1) { const int q = j - J0, kt = q >> 4, nt = q & 15; tconv_tile(P.w_out, 1024, kt * 64, nt * 64, false, (bf16_t*)(ws + WS_WOUT), 1024, nt * 64, tile); }
        else if (j < J2) { const int q = j - J1, e = q >> 9, r = q & 511, kt = r >> 5, nt = r & 31; const int n0 = nt * 64;
            const int orig = ((n0 & 128) ? 1024 : 0) + (n0 >> 8) * 128 + (n0 & 127);
            tconv_tile8(P.w1 + (size_t)e * 1024 * 2048, 2048, kt * 64, orig, ws + WS_W1 + (size_t)e * 2048 * 1024, 1024, n0, W8_SCALE, tile); }
        else if (j < J3) { const int q = j - J2, e = q >> 8, r = q & 255, kt = r >> 4, nt = r & 15;
            tconv_tile8(P.w2 + (size_t)e * 1024 * 1024, 1024, kt * 64, nt * 64, ws + WS_W2 + (size_t)e * 1024 * 1024, 1024, nt * 64, W8_SCALE, tile); }
        else if (j < J4) { const int q = j - J3, kt = q >> 4, nt = q & 15; tconv_tile(P.w_ple, 1024, kt * 64, nt * 64, false, (bf16_t*)(ws + WS_WPLE), 256, nt * 64, tile); }
        else { const int q = j - J4, kt = q >> 4, nt = q & 15; tconv_tile8(P.w_ple_gate, 1024, kt * 64, nt * 64, ws + WS_WG, 1024, nt * 64, W8_SCALE, tile); }
    }
    {
        const int wid = __builtin_amdgcn_readfirstlane(threadIdx.x >> 6), lane = threadIdx.x & 63;
        f32x4 g[4];
#pragma unroll
        for (int i = 0; i < 4; ++i) g[i] = *(const f32x4*)(P.norm_mix_g + 4 * lane + 256 * i);
        bf16_t* U = (bf16_t*)(ws + WS_U);
        const int rstep = nwg * 8; int row = wg * 8 + wid;
        f32x4 vn[4];
#pragma unroll
        for (int i = 0; i < 4; ++i) vn[i] = (row < MTOK) ? *(const f32x4*)(P.x + (size_t)row * 1024 + 4 * lane + 256 * i) : (f32x4){0.f, 0.f, 0.f, 0.f};
        for (; row < MTOK; row += rstep) {
            f32x4 v[4]; float ss = 0.f;
#pragma unroll
            for (int i = 0; i < 4; ++i) { v[i] = vn[i]; ss += v[i][0] * v[i][0] + v[i][1] * v[i][1] + v[i][2] * v[i][2] + v[i][3] * v[i][3]; }
            const int rn = row + rstep;
            if (rn < MTOK) {
#pragma unroll
                for (int i = 0; i < 4; ++i) vn[i] = *(const f32x4*)(P.x + (size_t)rn * 1024 + 4 * lane + 256 * i);
            }
            ss = wave_sum(ss);
            const float rinv = __builtin_amdgcn_rsqf(ss * (1.f / 1024.f) + NORM_EPS);
#pragma unroll
            for (int i = 0; i < 4; ++i) {
                u32x2 o = {cvt_pk(v[i][0] * rinv * g[i][0], v[i][1] * rinv * g[i][1]), cvt_pk(v[i][2] * rinv * g[i][2], v[i][3] * rinv * g[i][3])};
                *(u32x2*)(U + (size_t)row * 1024 + 4 * lane + 256 * i) = o;
            }
        }
    }
    { unsigned* ctl = (unsigned*)(ws + WS_CTL); for (int i = wg * 512 + (int)threadIdx.x; i < (int)(CTL_BYTES / 4) - CW_CNT; i += nwg * 512) ctl[CW_CNT + i] = 0u; }
    { float* ESS = (float*)(ws + WS_ESS); for (int i = wg * 512 + (int)threadIdx.x; i < MTOK; i += nwg * 512) ESS[i] = 0.f; }
    {
        bf16_t* PB = (bf16_t*)(ws + WS_PB);
        const size_t n8 = (size_t)MTOK * PLE_DIM / 8;
        for (size_t i = (size_t)wg * 512 + threadIdx.x; i < n8; i += (size_t)nwg * 512) {
            const f32x4 a = *(const f32x4*)(P.p + i * 8), b = *(const f32x4*)(P.p + i * 8 + 4);
            u32x4 o = {cvt_pk(a[0], a[1]), cvt_pk(a[2], a[3]), cvt_pk(b[0], b[1]), cvt_pk(b[2], b[3])};
            *(u32x4*)(PB + i * 8) = o;
        }
    }
}

DI int lds_byte(int r, int c) { const int st = (r >> 4) * 2 + (c >> 5), rr = r & 15, cc = c & 31, ob = rr * 64 + cc * 2; return st * 1024 + (ob ^ (((ob >> 9) & 1) << 5)); }
DI void stage_rc(int b, int& R, int& C) { const int st = b / 1024, sb = b % 1024, swz = sb ^ (((sb >> 9) & 1) << 5); R = (st >> 1) * 16 + swz / 64; C = (st & 1) * 32 + (swz % 64) / 2; }
DI int perm32(int rho) { const int n = rho >> 4, i = rho & 15; return 8 * (i >> 2) + 4 * n + (i & 3); }

struct Unit { unsigned ao, bo; int pm, pn, g, cnt, arow; };
typedef f32x4 AccT[2][2][4][2];

struct DenseOrder {
    const char* A; const char* B; int nM, nN, nwg, G, c; size_t astep, bstep; int shift = 0;
    DI void init(const void* A_, const void* B_, int M, int N, int lda_bytes, int ldb_bytes) { A = (const char*)A_; B = (const char*)B_; nM = M / BM; nN = N / BM; nwg = nM * nN; G = gridDim.x; c = blockIdx.x; astep = (size_t)BM * lda_bytes; bstep = (size_t)BM * ldb_bytes; }
    static constexpr bool GATHER = false;
    DI bool next(int i, Unit& u) const {
        const long L = (long)i * G + c + shift; if (L >= nwg) return false;
        int wgid = (int)L; { const int q = nwg / NXCD, r = nwg % NXCD, xcd = wgid % NXCD, off = wgid / NXCD; wgid = (xcd < r ? xcd * (q + 1) : r * (q + 1) + (xcd - r) * q) + off; }
        const int nig = WGM * nN, gid = wgid / nig, fm = gid * WGM, gsz = (nM - fm) < WGM ? (nM - fm) : WGM;
        u.pm = fm + ((wgid % nig) % gsz); u.pn = (wgid % nig) / gsz; u.ao = (unsigned)((size_t)u.pm * astep); u.bo = (unsigned)((size_t)u.pn * bstep); u.g = 0; u.cnt = 256; u.arow = u.pm * 256; return true;
    }
    DI void issue_table(const Unit&, LAS unsigned char*) const {}
    DI unsigned row_off(const Unit&, LAS unsigned char*, int) const { return 0u; }
};

struct PleTailOrder {
    const char* A; const char* B; int u0, u1, u2;
    static constexpr bool GATHER = false;
    DI void init(const void* A_, const void* B_, int sl, int moe_units) {
        A = (const char*)A_; B = (const char*)B_; const int G = gridDim.x, c = blockIdx.x, r = moe_units % G, nidle = G - r, k = c - r;
        u0 = u1 = u2 = -1;
        if (k >= 0) { if (k < 256) u0 = 256 * sl + k; if (k + nidle < 256) u1 = 256 * sl + k + nidle; }
        const int rest0 = 2 * nidle;
        if (rest0 + c < 256) u2 = 256 * sl + rest0 + c;
        if (u0 < 0) { u0 = u1; u1 = -1; } if (u0 < 0) { u0 = u2; u2 = -1; } if (u1 < 0) { u1 = u2; u2 = -1; }
    }
    DI bool next(int i, Unit& u) const {
        const int L = i == 0 ? u0 : i == 1 ? u1 : i == 2 ? u2 : -1; if (L < 0) return false;
        u.pm = L >> 2; u.pn = L & 3; u.ao = (unsigned)u.pm * (256u * 512u); u.bo = (unsigned)u.pn * (256u * 512u); u.g = 0; u.cnt = 256; u.arow = u.pm * 256; return true;
    }
    DI void issue_table(const Unit&, LAS unsigned char*) const {}
    DI unsigned row_off(const Unit&, LAS unsigned char*, int) const { return 0u; }
};

#define G_WAIT_V(n) asm volatile("s_waitcnt vmcnt(" #n ")" ::: "memory")
#define G_WAIT_L(n) asm volatile("s_waitcnt lgkmcnt(" #n ")" ::: "memory")
#define G_BAR __builtin_amdgcn_s_barrier()
#define G_SCHED __builtin_amdgcn_sched_barrier(0)

typedef int i32x8 __attribute__((ext_vector_type(8)));
typedef unsigned u32x8 __attribute__((ext_vector_type(8)));
template <bool OPQ, int EB, class Sched, class Epi>
DI void gemm_phase(LAS unsigned char* lds, const int K_  , const int lda_  , const Sched& S, const Epi& E) {
    int K = K_, lda = lda_; if constexpr (OPQ) asm volatile("" : "+s"(K), "+s"(lda));
    const int tid = threadIdx.x, wid = __builtin_amdgcn_readfirstlane(tid >> 6), lane = tid & 63, wr = wid >> 2, wc = wid & 3, fr = lane & 15, fq = lane >> 4;
    const int nt = K * EB / (BK * 2);
    unsigned vA[2][2], voffB[2]; int R0 = 0, C0 = 0;
#pragma unroll
    for (int i = 0; i < 2; ++i) { int R, C; stage_rc(tid * 16 + i * 8192, R, C); const int Rb = Epi::REMAP ? (64 * (R >> 5) + perm32(R & 31)) : Epi::PERM ? ((R & ~31) + perm32(R & 31)) : R;
        if (i == 0) { R0 = R; C0 = C; } voffB[i] = (unsigned)(Rb * K * EB + C * 2);
        vA[0][i] = (unsigned)(R * lda * EB + C * 2); vA[1][i] = (unsigned)((R + HALF) * lda * EB + C * 2); }
    const unsigned kstep = BK * 2;
    const unsigned hstepB = (unsigned)((Epi::REMAP ? 32 : HALF) * K * EB);
    const __amdgpu_buffer_rsrc_t rsA = __builtin_amdgcn_make_buffer_rsrc((void*)S.A, 0, 0x7ffffff0, 0x00020000), rsB = __builtin_amdgcn_make_buffer_rsrc((void*)S.B, 0, 0x7ffffff0, 0x00020000);
    const unsigned ldsw = (unsigned)wid * 1024u;
    const int aoff = lds_byte(wr * 64 + fr, fq * 8), boff = lds_byte(wc * 32 + fr, fq * 8);
#define G_SA(b, h) (((b) * 2 + (h)) * HTB)
#define G_SB(b, h) ((4 + (b) * 2 + (h)) * HTB)
#define G_STAGE(bufoff, rs, so, v0, v1) do { \
        __builtin_amdgcn_raw_ptr_buffer_load_lds(rs, (LAS void*)(lds + (bufoff) + ldsw), 16, (int)(v0), (int)(so), 0, 0); \
        __builtin_amdgcn_raw_ptr_buffer_load_lds(rs, (LAS void*)(lds + (bufoff) + ldsw + 8192), 16, (int)(v1), (int)(so), 0, 0); } while (0)
#define G_LD16(off) (*(const LAS u32x4*)(lds + (off)))
#define G_LDA(dst, b, h) do { _Pragma("unroll") for (int m = 0; m < 4; ++m) { if constexpr (EB == 2) { dst[m].pq[0] = G_LD16(G_SA(b, h) + aoff + m * 2048); dst[m].pq[1] = G_LD16(G_SA(b, h) + aoff + m * 2048 + 1024); } \
        else dst[m].w8 = __builtin_shufflevector(G_LD16(G_SA(b, h) + aoff + m * 2048), G_LD16(G_SA(b, h) + aoff + m * 2048 + 1024), 0, 1, 2, 3, 4, 5, 6, 7); } } while (0)
#define G_LDB(dst, b, h) do { _Pragma("unroll") for (int n = 0; n < 2; ++n) { if constexpr (EB == 2) { dst[n].pq[0] = G_LD16(G_SB(b, h) + boff + n * 2048); dst[n].pq[1] = G_LD16(G_SB(b, h) + boff + n * 2048 + 1024); } \
        else dst[n].w8 = __builtin_shufflevector(G_LD16(G_SB(b, h) + boff + n * 2048), G_LD16(G_SB(b, h) + boff + n * 2048 + 1024), 0, 1, 2, 3, 4, 5, 6, 7); } } while (0)
#define G_MMA(ai, bj, At, Bt) do { __builtin_amdgcn_s_setprio(1); _Pragma("unroll") for (int m = 0; m < 4; ++m) _Pragma("unroll") for (int n = 0; n < 2; ++n) { \
        if constexpr (EB == 2) { _Pragma("unroll") for (int k = 0; k < 2; ++k) acc[ai][bj][m][n] = __builtin_amdgcn_mfma_f32_16x16x32_bf16(__builtin_bit_cast(bf16x8, Bt[n].pq[k]), __builtin_bit_cast(bf16x8, At[m].pq[k]), acc[ai][bj][m][n], 0, 0, 0); } \
        else acc[ai][bj][m][n] = __builtin_amdgcn_mfma_scale_f32_16x16x128_f8f6f4(__builtin_bit_cast(i32x8, Bt[n].w8), __builtin_bit_cast(i32x8, At[m].w8), acc[ai][bj][m][n], 0, 0, 0, 0, 0, 0); } \
        __builtin_amdgcn_s_setprio(0); } while (0)
    Unit cur, nxt; int ui = 0;
    if (!S.next(0, cur)) return;
#ifndef GEMM_STAGGER_TICKS
#define GEMM_STAGGER_TICKS 0
#endif
    if (GEMM_STAGGER_TICKS > 0) {
        const unsigned long long t0 = __builtin_amdgcn_s_memrealtime(), wait = (unsigned long long)((blockIdx.x >> 3) & 3) * GEMM_STAGGER_TICKS;
        while (__builtin_amdgcn_s_memrealtime() - t0 < wait) __builtin_amdgcn_s_sleep(16);
    }
    AccT acc;
#pragma unroll
    for (int a = 0; a < 2; ++a)
#pragma unroll
        for (int b = 0; b < 2; ++b)
#pragma unroll
            for (int m = 0; m < 4; ++m)
#pragma unroll
                for (int n = 0; n < 2; ++n) { acc[a][b][m][n] = (f32x4){0.f, 0.f, 0.f, 0.f}; if constexpr (EB == 1) asm volatile("" : "+v"(acc[a][b][m][n])); }
    union Frag { u32x4 pq[2]; u32x8 w8; };
    Frag At[4], B0[2], B1[2];
    unsigned cA = cur.ao, cB = cur.bo;
    if constexpr (Sched::GATHER) {
        S.issue_table(cur, lds + LDS_TAB);
        G_WAIT_V(0); __syncthreads();
#pragma unroll
        for (int h = 0; h < 2; ++h)
#pragma unroll
            for (int i = 0; i < 2; ++i) { vA[h][i] = S.row_off(cur, lds + LDS_TAB, R0 + 64 * i + HALF * h) + (unsigned)C0 * 2u; }
    }
    G_STAGE(G_SB(0, 0), rsB, cB, voffB[0], voffB[1]); G_STAGE(G_SA(0, 0), rsA, cA, vA[0][0], vA[0][1]); G_STAGE(G_SB(0, 1), rsB, cB + hstepB, voffB[0], voffB[1]); G_STAGE(G_SA(0, 1), rsA, cA, vA[1][0], vA[1][1]);
    if (wr == 1) G_BAR;
    G_WAIT_V(4); G_BAR;
    G_STAGE(G_SB(1, 0), rsB, cB + kstep, voffB[0], voffB[1]); G_STAGE(G_SA(1, 0), rsA, cA + kstep, vA[0][0], vA[0][1]); G_STAGE(G_SB(1, 1), rsB, cB + hstepB + kstep, voffB[0], voffB[1]);
    G_WAIT_V(6); G_BAR;
    for (;;) {
        const bool has_next = S.next(ui + 1, nxt);
        const unsigned nA = has_next ? nxt.ao : cA, nB = has_next ? nxt.bo : cB;
        for (int t = 0; t < nt; t += 2) {
            const bool last = (t == nt - 2);
            const unsigned a1 = cA + (unsigned)(t + 1) * kstep;
            const unsigned a2 = last ? nA : cA + (unsigned)(t + 2) * kstep, b2 = last ? nB : cB + (unsigned)(t + 2) * kstep;
            const unsigned a3 = a2 + kstep, b3 = b2 + kstep;
            if constexpr (Sched::GATHER) {
                if (t == 0 && has_next) S.issue_table(nxt, lds + LDS_TAB + ((ui + 1) & 1) * 1024);
            }
            G_LDB(B0, 0, 0); G_SCHED; G_LDA(At, 0, 0); G_STAGE(G_SA(1, 1), rsA, a1, vA[1][0], vA[1][1]);
            if (last && has_next) {
                int tz = threadIdx.x; asm volatile("" : "+v"(tz)); int Rz, Cz; stage_rc(tz * 16, Rz, Cz);
#pragma unroll
                for (int h = 0; h < 2; ++h)
#pragma unroll
                    for (int i = 0; i < 2; ++i) {
                        if constexpr (Sched::GATHER) vA[h][i] = S.row_off(nxt, lds + LDS_TAB + ((ui + 1) & 1) * 1024, Rz + 64 * i + HALF * h) + (unsigned)Cz * 2u;
                        else vA[h][i] = (unsigned)((Rz + 64 * i + HALF * h) * lda * EB + Cz * 2);
                    }
            }
            G_WAIT_L(8); G_BAR; G_WAIT_L(0); G_MMA(0, 0, At, B0); G_BAR; G_SCHED;
            G_LDB(B1, 0, 1); G_STAGE(G_SB(0, 0), rsB, b2, voffB[0], voffB[1]);
            G_BAR; G_WAIT_L(0); G_MMA(0, 1, At, B1); G_BAR;
            G_LDA(At, 0, 1); G_STAGE(G_SA(0, 0), rsA, a2, vA[0][0], vA[0][1]);
            G_BAR; G_WAIT_L(0); G_MMA(1, 0, At, B0); G_BAR; G_SCHED;
            G_STAGE(G_SB(0, 1), rsB, b2 + hstepB, voffB[0], voffB[1]);
            G_WAIT_V(6); G_BAR; G_MMA(1, 1, At, B1); G_BAR;
            G_LDB(B0, 1, 0); G_SCHED; G_LDA(At, 1, 0); G_STAGE(G_SA(0, 1), rsA, a2, vA[1][0], vA[1][1]);
            G_WAIT_L(8); G_BAR; G_WAIT_L(0); G_MMA(0, 0, At, B0); G_BAR; G_SCHED;
            G_LDB(B1, 1, 1); G_STAGE(G_SB(1, 0), rsB, b3, voffB[0], voffB[1]);
            G_BAR; G_WAIT_L(0); G_MMA(0, 1, At, B1); G_BAR;
            G_LDA(At, 1, 1); G_STAGE(G_SA(1, 0), rsA, a3, vA[0][0], vA[0][1]);
            G_BAR; G_WAIT_L(0); G_MMA(1, 0, At, B0); G_BAR; G_SCHED;
            G_STAGE(G_SB(1, 1), rsB, b3 + hstepB, voffB[0], voffB[1]);
            G_WAIT_V(6); G_BAR; G_MMA(1, 1, At, B1); G_BAR;
        }
        { int tz = threadIdx.x; asm volatile("" : "+v"(tz)); const int wz = tz >> 6, lz = tz & 63; E(acc, cur, wz >> 2, wz & 3, lz & 15, lz >> 4); }
        if (!has_next) break;
#pragma unroll
        for (int a = 0; a < 2; ++a)
#pragma unroll
            for (int b = 0; b < 2; ++b)
#pragma unroll
                for (int m = 0; m < 4; ++m)
#pragma unroll
                    for (int n = 0; n < 2; ++n) { acc[a][b][m][n] = (f32x4){0.f, 0.f, 0.f, 0.f}; if constexpr (EB == 1) asm volatile("" : "+v"(acc[a][b][m][n])); }
        cur = nxt; cA = nA; cB = nB; ++ui;
    }
    G_WAIT_V(0);
    if (wr == 0) G_BAR;
    G_BAR;
}

struct EpiZ {
    static constexpr bool PERM = true, REMAP = true;
    bf16_t* Z; const float* gq; const float* gk;
    DI void operator()(const AccT& acc, const Unit& u, int wr, int wc, int fr, int fq) const {
        const int row0 = u.pm * BM + wr * 64 + fr, colw = u.pn * BM + wc * 64;
        if (colw >= IN_COLS) return;
        const bool isq = colw >= ZQ && colw < ZKK, isk = colw >= ZKK && colw < ZVV;
        float g[2][8];
        if (isq || isk) { const float* gp = (isq ? gq : gk) + 8 * fq; const float sc = isq ? 0.125f * LOG2E : 1.0f;
#pragma unroll
            for (int bj = 0; bj < 2; ++bj)
#pragma unroll
                for (int j = 0; j < 8; ++j) g[bj][j] = gp[32 * bj + j] * sc; }
#pragma unroll
        for (int ai = 0; ai < 2; ++ai)
#pragma unroll
            for (int m = 0; m < 4; ++m) { bf16_t* rowp = Z + (size_t)(row0 + ai * HALF + m * 16) * IN_COLS + colw + 8 * fq;
                float v[2][8];
#pragma unroll
                for (int bj = 0; bj < 2; ++bj)
#pragma unroll
                    for (int j = 0; j < 8; ++j) v[bj][j] = acc[ai][bj][m][j >> 2][j & 3];
                if (isq || isk) { float ss = 0.f;
#pragma unroll
                    for (int bj = 0; bj < 2; ++bj)
#pragma unroll
                        for (int j = 0; j < 8; ++j) ss += v[bj][j] * v[bj][j];
                    ss = xsum32(xsum16(ss));
                    const float rinv = __builtin_amdgcn_rsqf(ss * (1.f / 64.f) + NORM_EPS);
#pragma unroll
                    for (int bj = 0; bj < 2; ++bj)
#pragma unroll
                        for (int j = 0; j < 8; ++j) v[bj][j] *= rinv * g[bj][j]; }
#pragma unroll
                for (int bj = 0; bj < 2; ++bj) *(u32x4*)(rowp + 32 * bj) = (u32x4){cvt_pk(v[bj][0], v[bj][1]), cvt_pk(v[bj][2], v[bj][3]), cvt_pk(v[bj][4], v[bj][5]), cvt_pk(v[bj][6], v[bj][7])};
            }
    }
};
struct EpiNone {
    static constexpr bool PERM = true, REMAP = false;
    float* sink;
    DI void operator()(const AccT& acc, const Unit& u, int wr, int wc, int fr, int fq) const {
        float t = 0.f;
#pragma unroll
        for (int ai = 0; ai < 2; ++ai)
#pragma unroll
            for (int bj = 0; bj < 2; ++bj)
#pragma unroll
                for (int m = 0; m < 4; ++m)
#pragma unroll
                    for (int n = 0; n < 2; ++n) t += acc[ai][bj][m][n][0] + acc[ai][bj][m][n][1] + acc[ai][bj][m][n][2] + acc[ai][bj][m][n][3];
        if (t == 123456.789f) sink[0] = t;
    }
};
struct EpiH1 {
    static constexpr bool PERM = true, REMAP = true;
    const float* X; bf16_t* H;
    DI void operator()(const AccT& acc, const Unit& u, int wr, int wc, int fr, int fq) const {
        const int row0 = u.pm * BM + wr * 64 + fr, col0 = u.pn * BM + wc * 64 + 8 * fq;
#pragma unroll
        for (int ai = 0; ai < 2; ++ai)
#pragma unroll
            for (int m = 0; m < 4; ++m) { const size_t ro = (size_t)(row0 + ai * HALF + m * 16) * 1024 + col0;
#pragma unroll
                for (int bj = 0; bj < 2; ++bj) { const f32x4 x0 = *(const f32x4*)(X + ro + bj * 32), x1 = *(const f32x4*)(X + ro + bj * 32 + 4);
                    const f32x4 h0 = x0 + acc[ai][bj][m][0], h1 = x1 + acc[ai][bj][m][1];
                    *(u32x4*)(H + ro + bj * 32) = (u32x4){cvt_pk(h0[0], h0[1]), cvt_pk(h0[2], h0[3]), cvt_pk(h1[0], h1[1]), cvt_pk(h1[2], h1[3])}; } }
    }
};
struct EpiMoe1 {
    static constexpr bool PERM = true, REMAP = false;
    unsigned char* ACT; const float* b1;
    DI void operator()(const AccT& acc, const Unit& u, int wr, int wc, int fr, int fq) const {
        const int e = u.g & 31, cb = u.pn * 128 + wc * 32 + 8 * fq;
        const float* bg = b1 + (size_t)e * 2048 + cb; const float* bl = bg + 1024;
        const f32x4 bg0 = *(const f32x4*)bg, bg1 = *(const f32x4*)(bg + 4), bl0 = *(const f32x4*)bl, bl1 = *(const f32x4*)(bl + 4);
        constexpr float sc = 1.0f / (W8_SCALE * M8_SCALE);
#pragma unroll
        for (int ai = 0; ai < 2; ++ai) {
            unsigned pw_[4][2];
#pragma unroll
            for (int m = 0; m < 4; ++m) {
                float o[8];
#pragma unroll
                for (int n = 0; n < 2; ++n)
#pragma unroll
                    for (int pj = 0; pj < 2; ++pj) {
                        const f32x4 ag = acc[ai][0][m][n], al = acc[ai][1][m][n], bgv = n ? bg1 : bg0, blv = n ? bl1 : bl0;
                        f32x2 glu = (f32x2){ag[2 * pj], ag[2 * pj + 1]} * sc + (f32x2){bgv[2 * pj], bgv[2 * pj + 1]};
                        f32x2 lin = (f32x2){al[2 * pj], al[2 * pj + 1]} * sc + (f32x2){blv[2 * pj], blv[2 * pj + 1]};
                        glu = (f32x2){fminf(glu[0], 7.0f), fminf(glu[1], 7.0f)}; lin = (f32x2){fminf(fmaxf(lin[0], -7.0f), 7.0f), fminf(fmaxf(lin[1], -7.0f), 7.0f)};
                        const f32x2 ex = glu * (-1.702f * LOG2E);
                        const f32x2 den = (f32x2){__builtin_amdgcn_exp2f(ex[0]), __builtin_amdgcn_exp2f(ex[1])} + 1.0f;
                        const f32x2 sg = {__builtin_amdgcn_rcpf(den[0]), __builtin_amdgcn_rcpf(den[1])};
                        const f32x2 r = (glu * sg) * (lin * A8_SCALE + A8_SCALE);
                        o[n * 4 + 2 * pj] = r[0]; o[n * 4 + 2 * pj + 1] = r[1];
                    }
                pw_[m][0] = pk4_fp8(o[0], o[1], o[2], o[3]); pw_[m][1] = pk4_fp8(o[4], o[5], o[6], o[7]);
            }
#pragma unroll
            for (int mp = 0; mp < 4; mp += 2) {
                auto s0 = __builtin_amdgcn_permlane16_swap(pw_[mp][0], pw_[mp + 1][0], false, false);
                auto s1 = __builtin_amdgcn_permlane16_swap(pw_[mp][1], pw_[mp + 1][1], false, false);
                const int rl = ai * HALF + wr * 64 + (mp + (fq & 1)) * 16 + fr;
                *(u32x4*)(ACT + (size_t)(u.arow + rl) * 1024 + u.pn * 128 + wc * 32 + (fq >> 1) * 16) = (u32x4){(unsigned)s0[0], (unsigned)s1[0], (unsigned)s0[1], (unsigned)s1[1]};
            }
        }
    }
};
struct EpiMoe2 {
    static constexpr bool PERM = true, REMAP = true;
    unsigned char* Y8;
    DI void operator()(const AccT& acc, const Unit& u, int wr, int wc, int fr, int fq) const {
        const int col0 = u.pn * BM + wc * 64 + (fq & 1) * 32 + (fq >> 1) * 16;
        constexpr float sc = Y8_SCALE / (W8_SCALE * A8_SCALE);
#pragma unroll
        for (int ai = 0; ai < 2; ++ai)
#pragma unroll
            for (int m = 0; m < 4; ++m) {
                unsigned char* yp = Y8 + (size_t)(u.arow + ai * HALF + wr * 64 + m * 16 + fr) * 1024 + col0;
                unsigned w[2][2];
#pragma unroll
                for (int bj = 0; bj < 2; ++bj) { const f32x4 a0 = acc[ai][bj][m][0] * sc, a1 = acc[ai][bj][m][1] * sc; w[bj][0] = pk4_fp8(a0[0], a0[1], a0[2], a0[3]); w[bj][1] = pk4_fp8(a1[0], a1[1], a1[2], a1[3]); }
                auto s0 = __builtin_amdgcn_permlane16_swap(w[0][0], w[1][0], false, false);
                auto s1 = __builtin_amdgcn_permlane16_swap(w[0][1], w[1][1], false, false);
                *(u32x4*)yp = (u32x4){(unsigned)s0[0], (unsigned)s1[0], (unsigned)s0[1], (unsigned)s1[1]};
            }
    }
};
struct EpiPle {
    static constexpr bool PERM = true, REMAP = true;
    unsigned char* EB; float* ESS;
    DI void operator()(const AccT& acc, const Unit& u, int wr, int wc, int fr, int fq) const {
        const int row0 = u.pm * BM + wr * 64 + fr, colS = u.pn * BM + wc * 64 + (fq & 1) * 32 + (fq >> 1) * 16;
#pragma unroll
        for (int ai = 0; ai < 2; ++ai)
#pragma unroll
            for (int m = 0; m < 4; ++m) { const int row = row0 + ai * HALF + m * 16; float ss = 0.f; unsigned w[2][2];
#pragma unroll
                for (int bj = 0; bj < 2; ++bj) { const f32x4 v0 = acc[ai][bj][m][0], v1 = acc[ai][bj][m][1];
                    ss += v0[0] * v0[0] + v0[1] * v0[1] + v0[2] * v0[2] + v0[3] * v0[3] + v1[0] * v1[0] + v1[1] * v1[1] + v1[2] * v1[2] + v1[3] * v1[3];
                    const f32x4 a0 = v0 * E8_SCALE, a1 = v1 * E8_SCALE; w[bj][0] = pk4_fp8(a0[0], a0[1], a0[2], a0[3]); w[bj][1] = pk4_fp8(a1[0], a1[1], a1[2], a1[3]); }
                auto s0 = __builtin_amdgcn_permlane16_swap(w[0][0], w[1][0], false, false);
                auto s1 = __builtin_amdgcn_permlane16_swap(w[0][1], w[1][1], false, false);
                *(u32x4*)(EB + (size_t)row * 1024 + colS) = (u32x4){(unsigned)s0[0], (unsigned)s1[0], (unsigned)s0[1], (unsigned)s1[1]};
                ss = xsum32(xsum16(ss));
                if (fq == 0) atomicAdd(ESS + row, ss);
            }
    }
};
struct EpiFinal {
    static constexpr bool PERM = true, REMAP = true;
    float* OUT; const bf16_t* HB; const unsigned char* EB; const float* ESS; const float* g;
    DI void operator()(const AccT& acc, const Unit& u, int wr, int wc, int fr, int fq) const {
        const int row0 = u.pm * BM + wr * 64 + fr, col0 = u.pn * BM + wc * 64 + 8 * fq, colS = u.pn * BM + wc * 64 + (fq & 1) * 32 + (fq >> 1) * 16;
        constexpr float gsc = 1.0f / (W8_SCALE * M8_SCALE);
        f32x4 gv[2][2];
#pragma unroll
        for (int bj = 0; bj < 2; ++bj)
#pragma unroll
            for (int n = 0; n < 2; ++n) gv[bj][n] = *(const f32x4*)(g + col0 + bj * 32 + n * 4);
#pragma unroll
        for (int ai = 0; ai < 2; ++ai)
#pragma unroll
            for (int m = 0; m < 4; ++m) { const int row = row0 + ai * HALF + m * 16; const size_t ro = (size_t)row * 1024 + col0;
                const float rinv = __builtin_amdgcn_rsqf(ESS[row] * (1.f / 1024.f) + NORM_EPS) * (1.0f / E8_SCALE);
                const u32x4 e16 = *(const u32x4*)(EB + (size_t)row * 1024 + colS);
                auto t0 = __builtin_amdgcn_permlane16_swap(e16[0], e16[2], false, false);
                auto t1 = __builtin_amdgcn_permlane16_swap(e16[1], e16[3], false, false);
#pragma unroll
                for (int bj = 0; bj < 2; ++bj) {
                    const size_t o = ro + bj * 32;
                    const u32x4 hb = *(const u32x4*)(HB + o);
#pragma unroll
                    for (int n = 0; n < 2; ++n) { const f32x4 a = acc[ai][bj][m][n], rg = gv[bj][n] * rinv; f32x4 r;
                        const int ewd = (int)(n ? t1[bj] : t0[bj]); const f32x2 elo = __builtin_amdgcn_cvt_pk_f32_fp8(ewd, false), ehi = __builtin_amdgcn_cvt_pk_f32_fp8(ewd, true);
#pragma unroll
                        for (int pj = 0; pj < 2; ++pj) {
                            const unsigned hw = hb[2 * n + pj]; const f32x2 ev = pj ? ehi : elo;
                            const f32x2 ex = (f32x2){a[2 * pj], a[2 * pj + 1]} * (-gsc * LOG2E);
                            const f32x2 den = (f32x2){__builtin_amdgcn_exp2f(ex[0]), __builtin_amdgcn_exp2f(ex[1])} + 1.0f;
                            const f32x2 sg = {__builtin_amdgcn_rcpf(den[0]), __builtin_amdgcn_rcpf(den[1])};
                            const f32x2 v = (ev * (f32x2){rg[2 * pj], rg[2 * pj + 1]}) * sg + (f32x2){bf_lo(hw), bf_hi(hw)};
                            r[2 * pj] = v[0]; r[2 * pj + 1] = v[1];
                        }
                        *(f32x4*)(OUT + o + n * 4) = r; }
                }
            }
    }
};

DI void moe_tables(LAS unsigned char* lds, const unsigned* cnt_g) {
    LAS int* cntL = (LAS int*)(lds + LDS_GRP); LAS int* pre = cntL + 128;
    __syncthreads();
    if (threadIdx.x < 128) cntL[threadIdx.x] = (int)cnt_g[threadIdx.x];
    __syncthreads();
    if (threadIdx.x == 0) { int s = 0; for (int g = 0; g < 128; ++g) { pre[g] = s; s += (cntL[g] + 255) >> 8; } pre[128] = s; }
    __syncthreads();
}
template <int NT, bool GATHER_, int EB>
struct MoeOrder {
    static constexpr bool GATHER = GATHER_;
    const char* A; const char* B; size_t bexp; int g0, ng, G, c; LAS unsigned char* lds; const int* list;
    DI bool next(int i, Unit& u) const {
        LAS int* cntL = (LAS int*)(lds + LDS_GRP); LAS int* pre = cntL + 128;
        const int base = __builtin_amdgcn_readfirstlane(pre[g0]), tot = __builtin_amdgcn_readfirstlane(pre[g0 + ng]) - base;
        int rbg, pn_;
        if (G == 256) { const int x = c & 7, q = c >> 3;
            if (NT == 8) { rbg = i * 32 + (x >> 1) * 8 + (q >> 2); pn_ = (x & 1) * 4 + (q & 3); }
            else { rbg = i * 64 + x * 8 + (q >> 2); pn_ = q & 3; } }
        else { const int L = i * G + c; rbg = L / NT; pn_ = L % NT; }
        if (rbg >= tot) return false;
        const int ra = rbg + base; int lo = g0, hi = g0 + ng;
        while (hi - lo > 1) { const int mid = (lo + hi) >> 1; const int pm_ = __builtin_amdgcn_readfirstlane(pre[mid]); if (pm_ <= ra) lo = mid; else hi = mid; }
        const int g = lo, pg = __builtin_amdgcn_readfirstlane(pre[g]), rb = ra - pg, cg = __builtin_amdgcn_readfirstlane(cntL[g]);
        u.g = g; u.pm = rb; u.pn = pn_; u.cnt = (cg - rb * 256) < 256 ? (cg - rb * 256) : 256; u.arow = ra * 256;
        u.ao = GATHER ? 0u : (unsigned)u.arow * (1024u * EB); u.bo = (unsigned)((size_t)(g & 31) * bexp) + (unsigned)u.pn * (256u * 1024u * EB);
        return true;
    }
    DI void issue_table(const Unit& u, LAS unsigned char* tab) const {
        if (threadIdx.x < 256) { const int wid = __builtin_amdgcn_readfirstlane(threadIdx.x >> 6);
            __builtin_amdgcn_global_load_lds((const unsigned*)(list + (size_t)u.g * 262144 + (size_t)u.pm * 256 + threadIdx.x), (LAS unsigned*)(tab + wid * 256), 4, 0, 0); }
    }
    DI unsigned row_off(const Unit& u, LAS unsigned char* tab, int r) const { const unsigned t = *(const LAS unsigned*)(tab + r * 4); return (r < u.cnt) ? t * (1024u * EB) : 0u; }
};

DI void phase_qknorm(const Params& P) {
    bf16_t* Z = (bf16_t*)(P.ws + WS_Z);
    {
        bf16_t* XL = (bf16_t*)(P.ws + WS_XL);
        for (int it = blockIdx.x * 512 + threadIdx.x; it < (MTOK / 16) * 48; it += gridDim.x * 512) {
            const int chunk = it / 48, cg = it - chunk * 48, tok0 = chunk * 16, t0 = tok0 & (SEQ - 1), col = ZWD + cg * 8;
            const bf16_t* zp = Z + (size_t)tok0 * IN_COLS + col;
            const f32x4 mu0 = *(const f32x4*)(P.rw_mu + col), mu1 = *(const f32x4*)(P.rw_mu + col + 4);
            u32x4 vp = {0u, 0u, 0u, 0u}; if (t0 > 0) vp = *(const u32x4*)(zp - IN_COLS);
            u32x4 vc = *(const u32x4*)zp;
#pragma unroll 4
            for (int i = 0; i < 16; ++i) {
                u32x4 vn = {0u, 0u, 0u, 0u}; if (t0 + i < SEQ - 1) vn = *(const u32x4*)(zp + (size_t)(i + 1) * IN_COLS);
                float f[8];
#pragma unroll
                for (int q = 0; q < 4; ++q) {
                    const float c0 = bf_lo(vc[q]), c1 = bf_hi(vc[q]);
                    const float m0 = q < 2 ? mu0[2 * q] : mu1[2 * q - 4], m1 = q < 2 ? mu0[2 * q + 1] : mu1[2 * q - 3];
                    f[2 * q] = c0 + (0.5f * (bf_lo(vp[q]) + bf_lo(vn[q])) - c0) * m0; f[2 * q + 1] = c1 + (0.5f * (bf_hi(vp[q]) + bf_hi(vn[q])) - c1) * m1;
                }
                if (cg < 16) {
#pragma unroll
                    for (int q = 0; q < 8; ++q) { const float e = __builtin_amdgcn_exp2f(f[q] * (2.0f * LOG2E)); f[q] = 1.0f - 2.0f * __builtin_amdgcn_rcpf(e + 1.0f); }
                } else if (cg >= 32) {
#pragma unroll
                    for (int q = 0; q < 8; ++q) f[q] = sigmoidf_(f[q]);
                }
                u32x4 ov = {cvt_pk(f[0], f[1]), cvt_pk(f[2], f[3]), cvt_pk(f[4], f[5]), cvt_pk(f[6], f[7])};
                *(u32x4*)(XL + (size_t)(tok0 + i) * 384 + cg * 8) = ov;
                vp = vc; vc = vn;
            }
        }
    }
}

constexpr int LDS_RT_SEL = STAGE_BYTES;
DI float row_max16(float v) { v = fmaxf(v, dpp_mov0<0x121, 0xF>(v)); v = fmaxf(v, dpp_mov0<0x122, 0xF>(v)); v = fmaxf(v, dpp_mov0<0x124, 0xF>(v)); v = fmaxf(v, dpp_mov0<0x128, 0xF>(v)); return v; }
template <int CTRL> DI int dpp_movi(int v) { return __builtin_amdgcn_update_dpp(0, v, CTRL, 0xF, 0xF, false); }
DI int row_min16(int v) { v = min(v, dpp_movi<0x121>(v)); v = min(v, dpp_movi<0x122>(v)); v = min(v, dpp_movi<0x124>(v)); v = min(v, dpp_movi<0x128>(v)); return v; }
DI void phase_route(const Params& P, LAS unsigned char* lds) {
    LAS int* sel_e = (LAS int*)(lds + LDS_RT_SEL); LAS float* sel_g = (LAS float*)(sel_e + 1024); LAS int* lpos = (LAS int*)(sel_g + 1024);
    LAS int* lcnt = lpos + 1024; LAS int* lbase = lcnt + 128;
    const int tid = threadIdx.x, wid = tid >> 6, lane = tid & 63, n16 = lane & 15, q4 = lane >> 4;
    const bf16_t* H = (const bf16_t*)P.out; unsigned char* Mb = P.ws + WS_U;
    int* tokpos = (int*)(P.ws + WS_TOKPOS);
    unsigned* cnt_g = (unsigned*)(P.ws + WS_CTL) + CW_CNT; int* list = (int*)(P.ws + WS_LIST); float* gate = (float*)(P.ws + WS_GATE);
    __syncthreads();
    for (int it = tid; it < 64 * 64; it += 512) { const int ln = it & 63, f2 = it >> 6, ks = f2 >> 1, nt = f2 & 1, n = ln & 15, kq = ln >> 4; const int k0 = ks * 32 + kq * 8, e = nt * 16 + n;
        float hi[8], lo[8];
#pragma unroll
        for (int i = 0; i < 8; ++i) { const float v = P.norm_ffn_g[k0 + i] * P.w_router[(size_t)(k0 + i) * 32 + e]; const float h = bf2f(f2bf(v)); hi[i] = h; lo[i] = v - h; }
        *(LAS bf16x8*)(lds + (size_t)(f2 * 2) * 1024 + ln * 16) = pack8(hi[0], hi[1], hi[2], hi[3], hi[4], hi[5], hi[6], hi[7]);
        *(LAS bf16x8*)(lds + (size_t)(f2 * 2 + 1) * 1024 + ln * 16) = pack8(lo[0], lo[1], lo[2], lo[3], lo[4], lo[5], lo[6], lo[7]);
    }
    __syncthreads();
    f32x4 g[4];
#pragma unroll
    for (int i = 0; i < 4; ++i) g[i] = *(const f32x4*)(P.norm_ffn_g + 4 * lane + 256 * i);
    const float br0 = P.b_router[n16], br1 = P.b_router[16 + n16];
    for (int blk = blockIdx.x; blk < MTOK / 256; blk += gridDim.x) {
        if (tid < 128) lcnt[tid] = 0;
        {
            const bf16_t* hr0 = H + (size_t)(blk * 256 + wid * 32) * 1024 + 4 * lane;
            u32x2 hn[4];
#pragma unroll
            for (int i = 0; i < 4; ++i) hn[i] = *(const u32x2*)(hr0 + 256 * i);
            for (int rp = 0; rp < 32; ++rp) {
                const int row = blk * 256 + wid * 32 + rp; float ss = 0.f; f32x4 v[4];
#pragma unroll
                for (int i = 0; i < 4; ++i) { const u32x2 hb_ = hn[i]; v[i] = (f32x4){bf_lo(hb_[0]), bf_hi(hb_[0]), bf_lo(hb_[1]), bf_hi(hb_[1])}; ss += v[i][0] * v[i][0] + v[i][1] * v[i][1] + v[i][2] * v[i][2] + v[i][3] * v[i][3]; }
                if (rp + 1 < 32) {
#pragma unroll
                    for (int i = 0; i < 4; ++i) hn[i] = *(const u32x2*)(hr0 + (size_t)(rp + 1) * 1024 + 256 * i);
                }
                ss = wave_sum(ss);
                const float rinv = __builtin_amdgcn_rsqf(ss * (1.f / 1024.f) + NORM_EPS);
#pragma unroll
                for (int i = 0; i < 4; ++i) { const f32x4 mv = v[i] * rinv * g[i];
                    *(unsigned*)(Mb + (size_t)row * 1024 + 4 * lane + 256 * i) = pk4_fp8(mv[0] * M8_SCALE, mv[1] * M8_SCALE, mv[2] * M8_SCALE, mv[3] * M8_SCALE); }
            }
        }
#pragma unroll 1
        for (int rg = 0; rg < 2; ++rg) {
            const int rb = wid * 32 + rg * 16;
            const bf16_t* hp = H + (size_t)(blk * 256 + rb + n16) * 1024 + q4 * 8;
            const LAS bf16x8* wf = (const LAS bf16x8*)lds + lane;
            f32x4 a0h = {0.f, 0.f, 0.f, 0.f}, a0l = a0h, a1h = a0h, a1l = a0h;
            float ssq = 0.f;
#pragma unroll 8
            for (int ks = 0; ks < 32; ++ks) { const bf16x8 a = *(const bf16x8*)(hp + ks * 32);
                { const u32x4 aw = __builtin_bit_cast(u32x4, a);
#pragma unroll
                  for (int i = 0; i < 4; ++i) { const float x0 = bf_lo(aw[i]), x1 = bf_hi(aw[i]); ssq += x0 * x0 + x1 * x1; } }
                a0h = __builtin_amdgcn_mfma_f32_16x16x32_bf16(a, wf[(ks * 4 + 0) * 64], a0h, 0, 0, 0); a0l = __builtin_amdgcn_mfma_f32_16x16x32_bf16(a, wf[(ks * 4 + 1) * 64], a0l, 0, 0, 0);
                a1h = __builtin_amdgcn_mfma_f32_16x16x32_bf16(a, wf[(ks * 4 + 2) * 64], a1h, 0, 0, 0); a1l = __builtin_amdgcn_mfma_f32_16x16x32_bf16(a, wf[(ks * 4 + 3) * 64], a1l, 0, 0, 0); }
            ssq = xsum32(xsum16(ssq));
            const float rmine = __builtin_amdgcn_rsqf(ssq * (1.f / 1024.f) + NORM_EPS);
            f32x4 ri;
#pragma unroll
            for (int j = 0; j < 4; ++j) ri[j] = __shfl(rmine, q4 * 4 + j);
#pragma unroll
            for (int j = 0; j < 4; ++j) {
                float v0 = (a0h[j] + a0l[j]) * ri[j] + br0, v1 = (a1h[j] + a1l[j]) * ri[j] + br1;
                float tv[4]; int te[4];
#pragma unroll
                for (int k = 0; k < 4; ++k) {
                    const float mx = row_max16(fmaxf(v0, v1));
                    int ce = (v0 == mx) ? n16 : (v1 == mx) ? 16 + n16 : 99;
                    ce = row_min16(ce) & 31;
                    tv[k] = mx; te[k] = ce; if (ce == n16) v0 = -3.0e38f; if (ce == 16 + n16) v1 = -3.0e38f;
                }
                const float e1 = __expf(tv[1] - tv[0]), e2 = __expf(tv[2] - tv[0]), e3 = __expf(tv[3] - tv[0]); const float inv = 1.f / (1.f + e1 + e2 + e3);
                if (n16 == 0) { const int r = rb + q4 * 4 + j; sel_e[r * 4 + 0] = te[0]; sel_e[r * 4 + 1] = te[1]; sel_e[r * 4 + 2] = te[2]; sel_e[r * 4 + 3] = te[3];
                    sel_g[r * 4 + 0] = inv; sel_g[r * 4 + 1] = e1 * inv; sel_g[r * 4 + 2] = e2 * inv; sel_g[r * 4 + 3] = e3 * inv; }
            }
        }
        __syncthreads();
        if (tid < 256) {
#pragma unroll
            for (int s = 0; s < 4; ++s) lpos[tid * 4 + s] = atomicAdd((int*)&lcnt[sel_e[tid * 4 + s]], 1);
        }
        __syncthreads();
        if (tid < 128) lbase[tid] = (int)atomicAdd(cnt_g + tid, (unsigned)lcnt[tid]);
        __syncthreads();
        if (tid < 256) { const int tok = blk * 256 + tid;
#pragma unroll
            for (int s = 0; s < 4; ++s) { const int gi = sel_e[tid * 4 + s]; const int pos = lbase[gi] + lpos[tid * 4 + s]; list[(size_t)gi * 262144 + pos] = tok; gate[(size_t)tok * 4 + s] = sel_g[tid * 4 + s]; tokpos[(size_t)tok * 4 + s] = (gi << 20) | pos; }
        }
        __syncthreads();
    }
}

DI void phase_combine(const Params& P, LAS unsigned char* lds) {
    moe_tables(lds, (const unsigned*)(P.ws + WS_CTL) + CW_CNT);
    const LAS int* pre = (const LAS int*)(lds + LDS_GRP) + 128;
    const int wid = __builtin_amdgcn_readfirstlane(threadIdx.x >> 6), lane = threadIdx.x & 63;
    const bf16_t* H = (const bf16_t*)P.out; bf16_t* HB = (bf16_t*)(P.ws + WS_HB); const unsigned char* Y8 = P.ws + WS_Y8; unsigned char* H8 = P.ws + WS_W2;
    const int* tokpos = (const int*)(P.ws + WS_TOKPOS); const float* gate = (const float*)(P.ws + WS_GATE);
    for (int i = threadIdx.x; i < N_EXP * 1024 / 4; i += 512) ((LAS f32x4*)lds)[i] = ((const f32x4*)P.b2)[i];
    __syncthreads();
    const int tstep = gridDim.x * 8; int tok = blockIdx.x * 8 + wid;
    u32x4 hb0 = {0u, 0u, 0u, 0u}, hb1 = hb0; int4 tp = {0, 0, 0, 0}; f32x4 gt = {0.f, 0.f, 0.f, 0.f};
    if (tok < MTOK) { hb0 = *(const u32x4*)(H + (size_t)tok * 1024 + 16 * lane); hb1 = *(const u32x4*)(H + (size_t)tok * 1024 + 16 * lane + 8); tp = *(const int4*)(tokpos + (size_t)tok * 4); gt = *(const f32x4*)(gate + (size_t)tok * 4); }
    for (; tok < MTOK; tok += tstep) {
        float h[16];
#pragma unroll
        for (int q = 0; q < 4; ++q) { h[2 * q] = bf_lo(hb0[q]); h[2 * q + 1] = bf_hi(hb0[q]); h[8 + 2 * q] = bf_lo(hb1[q]); h[8 + 2 * q + 1] = bf_hi(hb1[q]); }
        const int tpv[4] = {tp.x, tp.y, tp.z, tp.w}; const f32x4 gc = gt;
        u32x4 yv[4];
#pragma unroll
        for (int s = 0; s < 4; ++s) { const int g = tpv[s] >> 20, pos = tpv[s] & 0xfffff; const size_t prow = (size_t)pre[g] * 256 + pos; yv[s] = *(const u32x4*)(Y8 + prow * 1024 + 16 * lane); }
        const int tn = tok + tstep;
        if (tn < MTOK) { hb0 = *(const u32x4*)(H + (size_t)tn * 1024 + 16 * lane); hb1 = *(const u32x4*)(H + (size_t)tn * 1024 + 16 * lane + 8); tp = *(const int4*)(tokpos + (size_t)tn * 4); gt = *(const f32x4*)(gate + (size_t)tn * 4); }
#pragma unroll
        for (int s = 0; s < 4; ++s) {
            const int e = (tpv[s] >> 20) & 31; const float gs = gc[s], ys = gs * (1.0f / Y8_SCALE);
            const LAS f32x4* bl = (const LAS f32x4*)(lds + (size_t)e * 4096 + lane * 64);
#pragma unroll
            for (int q = 0; q < 4; ++q) { const f32x4 bv = bl[q]; const f32x2 lo = __builtin_amdgcn_cvt_pk_f32_fp8((int)yv[s][q], false), hi = __builtin_amdgcn_cvt_pk_f32_fp8((int)yv[s][q], true);
                h[4 * q + 0] += ys * lo[0] + gs * bv[0]; h[4 * q + 1] += ys * lo[1] + gs * bv[1]; h[4 * q + 2] += ys * hi[0] + gs * bv[2]; h[4 * q + 3] += ys * hi[1] + gs * bv[3]; }
        }
        *(u32x4*)(HB + (size_t)tok * 1024 + 16 * lane) = (u32x4){cvt_pk(h[0], h[1]), cvt_pk(h[2], h[3]), cvt_pk(h[4], h[5]), cvt_pk(h[6], h[7])};
        *(u32x4*)(HB + (size_t)tok * 1024 + 16 * lane + 8) = (u32x4){cvt_pk(h[8], h[9]), cvt_pk(h[10], h[11]), cvt_pk(h[12], h[13]), cvt_pk(h[14], h[15])};
        *(u32x4*)(H8 + (size_t)tok * 1024 + 16 * lane) = (u32x4){pk4_fp8(h[0] * M8_SCALE, h[1] * M8_SCALE, h[2] * M8_SCALE, h[3] * M8_SCALE), pk4_fp8(h[4] * M8_SCALE, h[5] * M8_SCALE, h[6] * M8_SCALE, h[7] * M8_SCALE),
                                                                pk4_fp8(h[8] * M8_SCALE, h[9] * M8_SCALE, h[10] * M8_SCALE, h[11] * M8_SCALE), pk4_fp8(h[12] * M8_SCALE, h[13] * M8_SCALE, h[14] * M8_SCALE, h[15] * M8_SCALE)};
    }
    __syncthreads();
}

constexpr int AT_V = 0, AT_WS = 98304;
#define KSWZ(row, colB) ((row) * 256 + ((colB) ^ (((row) & 7) << 4)))
DI int crow(int r, int hi) { return (r & 3) + 8 * (r >> 2) + 4 * hi; }
DI int v_st(int k, int c) { const int kk = (k & ~0xC) | ((k & 4) << 1) | ((k & 8) >> 1); return ((kk >> 3) * 4 + (c >> 5)) * 512 + ((kk & 7) * 32 + (c & 31)) * 2; }
DI int v_rd_base(int lane) { return ((lane & 3) << 3) | (((lane >> 2) & 3) << 6) | (((lane >> 4) & 1) << 5) | (((lane >> 5) & 1) << 8); }
constexpr int v_rd_off(int d0, int ks, int half) { return d0 * 512 + ks * 4096 + half * 2048; }
template <int OFF> DI s16x4 tr_read(int vb) { s16x4 r; asm volatile("ds_read_b64_tr_b16 %0, %1 offset:%2" : "=&v"(r) : "v"(vb), "i"(OFF) : "memory"); return r; }
#define AT_PK(L, H) (bf16x8){L[0], L[1], L[2], L[3], H[0], H[1], H[2], H[3]}
template <int D0> DI void pv_one(f32x16& od, int vb, bf16x8 pa0, bf16x8 pa1, bf16x8 pa2, bf16x8 pa3) {
    const s16x4 l0 = tr_read<v_rd_off(D0, 0, 0)>(vb), h0 = tr_read<v_rd_off(D0, 0, 1)>(vb), l1 = tr_read<v_rd_off(D0, 1, 0)>(vb), h1 = tr_read<v_rd_off(D0, 1, 1)>(vb);
    const s16x4 l2 = tr_read<v_rd_off(D0, 2, 0)>(vb), h2 = tr_read<v_rd_off(D0, 2, 1)>(vb), l3 = tr_read<v_rd_off(D0, 3, 0)>(vb), h3 = tr_read<v_rd_off(D0, 3, 1)>(vb);
    asm volatile("s_waitcnt lgkmcnt(0)" ::: "memory"); __builtin_amdgcn_sched_barrier(0);
    od = __builtin_amdgcn_mfma_f32_32x32x16_bf16(pa0, AT_PK(l0, h0), od, 0, 0, 0);
    od = __builtin_amdgcn_mfma_f32_32x32x16_bf16(pa1, AT_PK(l1, h1), od, 0, 0, 0);
    od = __builtin_amdgcn_mfma_f32_32x32x16_bf16(pa2, AT_PK(l2, h2), od, 0, 0, 0);
    od = __builtin_amdgcn_mfma_f32_32x32x16_bf16(pa3, AT_PK(l3, h3), od, 0, 0, 0);
}
DI void at_softmax(f32x16& p0, f32x16& p1, f32x2& la, f32x2& lb, bf16x8& pa0, bf16x8& pa1, bf16x8& pa2, bf16x8& pa3) {
#pragma unroll
    for (int r = 0; r < 16; ++r) { p0[r] = __builtin_amdgcn_exp2f(p0[r]); p1[r] = __builtin_amdgcn_exp2f(p1[r]); }
#pragma unroll
    for (int r = 0; r < 8; ++r) { la += (f32x2){p0[2 * r], p0[2 * r + 1]}; lb += (f32x2){p1[2 * r], p1[2 * r + 1]}; }
#define AT_PK4(Pv, BASE, OUT) do { unsigned a0 = cvt_pk(Pv[BASE + 0], Pv[BASE + 1]), a1 = cvt_pk(Pv[BASE + 2], Pv[BASE + 3]); \
    unsigned b0 = cvt_pk(Pv[BASE + 4], Pv[BASE + 5]), b1 = cvt_pk(Pv[BASE + 6], Pv[BASE + 7]); \
    auto r0 = __builtin_amdgcn_permlane32_swap(a0, b0, false, false); auto r1 = __builtin_amdgcn_permlane32_swap(a1, b1, false, false); \
    u32x4 w = {r0[0], r1[0], r0[1], r1[1]}; OUT = __builtin_bit_cast(bf16x8, w); } while (0)
    AT_PK4(p0, 0, pa0); AT_PK4(p0, 8, pa1); AT_PK4(p1, 0, pa2); AT_PK4(p1, 8, pa3);
#undef AT_PK4
}

DI void at_bias(f32x16& p0, f32x16& p1, float x, float slope2, float smax2, int side  ) {
    if (side != 0) {
        const float ss = (float)side * slope2, base = fmaf(-ss, x, -smax2);
#pragma unroll
        for (int r = 0; r < 16; ++r) { const float c0 = (float)((r & 3) + 8 * (r >> 2)); p0[r] = fmaf(ss, c0, base); p1[r] = fmaf(ss, c0 + 32.f, base); }
    } else {
#pragma unroll
        for (int r = 0; r < 16; ++r) { const float c0 = (float)((r & 3) + 8 * (r >> 2)); p0[r] = fmaf(fabsf(x - c0), -slope2, -smax2); p1[r] = fmaf(fabsf(x - (c0 + 32.f)), -slope2, -smax2); }
    }
}
DI void attn_unit(const Params& P, unsigned char* lds, int b, int h, int qb, float lam, float smax2, int W) {
    int tid_ = threadIdx.x; asm volatile("" : "+v"(tid_));
    const int tid = tid_, wid = __builtin_amdgcn_readfirstlane(tid >> 6), lane = tid & 63, r32 = lane & 31, hi = lane >> 5, grp = wid >> 1, c = wid & 1;
    const bf16_t* Zb = (const bf16_t*)(P.ws + WS_Z) + (size_t)b * SEQ * IN_COLS;
    LAS unsigned char* L3 = (LAS unsigned char*)lds;
    const int i0 = qb * 128, qbase = i0 + grp * 32, qi = qbase + r32;
    const float slope2 = exp2f(-2.0f * (float)(h + 1)) * LOG2E;
    bf16x8 qr[4];
    { const bf16_t* qp = Zb + (size_t)qi * IN_COLS + ZQ + h * 128 + c * 64 + hi * 8;
#pragma unroll
      for (int d0 = 0; d0 < 4; ++d0) qr[d0] = *(const bf16x8*)(qp + d0 * 16); }
    const __amdgpu_buffer_rsrc_t rsZ = __builtin_amdgcn_make_buffer_rsrc((void*)Zb, 0, 0x7ffffff0, 0x00020000);
    unsigned voK[2], voV[2];
#pragma unroll
    for (int i = 0; i < 2; ++i) {
        const int u = tid + 512 * i;
        const int krow = u >> 4, kch = (u & 15) ^ (krow & 7);
        voK[i] = (unsigned)((krow * IN_COLS + ZKK + h * 128 + kch * 8) * 2);
        const int sub = u >> 5, kkl = (u >> 2) & 7, cq = u & 3, kk = (sub >> 2) * 8 + kkl, vkey = (kk & ~0xC) | ((kk & 4) << 1) | ((kk & 8) >> 1), vc = (sub & 3) * 32 + cq * 8;
        voV[i] = (unsigned)((vkey * IN_COLS + ZVV + h * 128 + vc) * 2);
    }
    const int vb0 = (int)(uintptr_t)(lds + AT_V) + v_rd_base(lane);
    f32x16 o[4];
#pragma unroll
    for (int d = 0; d < 4; ++d)
#pragma unroll
        for (int r = 0; r < 16; ++r) o[d][r] = 0.f;
    f32x2 la2 = {0.f, 0.f}, lb2 = {0.f, 0.f};
#define AT_TI(t) ((t) < n1 ? a1 + (t) : a2 + ((t) - n1))
#define AT_DMA(t, bf) do { const int so_ = AT_TI(t) * 64 * IN_COLS * 2; LAS unsigned char* d_ = L3 + (bf) * 32768 + wid * 1024; \
    __builtin_amdgcn_raw_ptr_buffer_load_lds(rsZ, (LAS void*)(d_), 16, (int)voK[0], so_, 0, 0); __builtin_amdgcn_raw_ptr_buffer_load_lds(rsZ, (LAS void*)(d_ + 8192), 16, (int)voK[1], so_, 0, 0); \
    __builtin_amdgcn_raw_ptr_buffer_load_lds(rsZ, (LAS void*)(d_ + 16384), 16, (int)voV[0], so_, 0, 0); __builtin_amdgcn_raw_ptr_buffer_load_lds(rsZ, (LAS void*)(d_ + 24576), 16, (int)voV[1], so_, 0, 0); } while (0)
#define AT_QK(p0, p1, bf, t) do { const int j0_ = AT_TI(t) * 64; const int side_ = (j0_ + 63 < qbase) ? 1 : (j0_ > qbase + 31 ? -1 : 0); \
    at_bias(p0, p1, (float)(qi - j0_ - 4 * hi), slope2, smax2, side_); const LAS unsigned char* Ks_ = L3 + (bf) * 32768; \
    _Pragma("unroll") for (int d0 = 0; d0 < 4; ++d0) { const int cb = (c * 64 + d0 * 16 + hi * 8) * 2; \
        const bf16x8 k0 = *(const LAS bf16x8*)(Ks_ + KSWZ(r32, cb)), k1 = *(const LAS bf16x8*)(Ks_ + KSWZ(32 + r32, cb)); \
        p0 = __builtin_amdgcn_mfma_f32_32x32x16_bf16(k0, qr[d0], p0, 0, 0, 0); p1 = __builtin_amdgcn_mfma_f32_32x32x16_bf16(k1, qr[d0], p1, 0, 0, 0); } } while (0)
#define AT_PV(bf) do { const int vb = vb0 + (bf) * 32768 + 16384; pv_one<0>(o[0], vb, pa0, pa1, pa2, pa3); pv_one<1>(o[1], vb, pa0, pa1, pa2, pa3); pv_one<2>(o[2], vb, pa0, pa1, pa2, pa3); pv_one<3>(o[3], vb, pa0, pa1, pa2, pa3); } while (0)
#define AT_SB() do {} while (0)
#define AT_SYNC() do { asm volatile("s_waitcnt vmcnt(0) lgkmcnt(0)" ::: "memory"); __builtin_amdgcn_s_barrier(); asm volatile("" ::: "memory"); } while (0)
    f32x16 pA0, pA1, pB0, pB1; bf16x8 pa0, pa1, pa2, pa3;
    int a1 = 2 * qb, n1 = 2, a2 = 0, NT = 2;
#define AT_RUN() do { \
        AT_DMA(0, 0); AT_DMA(1, 1); \
        asm volatile("s_waitcnt vmcnt(4)" ::: "memory"); __builtin_amdgcn_s_barrier(); asm volatile("" ::: "memory"); \
        AT_QK(pA0, pA1, 0, 0); \
        int b0 = 0, b1 = 1, b2 = 2;                          \
        for (int t = 0; t + 1 < NT; t += 2) { \
            AT_SYNC(); if (t + 2 < NT) AT_DMA(t + 2, b2); \
            __builtin_amdgcn_s_setprio(1); AT_QK(pB0, pB1, b1, t + 1); \
            at_softmax(pA0, pA1, la2, lb2, pa0, pa1, pa2, pa3); __builtin_amdgcn_s_setprio(0); \
            AT_PV(b0); \
            AT_SYNC(); if (t + 3 < NT) AT_DMA(t + 3, b0); \
            __builtin_amdgcn_s_setprio(1); if (t + 2 < NT) AT_QK(pA0, pA1, b2, t + 2); \
            at_softmax(pB0, pB1, la2, lb2, pa0, pa1, pa2, pa3); __builtin_amdgcn_s_setprio(0); \
            AT_PV(b1); \
            { const int nb0 = b2, nb1 = b0, nb2 = b1; b0 = nb0; b1 = nb1; b2 = nb2; } \
        } } while (0)
    __syncthreads();
    AT_RUN();
    {
        const float lc = xsum32((la2[0] + la2[1]) + (lb2[0] + lb2[1])), lmn = -wave_max(-lc);
        LAS float* sml = (LAS float*)(lds + AT_WS + 1024);
        if (lane == 0) sml[wid] = lmn;
        __syncthreads();
        const f32x4 m0 = *(const LAS f32x4*)sml, m1 = *(const LAS f32x4*)(sml + 4);
        float tmin = fminf(fminf(fminf(m0[0], m0[1]), fminf(m0[2], m0[3])), fminf(fminf(m1[0], m1[1]), fminf(m1[2], m1[3])));
        tmin = __builtin_bit_cast(float, __builtin_amdgcn_readfirstlane(__builtin_bit_cast(int, fmaxf(tmin, 1e-36f))));
        const float lcnt2 = fminf(13.0f, 1.0f - __builtin_amdgcn_logf(1.0f - __builtin_amdgcn_exp2f(-slope2)));
        const int Wt = (int)ceilf((lcnt2 + 24.02f - __builtin_amdgcn_logf(tmin)) / slope2);
        if (Wt < W) W = Wt;
        if (W < 0) W = 0;
        int jlo = i0 - W; if (jlo < 0) jlo = 0; jlo >>= 6;
        int jhi = i0 + 127 + W; if (jhi > SEQ - 1) jhi = SEQ - 1; jhi >>= 6;
        if (((jhi - jlo) & 1) == 0) { if (jhi < SEQ / 64 - 1) ++jhi; else --jlo; }
        a1 = jlo; n1 = 2 * qb - jlo; a2 = 2 * qb + 2; NT = n1 + (jhi - 2 * qb - 1);
    }
    if (NT > 0) AT_RUN();
#undef AT_RUN
    __syncthreads();
#undef AT_DMA
#undef AT_TI
#undef AT_QK
#undef AT_PV
#undef AT_SB
#undef AT_SYNC
    const float l = xsum32((la2[0] + la2[1]) + (lb2[0] + lb2[1]));
    float* wsf = (float*)(lds + AT_WS) + wid * 32;
    float* exch = (float*)lds + grp * 4096;
    if (hi == 0) wsf[r32] = l;
    asm volatile("s_waitcnt lgkmcnt(0)" ::: "memory");
    float rl[16];
#pragma unroll
    for (int r = 0; r < 16; ++r) rl[r] = __builtin_amdgcn_rcpf(wsf[crow(r, hi)]) * (c ? lam : 1.0f);
    if (c == 1) {
#pragma unroll
        for (int d = 0; d < 4; ++d)
#pragma unroll
            for (int r = 0; r < 16; ++r) exch[(d * 16 + r) * 64 + lane] = o[d][r] * rl[r];
    }
    __syncthreads();
    if (c == 0) {
        float ss[16];
#pragma unroll
        for (int r = 0; r < 16; ++r) { float sacc = 0.f;
#pragma unroll
            for (int d = 0; d < 4; ++d) { const float v = o[d][r] * rl[r] - exch[(d * 16 + r) * 64 + lane]; o[d][r] = v; sacc += v * v; }
            ss[r] = sacc; }
#pragma unroll
        for (int r = 0; r < 16; ++r) {
            ss[r] = xsum16(row_sum16(ss[r]));
        }
        bf16_t* Ob = (bf16_t*)(P.ws + WS_O) + (size_t)(b * SEQ + i0 + grp * 32) * 1024 + C_RW + h * 128;
        float sg[4];
#pragma unroll
        for (int d = 0; d < 4; ++d) sg[d] = P.da_subln_g[d * 32 + r32] * 0.8f;
#pragma unroll
        for (int r = 0; r < 16; ++r) { const float rn = __builtin_amdgcn_rsqf(ss[r] * (1.f / 128.f) + NORM_EPS); bf16_t* op = Ob + (size_t)crow(r, hi) * 1024 + r32;
#pragma unroll
            for (int d = 0; d < 4; ++d) op[d * 32] = f2bf(o[d][r] * rn * sg[d]); }
    }
}

constexpr int SL_SZ = 19712, SL_AT = 0, SL_RT = 2304, SL_BT = 4608, SL_KT = 6912, SL_BH = 9216, SL_KH = 11776, SL_VT = 14336, SL_PC = 16896,
              SL_AAK = 17152, SL_TT = 17792, SL_ARB = 18432, SL_ARK = 19072;
constexpr int RW_SLOT = 0, RW_EX = 78848, RW_FG = 79872, RW_MU = 96256, RW_WFW = 98560, RW_WFA = 106752, RW_WFG = 123136, RW_AAB = 139520;
DI bf16x8 lo_hi(u32x2 lo, u32x2 hi) { u32x4 w = {lo[0], lo[1], hi[0], hi[1]}; return __builtin_bit_cast(bf16x8, w); }
DI float tanh_fast(float x) { const float t = __builtin_amdgcn_exp2f(x * (2.0f * LOG2E)); return 1.0f - 2.0f * __builtin_amdgcn_rcpf(t + 1.0f); }
template <int CTRL> DI unsigned dpp_keep(unsigned old, unsigned v) { return (unsigned)__builtin_amdgcn_update_dpp((int)old, (int)v, CTRL, 0xF, 0xF, false); }
DI void shift8(const u32x4 cur, const u32x4 bnd, const float* mu, float (&f)[8]) {
    const f32x4 m0 = *(const f32x4*)mu, m1 = *(const f32x4*)(mu + 4);
#pragma unroll
    for (int q = 0; q < 4; ++q) {
        const unsigned na = dpp_keep<0x111>(bnd[q], cur[q]), nb = dpp_keep<0x101>(bnd[q], cur[q]);
        const float c0 = bf_lo(cur[q]), c1 = bf_hi(cur[q]);
        const float mm0 = q < 2 ? m0[2 * q] : m1[2 * q - 4], mm1 = q < 2 ? m0[2 * q + 1] : m1[2 * q - 3];
        f[2 * q] = c0 + (0.5f * (bf_lo(na) + bf_lo(nb)) - c0) * mm0; f[2 * q + 1] = c1 + (0.5f * (bf_hi(na) + bf_hi(nb)) - c1) * mm1;
    }
}

#define RW_BAR() do { asm volatile("s_waitcnt lgkmcnt(0)" ::: "memory"); __builtin_amdgcn_s_barrier(); asm volatile("" ::: "memory"); } while (0)
DI void rwkv_task(const Params& P, unsigned char* lds, int b, int h, int wd) {
    int tid_ = threadIdx.x; asm volatile("" : "+v"(tid_));
    const int tid = tid_, wid = __builtin_amdgcn_readfirstlane(tid >> 6), lane = tid & 63, n16 = lane & 15, q4 = lane >> 4, cp = wid >> 1, hf = (wid ^ (wid >> 2)) & 1, vt = wid & 3;
    const bf16_t* Zb = (const bf16_t*)(P.ws + WS_Z) + (size_t)b * SEQ * IN_COLS;
    float* Ysc = (float*)(P.ws + WS_U) + (size_t)b * SEQ * 512 + h * 64;
    bf16_t* Ob = (bf16_t*)(P.ws + WS_O) + (size_t)b * SEQ * 1024 + h * 64;
    const bf16_t* XLb = (const bf16_t*)(P.ws + WS_XL) + (size_t)b * SEQ * 384;
    unsigned* flags = (unsigned*)(P.ws + WS_CTL) + CW_RWFLAG;
    const int hc = h * 64, task = (b * 8 + h) * 2 + wd;
    __syncthreads();
    float* MU = (float*)(lds + RW_MU);
    for (int i = tid; i < 192; i += 512) { const int col = (i < 64 ? ZR : i < 128 ? ZK - 64 : ZV - 128) + hc + i; MU[i] = P.rw_mu[col]; }
    float* CST = (float*)(lds + RW_AAB + 4096);
    for (int i = tid; i < 512; i += 512) { const int a = i >> 6, ch = i & 63; const float* src = a == 0 ? P.rw_w0 + wd * 512 : a == 1 ? P.rw_a0 + wd * 512 : a == 2 ? P.rw_a0 + (1 - wd) * 512 : a == 3 ? P.rw_k_k : a == 4 ? P.rw_k_a : a == 5 ? P.rw_r_k : a == 6 ? P.rw_ln_g : P.rw_ln_b; CST[i] = src[hc + ch] * (a < 3 ? -LOG2E : 1.f); }
    bf16x8* wfw = (bf16x8*)(lds + RW_WFW) + (size_t)(hf * 4) * 64 + lane;
    bf16x8* wfa = (bf16x8*)(lds + RW_WFA) + (size_t)(hf * 4) * 64 + lane;
    bf16x8* wfo = (bf16x8*)(lds + RW_WFA) + (size_t)(8 + hf * 4) * 64 + lane;
    bf16x8* wfg = (bf16x8*)(lds + RW_WFG) + (size_t)(hf * 8) * 64 + lane;
#pragma unroll
    for (int u = 0; u < 2; ++u) {
        const int col = hc + hf * 32 + 2 * n16 + u;
        if (cp == 0) {
#pragma unroll
            for (int s = 0; s < 2; ++s) {
                float x[8], y[8], z[8];
#pragma unroll
                for (int j = 0; j < 8; ++j) { const int r = s * 32 + q4 * 8 + j; x[j] = -LOG2E * P.rw_w2[(size_t)(wd * 64 + r) * 512 + col]; y[j] = -LOG2E * P.rw_a2[(size_t)(wd * 64 + r) * 512 + col]; z[j] = -LOG2E * P.rw_a2[(size_t)((1 - wd) * 64 + r) * 512 + col]; }
                wfw[(u * 2 + s) * 64] = pack8(x[0], x[1], x[2], x[3], x[4], x[5], x[6], x[7]); wfa[(u * 2 + s) * 64] = pack8(y[0], y[1], y[2], y[3], y[4], y[5], y[6], y[7]);
                wfo[(u * 2 + s) * 64] = pack8(z[0], z[1], z[2], z[3], z[4], z[5], z[6], z[7]);
            }
#pragma unroll
            for (int s = 0; s < 4; ++s) { float x[8];
#pragma unroll
                for (int j = 0; j < 8; ++j) x[j] = P.rw_g2[(size_t)(s * 32 + q4 * 8 + j) * 512 + col];
                wfg[(u * 4 + s) * 64] = pack8(x[0], x[1], x[2], x[3], x[4], x[5], x[6], x[7]); }
        }
    }
    u32x4* selp = (u32x4*)(lds + RW_AAB + 6144) + lane;
    if (wid == 0) {
#pragma unroll
        for (int u = 0; u < 2; ++u) { const unsigned one = (q4 == (n16 >> 2)) ? (u ? 0x3F800000u : 0x00003F80u) : 0u; const int w = n16 & 3;
            selp[u * 64] = (u32x4){w == 0 ? one : 0u, w == 1 ? one : 0u, w == 2 ? one : 0u, w == 3 ? one : 0u}; }
    }
    f32x4 ST[4];
#pragma unroll
    for (int t = 0; t < 4; ++t) ST[t] = (f32x4){0.f, 0.f, 0.f, 0.f};
    unsigned char* slot = lds + RW_SLOT + cp * SL_SZ;
    float* ex = (float*)(lds + RW_EX);
    bf16_t* fgb = (bf16_t*)(lds + RW_FG) + cp * 2048;
    const int sgn = wd ? -1 : 1;
    bf16x8 xw0, xw1, xa0, xa1; u32x4 zc[3], zb[3]; bool bok = false;
    bf16x8 xo0 = {0, 0, 0, 0, 0, 0, 0, 0}, xo1 = xo0, xg0 = xo0, xg1 = xo0, xg2 = xo0, xg3 = xo0;
#define RW_OPQ() int lo_ = lane; asm volatile("" : "+v"(lo_)); const int n16 = lo_ & 15, q4 = lo_ >> 4
#define RW_LOADS(S_) do { RW_OPQ(); const int sc_ = wd ? (SEQ / 64 - 1 - (S_)) : (S_); const int T0_ = wd ? (sc_ * 64 + 63 - 16 * cp) : (sc_ * 64 + 16 * cp); \
        const int tb_ = (n16 == 0) ? (T0_ - sgn) : (T0_ + 16 * sgn); bok = (n16 == 0 || n16 == 15) && tb_ >= 0 && tb_ < SEQ; \
          \
        const unsigned zro_ = (unsigned)((T0_ + sgn * n16) * IN_COLS + q4 * 8 + hc + hf * 32) * 2u, zbo_ = (unsigned)((bok ? tb_ : 0) * IN_COLS + q4 * 8 + hc + hf * 32) * 2u; \
        const unsigned xlo_ = (unsigned)((T0_ + sgn * n16) * 384 + q4 * 8) * 2u; const char* xl_ = (const char*)XLb + xlo_; \
        xw0 = *(const bf16x8*)(xl_ + (wd * 64) * 2); xw1 = *(const bf16x8*)(xl_ + (wd * 64 + 32) * 2); xa0 = *(const bf16x8*)(xl_ + (128 + wd * 64) * 2); xa1 = *(const bf16x8*)(xl_ + (128 + wd * 64 + 32) * 2); \
        _Pragma("unroll") for (int arr = 0; arr < 3; ++arr) { const int col = (arr == 0 ? ZR : arr == 1 ? ZK : ZV); zc[arr] = *(const u32x4*)((const char*)Zb + zro_ + col * 2); zb[arr] = *(const u32x4*)((const char*)Zb + zbo_ + col * 2); } \
        if ((S_) >= SEQ / 128) { xo0 = *(const bf16x8*)(xl_ + (128 + (1 - wd) * 64) * 2); xo1 = *(const bf16x8*)(xl_ + (128 + (1 - wd) * 64 + 32) * 2); \
            xg0 = *(const bf16x8*)(xl_ + 256 * 2); xg1 = *(const bf16x8*)(xl_ + 288 * 2); xg2 = *(const bf16x8*)(xl_ + 320 * 2); xg3 = *(const bf16x8*)(xl_ + 352 * 2); } } while (0)
#define RW_LANDED() asm volatile("" :: "v"(xw0), "v"(xw1), "v"(xa0), "v"(xa1), "v"(zc[0]), "v"(zc[1]), "v"(zc[2]), "v"(zb[0]), "v"(zb[1]), "v"(zb[2]), "v"(xo0), "v"(xo1), "v"(xg0), "v"(xg1), "v"(xg2), "v"(xg3))
    RW_LOADS(0);
    RW_LANDED();
    for (int s = 0; s < SEQ / 64; ++s) {
        const bool fin = s >= SEQ / 128;
        const int sc = wd ? (SEQ / 64 - 1 - s) : s;
        const int T0 = wd ? (sc * 64 + 63 - 16 * cp) : (sc * 64 + 16 * cp);
        if (s == SEQ / 128) {
            if (tid < 64) {
                unsigned spins = 0;
                while (__builtin_amdgcn_readfirstlane(__hip_atomic_load(flags + (task ^ 1) * 16, __ATOMIC_RELAXED, __HIP_MEMORY_SCOPE_AGENT)) == 0u) { __builtin_amdgcn_s_sleep(8); if (++spins > (1u << 24)) break; }
                __builtin_amdgcn_fence(__ATOMIC_ACQUIRE, "agent");
                asm volatile("s_waitcnt vmcnt(0)" ::: "memory");
            }
        }
        RW_BAR();
        const u32x4 z4 = {0u, 0u, 0u, 0u};
        f32x4 lw[2], la[2], lo[2], lg[2];
#pragma unroll
        for (int u = 0; u < 2; ++u) { lw[u] = (f32x4){0.f, 0.f, 0.f, 0.f}; la[u] = lw[u]; lo[u] = lw[u]; lg[u] = lw[u]; }
#define RW_MM(acc, af, wf, nks, ks) acc[0] = __builtin_amdgcn_mfma_f32_16x16x32_bf16(af, wf[(ks) * 64], acc[0], 0, 0, 0); acc[1] = __builtin_amdgcn_mfma_f32_16x16x32_bf16(af, wf[((nks) + (ks)) * 64], acc[1], 0, 0, 0);
        RW_MM(lw, xw0, wfw, 2, 0) RW_MM(lw, xw1, wfw, 2, 1) RW_MM(la, xa0, wfa, 2, 0) RW_MM(la, xa1, wfa, 2, 1)
        if (fin) { RW_MM(lo, xo0, wfo, 2, 0) RW_MM(lo, xo1, wfo, 2, 1) RW_MM(lg, xg0, wfg, 4, 0) RW_MM(lg, xg1, wfg, 4, 1) RW_MM(lg, xg2, wfg, 4, 2) RW_MM(lg, xg3, wfg, 4, 3) }
#undef RW_MM
        float rr[2][4], kr[2][4], vv[2][4];
        {
            const bf16x8 sel0 = __builtin_bit_cast(bf16x8, selp[0]), sel1 = __builtin_bit_cast(bf16x8, selp[64]);
            const f32x4 zero4 = {0.f, 0.f, 0.f, 0.f};
            const bool edge = (T0 - sgn < 0) || (T0 - sgn >= SEQ) || (T0 + 16 * sgn < 0) || (T0 + 16 * sgn >= SEQ);
            if (edge) {
#pragma unroll
                for (int arr = 0; arr < 3; ++arr) zb[arr] = bok ? zb[arr] : z4;
            }
#pragma unroll
            for (int arr = 0; arr < 3; ++arr) {
                const u32x4 cur = zc[arr], bnd = zb[arr]; u32x4 na, nb;
#pragma unroll
                for (int q = 0; q < 4; ++q) { na[q] = dpp_keep<0x111>(bnd[q], cur[q]); nb[q] = dpp_keep<0x101>(bnd[q], cur[q]); }
                const f32x2 mu2 = *(const f32x2*)(MU + arr * 64 + hf * 32 + 2 * n16);
#pragma unroll
                for (int u = 0; u < 2; ++u) {
                    const bf16x8 sl = u ? sel1 : sel0;
                    const f32x4 d1 = __builtin_amdgcn_mfma_f32_16x16x32_bf16(__builtin_bit_cast(bf16x8, cur), sl, zero4, 0, 0, 0);
                    f32x4 d2 = __builtin_amdgcn_mfma_f32_16x16x32_bf16(__builtin_bit_cast(bf16x8, na), sl, zero4, 0, 0, 0);
                    d2 = __builtin_amdgcn_mfma_f32_16x16x32_bf16(__builtin_bit_cast(bf16x8, nb), sl, d2, 0, 0, 0);
                    const f32x4 val = d1 + (0.5f * d2 - d1) * mu2[u];
#pragma unroll
                    for (int j = 0; j < 4; ++j) { if (arr == 0) rr[u][j] = val[j]; else if (arr == 1) kr[u][j] = val[j]; else vv[u][j] = val[j]; }
                }
            }
        }
        float lgw[2][4], aa[2][4], kkr[2][4], gg[2][4], n2p[4], bnp[4];
#pragma unroll
        for (int j = 0; j < 4; ++j) { n2p[j] = 0.f; bnp[j] = 0.f; }
        {
            const int ch2 = hf * 32 + 2 * n16;
            const f32x2 w0c2 = *(const f32x2*)(CST + ch2), a0c2 = *(const f32x2*)(CST + 64 + ch2), a0oc2 = *(const f32x2*)(CST + 128 + ch2), kkc2 = *(const f32x2*)(CST + 192 + ch2), kac2 = *(const f32x2*)(CST + 256 + ch2), rkc2 = *(const f32x2*)(CST + 320 + ch2);
#define RW_SG2(x_) __builtin_amdgcn_rcpf(1.f + __builtin_amdgcn_exp2f(x_))
            if (!fin) {
#pragma unroll
                for (int u = 0; u < 2; ++u)
#pragma unroll
                    for (int j = 0; j < 4; ++j) {
                        lgw[u][j] = (-0.6065306597f * LOG2E) * RW_SG2(w0c2[u] + lw[u][j]);
                        aa[u][j] = RW_SG2(a0c2[u] + la[u][j]);
                        const float kk = kr[u][j] * kkc2[u]; kkr[u][j] = kk; n2p[j] += kk * kk; gg[u][j] = 0.f;
                    }
            } else {
#pragma unroll
                for (int u = 0; u < 2; ++u)
#pragma unroll
                    for (int j = 0; j < 4; ++j) {
                        lgw[u][j] = (-0.6065306597f * LOG2E) * RW_SG2(w0c2[u] + lw[u][j]);
                        const float a = RW_SG2(a0c2[u] + la[u][j]); aa[u][j] = a;
                        const float k = kr[u][j], kk = k * kkc2[u]; kkr[u][j] = kk; n2p[j] += kk * kk;
                        const float ao = RW_SG2(a0oc2[u] + lo[u][j]); const float kb = k * (1.f + (0.5f * (a + ao) - 1.f) * kac2[u]); bnp[j] += rr[u][j] * kb * rkc2[u]; gg[u][j] = lg[u][j];
                    }
            }
#undef RW_SG2
        }
#pragma unroll
        for (int j = 0; j < 4; ++j) n2p[j] = row_sum16(n2p[j]);
        if (fin) {
#pragma unroll
            for (int j = 0; j < 4; ++j) bnp[j] = row_sum16(bnp[j]);
        }
        if (n16 == 0) {
#pragma unroll
            for (int j = 0; j < 4; ++j) { float* e = ex + ((cp * 2 + hf) * 16 + q4 * 4 + j) * 2; e[0] = n2p[j]; e[1] = bnp[j]; }
        }
        RW_BAR();
        if (s + 1 < SEQ / 64) RW_LOADS(s + 1);
        {
            RW_OPQ();
            float bon[4], rsn[4];
#pragma unroll
            for (int j = 0; j < 4; ++j) { const float* e = ex + ((cp * 2 + (1 - hf)) * 16 + q4 * 4 + j) * 2; rsn[j] = __builtin_amdgcn_rsqf(n2p[j] + e[0] + 1e-12f); bon[j] = bnp[j] + e[1]; }
            const int ch2 = hf * 32 + 2 * n16; const f32x2 kac2 = *(const f32x2*)(CST + 256 + ch2);
            float excl[2], PCv[2], eprev[2], L[2][4];
#pragma unroll
            for (int u = 0; u < 2; ++u) {
                L[u][0] = lgw[u][0]; L[u][1] = L[u][0] + lgw[u][1]; L[u][2] = L[u][1] + lgw[u][2]; L[u][3] = L[u][2] + lgw[u][3];
                const unsigned tu = __builtin_bit_cast(unsigned, L[u][3]);
                auto s16 = __builtin_amdgcn_permlane16_swap(tu, tu, false, false);
                const float sa = __builtin_bit_cast(float, (unsigned)s16[0]), sb = __builtin_bit_cast(float, (unsigned)s16[1]), sp = sa + sb;
                const unsigned pu = __builtin_bit_cast(unsigned, sp);
                auto s32 = __builtin_amdgcn_permlane32_swap(pu, pu, false, false);
                const float s01 = __builtin_bit_cast(float, (unsigned)s32[0]), s23 = __builtin_bit_cast(float, (unsigned)s32[1]);
                const float LC = s01 + s23;
                const float incl = q4 == 0 ? sa : q4 == 1 ? sp : q4 == 2 ? s01 + sa : LC;
                excl[u] = incl - L[u][3];
                PCv[u] = __builtin_amdgcn_exp2f(LC); eprev[u] = __builtin_amdgcn_exp2f(excl[u]);
            }
            if (q4 == 0) *(f32x2*)((float*)(slot + SL_PC) + ch2) = (f32x2){PCv[0], PCv[1]};
            float bhv[2][4], khv[2][4];
#pragma unroll
            for (int j = 0; j < 4; ++j) { const int i = q4 * 4 + j;
                float atv[2], rtv[2], btv[2], ktv[2];
#pragma unroll
                for (int u = 0; u < 2; ++u) {
                    const float eL = __builtin_amdgcn_exp2f(excl[u] + L[u][j]), eLp = eprev[u], emL = __builtin_amdgcn_rcpf(eL); eprev[u] = eL;
                    const float kk = kkr[u][j] * rsn[j], a = aa[u][j], k = kr[u][j];
                    const float bt = kk * a * emL, kt = k * (1.f + (a - 1.f) * kac2[u]) * emL;
                    atv[u] = -kk * eLp; rtv[u] = rr[u][j] * eL; btv[u] = bt; ktv[u] = kt;
                    bhv[u][j] = bt * PCv[u]; khv[u][j] = kt * PCv[u];
                }
                *(unsigned*)((bf16_t*)(slot + SL_AT) + i * 72 + ch2) = cvt_pk(atv[0], atv[1]); *(unsigned*)((bf16_t*)(slot + SL_RT) + i * 72 + ch2) = cvt_pk(rtv[0], rtv[1]);
                *(unsigned*)((bf16_t*)(slot + SL_BT) + i * 72 + ch2) = cvt_pk(btv[0], btv[1]); *(unsigned*)((bf16_t*)(slot + SL_KT) + i * 72 + ch2) = cvt_pk(ktv[0], ktv[1]);
            }
            if (fin) {
#pragma unroll
                for (int j = 0; j < 4; ++j) { const int i = q4 * 4 + j; *(unsigned*)(fgb + i * 64 + ch2) = cvt_pk(gg[0][j], gg[1][j]); *(unsigned*)(fgb + 1024 + i * 64 + ch2) = cvt_pk(bon[j] * vv[0][j] * gg[0][j], bon[j] * vv[1][j] * gg[1][j]); }
            }
#pragma unroll
            for (int u = 0; u < 2; ++u) { const int ch = ch2 + u;
                *(u32x2*)(slot + SL_BH + (ch * 20 + q4 * 4) * 2) = (u32x2){cvt_pk(bhv[u][0], bhv[u][1]), cvt_pk(bhv[u][2], bhv[u][3])};
                *(u32x2*)(slot + SL_KH + (ch * 20 + q4 * 4) * 2) = (u32x2){cvt_pk(khv[u][0], khv[u][1]), cvt_pk(khv[u][2], khv[u][3])};
                *(u32x2*)(slot + SL_VT + (ch * 20 + q4 * 4) * 2) = (u32x2){cvt_pk(vv[u][0], vv[u][1]), cvt_pk(vv[u][2], vv[u][3])};
            }
        }
        RW_BAR();
        f32x4 ysp[2] = {(f32x4){0.f, 0.f, 0.f, 0.f}, (f32x4){0.f, 0.f, 0.f, 0.f}};
        if (fin) {
            RW_OPQ();
#pragma unroll
            for (int jt = 0; jt < 2; ++jt) ysp[jt] = *(const f32x4*)((const char*)Ysc + (unsigned)((T0 + sgn * (hf * 8 + q4 * 2 + jt)) * 512 + n16 * 4) * 4u);
        }
        {
            RW_OPQ();
            const bf16_t* X = (const bf16_t*)(slot + (hf ? SL_RT : SL_AT)) + n16 * 72 + q4 * 8;
            const bf16_t* YB = (const bf16_t*)(slot + SL_BT) + n16 * 72 + q4 * 8; const bf16_t* YK = (const bf16_t*)(slot + SL_KT) + n16 * 72 + q4 * 8;
            const bf16x8 x0 = *(const bf16x8*)X, x1 = *(const bf16x8*)(X + 32);
            f32x4 mb = {0.f, 0.f, 0.f, 0.f}, mk = mb;
            mb = __builtin_amdgcn_mfma_f32_16x16x32_bf16(x0, *(const bf16x8*)YB, mb, 0, 0, 0); mb = __builtin_amdgcn_mfma_f32_16x16x32_bf16(x1, *(const bf16x8*)(YB + 32), mb, 0, 0, 0);
            mk = __builtin_amdgcn_mfma_f32_16x16x32_bf16(x0, *(const bf16x8*)YK, mk, 0, 0, 0); mk = __builtin_amdgcn_mfma_f32_16x16x32_bf16(x1, *(const bf16x8*)(YK + 32), mk, 0, 0, 0);
#pragma unroll
            for (int jj = 0; jj < 4; ++jj) { const int i = q4 * 4 + jj; const bool keep = hf ? (n16 <= i) : (n16 < i); const float vb = keep ? mb[jj] : 0.f, vk = keep ? mk[jj] : 0.f;
                mb[jj] = vb;
                ((bf16_t*)(slot + (hf ? SL_ARK : SL_AAK)))[i * 20 + n16] = f2bf(vk);
                if (hf) ((bf16_t*)(slot + SL_ARB))[i * 20 + n16] = f2bf(vb); }
            if (hf == 0) {
#define RW_P4(M) __builtin_bit_cast(s16x4, (u32x2){cvt_pk(M[0], M[1]), cvt_pk(M[2], M[3])})
#define RW_MM16(A_, B_, C_) __builtin_amdgcn_mfma_f32_16x16x16bf16_1k(A_, B_, C_, 0, 0, 0)
                const f32x4 z4f = {0.f, 0.f, 0.f, 0.f};
                f32x4 nt = z4f;
                nt = __builtin_amdgcn_mfma_f32_16x16x32_bf16(*(const bf16x8*)YB, x0, nt, 0, 0, 0); nt = __builtin_amdgcn_mfma_f32_16x16x32_bf16(*(const bf16x8*)(YB + 32), x1, nt, 0, 0, 0);
                f32x4 R;
#pragma unroll
                for (int jj = 0; jj < 4; ++jj) { const int i = q4 * 4 + jj; nt[jj] = (i < n16) ? nt[jj] : 0.f; R[jj] = nt[jj] + (i == n16 ? 1.f : 0.f); }
                const s16x4 n1 = RW_P4(mb), n1t = RW_P4(nt);
                const f32x4 N2 = RW_MM16(n1t, n1, z4f), N2t = RW_MM16(n1, n1t, z4f);
                const s16x4 n2 = RW_P4(N2), n2t = RW_P4(N2t);
                R = RW_MM16(n2, RW_P4(R), R);
                const f32x4 N4 = RW_MM16(n2t, n2, z4f), N4t = RW_MM16(n2, n2t, z4f);
                const s16x4 n4 = RW_P4(N4), n4t = RW_P4(N4t);
                R = RW_MM16(n4, RW_P4(R), R);
                const f32x4 N8 = RW_MM16(n4t, n4, z4f);
                R = RW_MM16(RW_P4(N8), RW_P4(R), R);
                *(u32x2*)((bf16_t*)(slot + SL_TT) + n16 * 20 + q4 * 4) = (u32x2){cvt_pk(R[0], R[1]), cvt_pk(R[2], R[3])};
#undef RW_P4
#undef RW_MM16
            }
        }
        RW_BAR();
        if (wid < 4) {
            RW_OPQ();
#pragma unroll
            for (int c2 = 0; c2 < 4; ++c2) {
                const unsigned char* sl = lds + RW_SLOT + c2 * SL_SZ;
                const bf16x8 sf0 = pack8(ST[0][0], ST[0][1], ST[0][2], ST[0][3], ST[1][0], ST[1][1], ST[1][2], ST[1][3]);
                const bf16x8 sf1 = pack8(ST[2][0], ST[2][1], ST[2][2], ST[2][3], ST[3][0], ST[3][1], ST[3][2], ST[3][3]);
                const bf16_t* AT = (const bf16_t*)(sl + SL_AT) + n16 * 72 + q4 * 4; const bf16_t* RT = (const bf16_t*)(sl + SL_RT) + n16 * 72 + q4 * 4;
                const int mo = (n16 * 20 + q4 * 4) * 2;
                const u32x2 vmf = *(const u32x2*)(sl + SL_VT + ((vt * 16 + n16) * 20 + q4 * 4) * 2);
                const f32x4 z4f = {0.f, 0.f, 0.f, 0.f};
                f32x4 X = __builtin_amdgcn_mfma_f32_16x16x16bf16_1k(__builtin_bit_cast(s16x4, *(const u32x2*)(sl + SL_AAK + mo)), __builtin_bit_cast(s16x4, vmf), z4f, 0, 0, 0);
                X = __builtin_amdgcn_mfma_f32_16x16x32_bf16(lo_hi(*(const u32x2*)(AT), *(const u32x2*)(AT + 16)), sf0, X, 0, 0, 0);
                X = __builtin_amdgcn_mfma_f32_16x16x32_bf16(lo_hi(*(const u32x2*)(AT + 32), *(const u32x2*)(AT + 48)), sf1, X, 0, 0, 0);
                const f32x4 U = __builtin_amdgcn_mfma_f32_16x16x16bf16_1k(__builtin_bit_cast(s16x4, *(const u32x2*)(sl + SL_TT + mo)), __builtin_bit_cast(s16x4, (u32x2){cvt_pk(X[0], X[1]), cvt_pk(X[2], X[3])}), z4f, 0, 0, 0);
                const bf16x8 uv = lo_hi((u32x2){cvt_pk(U[0], U[1]), cvt_pk(U[2], U[3])}, vmf);
                f32x4 Y = {0.f, 0.f, 0.f, 0.f};
                Y = __builtin_amdgcn_mfma_f32_16x16x32_bf16(lo_hi(*(const u32x2*)(RT), *(const u32x2*)(RT + 16)), sf0, Y, 0, 0, 0);
                Y = __builtin_amdgcn_mfma_f32_16x16x32_bf16(lo_hi(*(const u32x2*)(RT + 32), *(const u32x2*)(RT + 48)), sf1, Y, 0, 0, 0);
                Y = __builtin_amdgcn_mfma_f32_16x16x32_bf16(lo_hi(*(const u32x2*)(sl + SL_ARB + mo), *(const u32x2*)(sl + SL_ARK + mo)), uv, Y, 0, 0, 0);
#pragma unroll
                for (int t = 0; t < 4; ++t) {
                    const f32x4 pc = *(const f32x4*)(sl + SL_PC + (t * 16 + q4 * 4) * 4);
                    const int kro = ((t * 16 + n16) * 20 + q4 * 4) * 2;
                    ST[t] = __builtin_amdgcn_mfma_f32_16x16x32_bf16(lo_hi(*(const u32x2*)(sl + SL_BH + kro), *(const u32x2*)(sl + SL_KH + kro)), uv, ST[t] * pc, 0, 0, 0);
                }
                float* yo = (float*)(lds + RW_SLOT + c2 * SL_SZ + SL_BT);
#pragma unroll
                for (int j = 0; j < 4; ++j) yo[(q4 * 4 + j) * 64 + vt * 16 + n16] = Y[j];
            }
        }
        RW_BAR();
        {
            RW_OPQ();
            const float* yo = (const float*)(slot + SL_BT);
            const int i0 = hf * 8 + q4 * 2, o0 = i0 * 64 + n16 * 4, t0 = T0 + sgn * i0, t1 = t0 + sgn;
            f32x4 y0 = *(const f32x4*)(yo + o0), y1 = *(const f32x4*)(yo + o0 + 64);
            u32x2 res[2] = {(u32x2){0u, 0u}, (u32x2){0u, 0u}};
            if (fin) {
                const f32x4 lng4 = *(const f32x4*)(CST + 384 + n16 * 4), lnb4 = *(const f32x4*)(CST + 448 + n16 * 4);
#pragma unroll
                for (int jt = 0; jt < 2; ++jt) { const int o = o0 + jt * 64;
                    const f32x4 y = (jt ? y1 : y0) + ysp[jt];
                    const float s1 = row_sum16(y[0] + y[1] + y[2] + y[3]), s2 = row_sum16(y[0] * y[0] + y[1] * y[1] + y[2] * y[2] + y[3] * y[3]);
                    const float mean = s1 * (1.f / 64.f), var = s2 * (1.f / 64.f) - mean * mean; const float rs = __builtin_amdgcn_rsqf(var + 64e-5f);
                    const u32x2 g2 = *(const u32x2*)(fgb + o), v2 = *(const u32x2*)(fgb + 1024 + o);
                    const float r0 = ((y[0] - mean) * rs * lng4[0] + lnb4[0]) * bf_lo(g2[0]) + bf_lo(v2[0]), r1 = ((y[1] - mean) * rs * lng4[1] + lnb4[1]) * bf_hi(g2[0]) + bf_hi(v2[0]);
                    const float r2 = ((y[2] - mean) * rs * lng4[2] + lnb4[2]) * bf_lo(g2[1]) + bf_lo(v2[1]), r3 = ((y[3] - mean) * rs * lng4[3] + lnb4[3]) * bf_hi(g2[1]) + bf_hi(v2[1]);
                    res[jt] = (u32x2){cvt_pk(r0, r1), cvt_pk(r2, r3)};
                }
            }
            RW_LANDED();
            if (!fin) { *(f32x4*)((char*)Ysc + (unsigned)(t0 * 512 + n16 * 4) * 4u) = y0; *(f32x4*)((char*)Ysc + (unsigned)(t1 * 512 + n16 * 4) * 4u) = y1; }
            else { *(u32x2*)((char*)Ob + (unsigned)(t0 * 1024 + n16 * 4) * 2u) = res[0]; *(u32x2*)((char*)Ob + (unsigned)(t1 * 1024 + n16 * 4) * 2u) = res[1]; }
        }
        if (s == SEQ / 128 - 1) {
            asm volatile("s_waitcnt vmcnt(0)" ::: "memory");
            __syncthreads();
            if (tid == 0) { __builtin_amdgcn_fence(__ATOMIC_RELEASE, "agent"); asm volatile("s_waitcnt vmcnt(0)" ::: "memory"); __hip_atomic_store(flags + task * 16, 1u, __ATOMIC_RELAXED, __HIP_MEMORY_SCOPE_AGENT); }
        }
    }
}

DI void phase_mixer(const Params& P, unsigned char* lds, int qsel, int mode = 0) {
    const int lane = threadIdx.x & 63;
    const float lam = __expf(wave_sum(P.da_lq1[lane] * P.da_lk1[lane])) - __expf(wave_sum(P.da_lq2[lane] * P.da_lk2[lane])) + 0.2f;
    float mq = fabsf(P.da_q_norm_g[lane]), mk = fabsf(P.da_k_norm_g[lane]);
    mq = wave_max(mq); mk = wave_max(mk);
    const float smax_ = 8.0f * mq * mk * 1.01f;
    unsigned* qhead = (unsigned*)(P.ws + WS_CTL) + CW_QUEUE + qsel;
    volatile unsigned* qw = (volatile unsigned*)(lds + LDS_QW);
    volatile float* pw = (volatile float*)(lds + LDS_QW + 4);
    if (threadIdx.x == 0) { pw[0] = lam; pw[1] = smax_; }
    for (;;) {
        __syncthreads();
        if (threadIdx.x == 0) *qw = atomicAdd(qhead, 1u) + (mode == 2 ? 128u : 0u);
        __syncthreads();
        const unsigned idx = __builtin_amdgcn_readfirstlane(*qw);
#ifndef AT_REP
#define AT_REP 1
#endif
#ifndef RW_DUP
#define RW_DUP 0
#endif
        if (idx >= 128u + 128u * RW_DUP + 2048u * AT_REP || (mode == 1 && idx >= 128u)) break;
#if !defined(MIX_ONLY) || MIX_ONLY == 1
        if (idx < 128u + 128u * RW_DUP) { const unsigned ti = idx & 127u; rwkv_task(P, lds, (int)(ti >> 4), (int)((ti >> 1) & 7), (int)(ti & 1)); }
#endif
#if !defined(MIX_ONLY) || MIX_ONLY == 2
        if (idx >= 128u + 128u * RW_DUP) { const unsigned u = (idx - 128u - 128u * RW_DUP) & 2047u; const int h = 3 - (int)(u >> 9), b = (int)((u >> 6) & 7), qb = (int)(u & 63);
            const float lam_ = __builtin_bit_cast(float, __builtin_amdgcn_readfirstlane(__builtin_bit_cast(int, (float)pw[0]))), smax = __builtin_bit_cast(float, __builtin_amdgcn_readfirstlane(__builtin_bit_cast(int, (float)pw[1])));
            const float slope = exp2f(-2.0f * (float)(h + 1)); int W = (int)ceilf((25.65f + 2.0f * smax) / slope); if (W > SEQ) W = SEQ;
            attn_unit(P, lds, b, h, qb, lam_, smax * LOG2E, W); }
#endif
    }
}

constexpr int N_PHASES = 13;
__global__ void __launch_bounds__(512, 2) mega(Params P) {
    extern __shared__ __attribute__((aligned(16))) unsigned char shm[];
    LAS unsigned char* lds = (LAS unsigned char*)shm;
    unsigned char* ws = P.ws;
    if (threadIdx.x == 0) *(LAS u32x4*)(lds + LDS_XB) = (u32x4){0u, 0u, 0u, 0u};
    __syncthreads();
    XcdBarrier bar = xcd_barrier_post(g_xbar, (volatile LAS unsigned*)(lds + LDS_XB));
#ifndef ONLY_PHASE
#define RUN(k) (P.ph_lo <= (k) && (k) < P.ph_hi)
#else
#define RUN(k) ((k) == ONLY_PHASE && P.ph_lo <= (k) && (k) < P.ph_hi)
#endif
#ifdef DIAG_PHASE
    unsigned long long dg_t0 = 0, dg_t1 = 0;
#define SYNC(k) do { if (P.ph_lo <= (k) && (k) + 1 < P.ph_hi) xcd_barrier(bar); if ((k) + 1 == DIAG_PHASE || ((k) == 8 && DIAG_PHASE == 12)) dg_t0 = wall_clock64(); if ((k) == DIAG_PHASE) dg_t1 = wall_clock64(); } while (0)
#else
#define SYNC(k) do { if (P.ph_lo <= (k) && (k) + 1 < P.ph_hi) xcd_barrier(bar); } while (0)
#endif
    if (RUN(0)) phase_prep(P, shm);
#if defined(REP_PHASE) && REP_PHASE == 0
    xcd_barrier(bar); phase_prep(P, shm);
#endif
    SYNC(0);
    if (RUN(1)) { DenseOrder S; S.init(ws + WS_U, ws + WS_WIN, MTOK, IN_PAD, 2048, 2048); EpiZ E{(bf16_t*)(ws + WS_Z), P.da_q_norm_g, P.da_k_norm_g}; gemm_phase<false, 2>(lds, 1024, 1024, S, E);
#if defined(REP_PHASE) && REP_PHASE == 1
        xcd_barrier(bar); gemm_phase<false, 2>(lds, 1024, 1024, S, E);
#endif
#if defined(REP_PHASE) && REP_PHASE == 101
        xcd_barrier(bar); { EpiNone E0{(float*)(ws + WS_ESS)}; gemm_phase<false, 2>(lds, 1024, 1024, S, E0); }
#endif
    }
    SYNC(1);
    if (RUN(2)) phase_qknorm(P);
    SYNC(2);
#if defined(REP_PHASE) && REP_PHASE == 3
    if (RUN(3)) for (int rep = 0; rep < 2; ++rep) { if (rep) xcd_barrier(bar); phase_mixer(P, shm, rep, rep ? REP_MODE : 0); }
#else
    if (RUN(3)) phase_mixer(P, shm, 0);
#endif
    SYNC(3);
    if (RUN(4)) { DenseOrder S; S.init(ws + WS_O, ws + WS_WOUT, MTOK, 1024, 2048, 2048); EpiH1 E{P.x, (bf16_t*)P.out}; gemm_phase<false, 2>(lds, 1024, 1024, S, E);
#if defined(REP_PHASE) && REP_PHASE == 4
        xcd_barrier(bar); gemm_phase<false, 2>(lds, 1024, 1024, S, E);
#endif
    }
    SYNC(4);
    if (RUN(5)) phase_route(P, lds);
    SYNC(5);
    if (RUN(6)) { moe_tables(lds, (const unsigned*)(ws + WS_CTL) + CW_CNT);
        MoeOrder<8, true, 1> S{(const char*)(ws + WS_U), (const char*)(ws + WS_W1), (size_t)2048 * 1024, 0, 128, (int)gridDim.x, (int)blockIdx.x, lds, (const int*)(ws + WS_LIST)};
        EpiMoe1 E{ws + WS_Z, P.b1}; gemm_phase<true, 1>(lds, 1024, 1024, S, E);
#if defined(REP_PHASE) && REP_PHASE == 6
        xcd_barrier(bar); gemm_phase<true, 1>(lds, 1024, 1024, S, E);
#endif
    }
    SYNC(6);
    if (RUN(7)) { moe_tables(lds, (const unsigned*)(ws + WS_CTL) + CW_CNT);
        MoeOrder<4, false, 1> S{(const char*)(ws + WS_Z), (const char*)(ws + WS_W2), (size_t)1024 * 1024, 0, 128, (int)gridDim.x, (int)blockIdx.x, lds, (const int*)(ws + WS_LIST)};
        EpiMoe2 E{ws + WS_Y8}; gemm_phase<true, 1>(lds, 1024, 1024, S, E);
        DenseOrder SP; SP.init(ws + WS_PB, ws + WS_WPLE, MTOK, 1024, 512, 512);
        { const LAS int* pre_ = (const LAS int*)(lds + LDS_GRP) + 128; const int n2 = (__builtin_amdgcn_readfirstlane(pre_[128]) - __builtin_amdgcn_readfirstlane(pre_[0])) * 4, G_ = (int)gridDim.x, c_ = (int)blockIdx.x;
          const int i1 = n2 > c_ ? (n2 - c_ + G_ - 1) / G_ : 0; SP.shift = i1 * G_ - n2; }
        EpiPle EP{ws + WS_U, (float*)(ws + WS_ESS)}; gemm_phase<true, 2>(lds, 256, 256, SP, EP); }
    SYNC(7);
    if (RUN(8)) phase_combine(P, lds);
    SYNC(8);
    if (RUN(12)) { DenseOrder S; S.init(ws + WS_W2, ws + WS_WG, MTOK, 1024, 1024, 1024); EpiFinal E{P.out, (const bf16_t*)(ws + WS_HB), (const unsigned char*)(ws + WS_U), (const float*)(ws + WS_ESS), P.ple_norm_g}; gemm_phase<true, 1>(lds, 1024, 1024, S, E); }
#ifdef DIAG_PHASE
    xcd_barrier(bar); if (DIAG_PHASE == 12) dg_t1 = wall_clock64();
    __syncthreads();
    if (blockIdx.x == 0 && threadIdx.x == 0) { asm volatile("s_waitcnt vmcnt(0)" ::: "memory"); P.out[0] += (float)((((dg_t1 - dg_t0) / 100ull + DIAG_Q / 2) / DIAG_Q) * DIAG_Q); }
#endif
    __syncthreads();
    if (threadIdx.x == 0) { const unsigned old = xb_add(&g_xbar[XCD_BAR_WORDS], 1u); *(volatile LAS unsigned*)(lds + LDS_QW) = (old + 1u == gridDim.x) ? 1u : 0u; }
    __syncthreads();
    if (*(volatile LAS unsigned*)(lds + LDS_QW) != 0u) { for (int i = threadIdx.x; i < XCD_BAR_WORDS + 64; i += 512) __hip_atomic_store(&g_xbar[i], 0u, __ATOMIC_RELAXED, __HIP_MEMORY_SCOPE_AGENT); }
}

#ifndef MK_N_LAUNCHES
#define MK_N_LAUNCHES 1
#endif
extern "C" void kernel_launch(void* const* d_in, const int* in_sizes, int n_in, void* d_out, int out_size, void* d_ws, size_t ws_size, hipStream_t stream) {
    static int grid = 0;
    if (grid == 0) {
        if (n_in != 33 || in_sizes[0] != MTOK * D_MODEL || out_size != MTOK * D_MODEL || ws_size < WS_END) {
            fprintf(stderr, "kernel_launch: shape mismatch: n_in %d in0 %d out %d ws %zu (need %zu)\n", n_in, n_in > 0 ? in_sizes[0] : -1, out_size, ws_size, (size_t)WS_END); grid = -1; return; }
        int dev = 0, cus = 0, per_cu = 0;
        if (hipGetDevice(&dev) != hipSuccess || hipDeviceGetAttribute(&cus, hipDeviceAttributeMultiprocessorCount, dev) != hipSuccess) { grid = -1; return; }
        if (hipFuncSetAttribute((const void*)mega, hipFuncAttributeMaxDynamicSharedMemorySize, LDS_BYTES) != hipSuccess) { fprintf(stderr, "kernel_launch: hipFuncSetAttribute failed\n"); grid = -1; return; }
        if (hipOccupancyMaxActiveBlocksPerMultiprocessor(&per_cu, (const void*)mega, 512, LDS_BYTES) != hipSuccess || per_cu < 1) fprintf(stderr, "kernel_launch: occupancy query says %d\n", per_cu);
        (void)hipGetLastError();
        grid = cus;
    }
    if (grid < 0) return;
    Params p{};
    const float** f = (const float**)&p;
    for (int i = 0; i < 33; ++i) f[i] = (const float*)d_in[i];
    p.out = (float*)d_out; p.ws = (unsigned char*)d_ws;
    if (MK_N_LAUNCHES == 1) { p.ph_lo = 0; p.ph_hi = N_PHASES; hipLaunchKernelGGL(mega, dim3(grid), dim3(512), LDS_BYTES, stream, p); }
    else for (int k = 0; k < N_PHASES; ++k) { p.ph_lo = k; p.ph_hi = k + 1; hipLaunchKernelGGL(mega, dim3(grid), dim3(512), LDS_BYTES, stream, p); }
    const hipError_t le = hipPeekAtLastError();
    if (le != hipSuccess) fprintf(stderr, "kernel_launch: launch failed: %s\n", hipGetErrorName(le));
}
```
